# Optimizing an MI355X kernel written in HIP

```python
import math
import jax
import jax.numpy as jnp
from jax import lax
import numpy as np

D_MODEL = 1024
BATCH = 8
SEQ = 4096
DEPTH = 4

N_HEADS = 16
N_KV_HEADS = 4
HEAD_DIM = 64
GROUP = N_HEADS // N_KV_HEADS
WINDOW = 128
BLOCK = 128
ATTN_W = N_HEADS * HEAD_DIM
KV_W = N_KV_HEADS * HEAD_DIM
NUM_BUCKETS = 32
MAX_DISTANCE = 128
MAX_EXACT = NUM_BUCKETS // 2
D_RNN = D_MODEL
N_LRU_BLOCKS = 16
LRU_BLOCK = D_RNN // N_LRU_BLOCKS
CONV_WIDTH = 4
LRU_C = 8.0
D_FF = D_MODEL * 7 // 2
N_EXPERTS = 8
TOP_K = 2
N_DENSE = (DEPTH + 1) // 2
N_MOE = DEPTH // 2
PLE_DIM = 256
IN_SPLITS = (ATTN_W, KV_W, KV_W, D_RNN, D_RNN, D_MODEL, D_MODEL)
N_IN = sum(IN_SPLITS)
EPS = 1e-6
NEG_INF = -1e30

kernel_name = "hybrid_swa_rglru_moe_trunk"


def rmsnorm(x, g):
    xf = x.astype(jnp.float32)
    y = xf * lax.rsqrt(jnp.mean(xf * xf, axis=-1, keepdims=True) + EPS)
    return (y * g.astype(jnp.float32)).astype(x.dtype)


def t5_bucket(dist):
    d = jnp.maximum(dist, 0)
    large = MAX_EXACT + (jnp.log(jnp.maximum(d, 1).astype(jnp.float32) / MAX_EXACT)
                         / math.log(MAX_DISTANCE / MAX_EXACT)
                         * (NUM_BUCKETS - MAX_EXACT)).astype(jnp.int32)
    large = jnp.minimum(large, NUM_BUCKETS - 1)
    return jnp.where(d < MAX_EXACT, d, large)


def band_geometry(n_blocks):
    qi = jnp.arange(BLOCK, dtype=jnp.int32)[:, None]
    ks = jnp.arange(2 * BLOCK, dtype=jnp.int32)[None, :]
    dist = BLOCK + qi - ks
    in_window = (dist >= 0) & (dist < WINDOW)
    key_abs = jnp.arange(n_blocks, dtype=jnp.int32)[:, None, None] * BLOCK - BLOCK + ks[None]
    mask = in_window[None] & (key_abs >= 0)
    return t5_bucket(dist), mask


def head_rms(x, g):
    return rmsnorm(x, g)


def sliding_window_attention(q, k, v, bias, mask, sink):
    B, S = q.shape[0], q.shape[1]
    nb = S // BLOCK
    qb = q.reshape(B, nb, BLOCK, N_KV_HEADS, GROUP, HEAD_DIM)

    def band(t):
        tb = t.reshape(B, nb, BLOCK, N_KV_HEADS, HEAD_DIM)
        prev = jnp.pad(tb[:, :-1], ((0, 0), (1, 0), (0, 0), (0, 0), (0, 0)))
        return jnp.concatenate([prev, tb], axis=2)

    kb, vb = band(k), band(v)
    s = jnp.einsum('bnqkgd,bnskd->bnkgqs', qb, kb).astype(jnp.float32) * (HEAD_DIM ** -0.5)
    s = jnp.where(mask[None, :, None, None], s + bias[None, None].astype(jnp.float32), NEG_INF)
    sink_l = sink.astype(jnp.float32).reshape(1, 1, N_KV_HEADS, GROUP, 1, 1)
    m = jnp.maximum(jnp.max(s, axis=-1, keepdims=True), sink_l)
    e = jnp.exp(s - m)
    probs = e / (jnp.sum(e, axis=-1, keepdims=True) + jnp.exp(sink_l - m))
    o = jnp.einsum('bnkgqs,bnskd->bnqkgd', probs.astype(v.dtype), vb)
    return o.reshape(B, S, ATTN_W)


def block_diag(x, w, b):
    B, S, C = x.shape
    xb = x.reshape(B, S, N_LRU_BLOCKS, LRU_BLOCK)
    return (jnp.einsum('bsnc,ncd->bsnd', xb, w) + b).reshape(B, S, C)


def rg_lru_branch(xb, gb, conv_w, conv_b, w_rg, b_rg, w_ig, b_ig, lam):
    C = xb.shape[-1]
    xc = lax.conv_general_dilated(xb, conv_w[:, None, :], window_strides=(1,),
                                  padding=[(CONV_WIDTH - 1, 0)],
                                  dimension_numbers=('NWC', 'WIO', 'NWC'),
                                  feature_group_count=C) + conv_b
    r = jax.nn.sigmoid(block_diag(xc, w_rg, b_rg))
    i = jax.nn.sigmoid(block_diag(xc, w_ig, b_ig))
    log_a = -LRU_C * r.astype(jnp.float32) * jax.nn.softplus(-lam.astype(jnp.float32))
    a = jnp.exp(log_a)
    u = jnp.sqrt(-jnp.expm1(2.0 * log_a)) * (i * xc).astype(jnp.float32)

    def combine(left, right):
        a1, b1 = left
        a2, b2 = right
        return a1 * a2, a2 * b1 + b2

    _, h = lax.associative_scan(combine, (a, u), axis=1)
    return h.astype(xb.dtype) * jax.nn.gelu(gb)


def swiglu(x, w1, w3, w2):
    return (jax.nn.silu(x @ w1) * (x @ w3)) @ w2


def moe_ffn(xn, router_w, router_b, w1, w3, w2):
    logits = (xn @ router_w).astype(jnp.float32) + router_b.astype(jnp.float32)
    top_v, top_i = lax.top_k(logits, TOP_K)
    w = jax.nn.softmax(top_v, axis=-1)
    gate = jnp.sum(jax.nn.one_hot(top_i, N_EXPERTS, dtype=jnp.float32) * w[..., None], axis=-2)
    gate = gate.astype(xn.dtype)
    out = jnp.zeros_like(xn)
    for e in range(N_EXPERTS):
        out = out + gate[..., e:e + 1] * swiglu(xn, w1[e], w3[e], w2[e])
    return out


def setup_inputs(seed: int = 0) -> dict:
    key = jax.random.key(seed)
    keys = iter(jax.random.split(key, 40))
    f32 = jnp.float32

    def nrm(shape, fan_in):
        return jax.random.normal(next(keys), shape, f32) * (fan_in ** -0.5)

    def gain(shape):
        return 1.0 + 0.01 * jax.random.normal(next(keys), shape, f32)

    def small(shape, scale=0.01):
        return scale * jax.random.normal(next(keys), shape, f32)

    x = jax.random.normal(next(keys), (BATCH, SEQ, D_MODEL), f32)
    p = jax.random.normal(next(keys), (DEPTH, BATCH, SEQ, PLE_DIM), f32)
    mix_norm = gain((DEPTH, D_MODEL))
    w_in = nrm((DEPTH, D_MODEL, N_IN), D_MODEL)
    q_norm = gain((DEPTH, HEAD_DIM))
    k_norm = gain((DEPTH, HEAD_DIM))
    sinks = small((DEPTH, N_HEADS), 0.5)
    rel_bias = small((NUM_BUCKETS, N_HEADS), 0.5)
    conv_w = nrm((DEPTH, CONV_WIDTH, D_RNN), CONV_WIDTH)
    conv_b = small((DEPTH, D_RNN))
    w_rg = nrm((DEPTH, N_LRU_BLOCKS, LRU_BLOCK, LRU_BLOCK), LRU_BLOCK)
    b_rg = small((DEPTH, N_LRU_BLOCKS, LRU_BLOCK))
    w_ig = nrm((DEPTH, N_LRU_BLOCKS, LRU_BLOCK, LRU_BLOCK), LRU_BLOCK)
    b_ig = small((DEPTH, N_LRU_BLOCKS, LRU_BLOCK))
    a_c = jax.random.uniform(next(keys), (DEPTH, D_RNN), f32, 0.9, 0.999)
    sig_l = a_c ** (1.0 / LRU_C)
    lru_lambda = jnp.log(sig_l) - jnp.log1p(-sig_l)
    w_proj_attn = nrm((DEPTH, ATTN_W, D_MODEL), ATTN_W)
    w_proj_lru = nrm((DEPTH, D_RNN, D_MODEL), D_RNN)
    w_out = nrm((DEPTH, D_MODEL, D_MODEL), D_MODEL)
    ffn_norm = gain((DEPTH, D_MODEL))
    dense_w1 = nrm((N_DENSE, D_MODEL, D_FF), D_MODEL)
    dense_w3 = nrm((N_DENSE, D_MODEL, D_FF), D_MODEL)
    dense_w2 = nrm((N_DENSE, D_FF, D_MODEL), D_FF)
    router_w = nrm((N_MOE, D_MODEL, N_EXPERTS), D_MODEL)
    router_b = small((N_MOE, N_EXPERTS))
    moe_w1 = nrm((N_MOE, N_EXPERTS, D_MODEL, D_FF), D_MODEL)
    moe_w3 = nrm((N_MOE, N_EXPERTS, D_MODEL, D_FF), D_MODEL)
    moe_w2 = nrm((N_MOE, N_EXPERTS, D_FF, D_MODEL), D_FF)
    ple_norm = gain((DEPTH, D_MODEL))
    ple_gate_w = nrm((DEPTH, D_MODEL, D_MODEL), D_MODEL)
    ple_proj_w = nrm((DEPTH, PLE_DIM, D_MODEL), PLE_DIM)
    return {"x": x, "p": p, "mix_norm": mix_norm, "w_in": w_in, "q_norm": q_norm,
            "k_norm": k_norm, "sinks": sinks, "rel_bias": rel_bias, "conv_w": conv_w,
            "conv_b": conv_b, "w_rg": w_rg, "b_rg": b_rg, "w_ig": w_ig, "b_ig": b_ig,
            "lru_lambda": lru_lambda, "w_proj_attn": w_proj_attn, "w_proj_lru": w_proj_lru,
            "w_out": w_out, "ffn_norm": ffn_norm, "dense_w1": dense_w1, "dense_w3": dense_w3,
            "dense_w2": dense_w2, "router_w": router_w, "router_b": router_b,
            "moe_w1": moe_w1, "moe_w3": moe_w3, "moe_w2": moe_w2, "ple_norm": ple_norm,
            "ple_gate_w": ple_gate_w, "ple_proj_w": ple_proj_w}


def reference(x, p, mix_norm, w_in, q_norm, k_norm, sinks, rel_bias, conv_w, conv_b,
              w_rg, b_rg, w_ig, b_ig, lru_lambda, w_proj_attn, w_proj_lru, w_out,
              ffn_norm, dense_w1, dense_w3, dense_w2, router_w, router_b,
              moe_w1, moe_w3, moe_w2, ple_norm, ple_gate_w, ple_proj_w):
    B, S, _ = x.shape
    nb = S // BLOCK
    bucket, mask = band_geometry(nb)
    bias = jnp.transpose(rel_bias[bucket], (2, 0, 1)).reshape(N_KV_HEADS, GROUP, BLOCK, 2 * BLOCK)
    split_points = list(np.cumsum(IN_SPLITS)[:-1])

    h = x
    for i in range(DEPTH):
        xn = rmsnorm(h, mix_norm[i])
        u = xn @ w_in[i]
        q, k, v, lx, lg, ga, gb = jnp.split(u, split_points, axis=-1)
        q = head_rms(q.reshape(B, S, N_HEADS, HEAD_DIM), q_norm[i])
        k = head_rms(k.reshape(B, S, N_KV_HEADS, HEAD_DIM), k_norm[i])
        v = v.reshape(B, S, N_KV_HEADS, HEAD_DIM)
        y_a = sliding_window_attention(q, k, v, bias, mask, sinks[i])
        y_b = rg_lru_branch(lx, lg, conv_w[i], conv_b[i], w_rg[i], b_rg[i],
                            w_ig[i], b_ig[i], lru_lambda[i])
        merged = (jax.nn.sigmoid(ga) * (y_a @ w_proj_attn[i])
                  + jax.nn.sigmoid(gb) * (y_b @ w_proj_lru[i]))
        h = h + merged @ w_out[i]
        xn2 = rmsnorm(h, ffn_norm[i])
        j = i // 2
        if i % 2 == 0:
            h = h + swiglu(xn2, dense_w1[j], dense_w3[j], dense_w2[j])
        else:
            h = h + moe_ffn(xn2, router_w[j], router_b[j], moe_w1[j], moe_w3[j], moe_w2[j])
        xn3 = rmsnorm(h, ple_norm[i])
        h = h + jax.nn.sigmoid(xn3 @ ple_gate_w[i]) * (p[i] @ ple_proj_w[i])
    return h
```

```cpp
#include <hip/hip_runtime.h>
#include <cstdio>
#include <cstdint>
#include <cstring>

#define LAS __attribute__((address_space(3)))
#define GAS __attribute__((address_space(1)))
typedef unsigned short bf16;
typedef short bf16x8 __attribute__((ext_vector_type(8)));
typedef float f32x4 __attribute__((ext_vector_type(4)));
typedef float f32x2 __attribute__((ext_vector_type(2)));
typedef unsigned u32x4 __attribute__((ext_vector_type(4)));
typedef unsigned u32x2 __attribute__((ext_vector_type(2)));

constexpr int BATCH = 8, SEQ = 4096, DM = 1024, DEPTH = 4, M = BATCH * SEQ;
constexpr int NIN = 5632, C_Q = 0, C_K = 1024, C_V = 1280, C_LX = 1536, C_LG = 2560, C_GA = 3584, C_GB = 4608;
constexpr int DFF = 3584, NEXP = 8, PLE = 256;
constexpr int NSLOT = 67584;
constexpr float EPS = 1e-6f, LOG2E = 1.4426950408889634f, QSCALE = 0.125f * LOG2E;

constexpr size_t MiB = 1u << 20;
constexpr size_t WS_CTL = 0;
constexpr size_t WS_WIN = 1 * MiB;
constexpr size_t WS_WPA = 45 * MiB, WS_WPB = 53 * MiB, WS_WOUT = 61 * MiB, WS_WPG = 69 * MiB;
constexpr size_t WS_WPP = 77 * MiB;
constexpr size_t WS_W13D = 79 * MiB;
constexpr size_t WS_W2D = 107 * MiB;
constexpr size_t WS_LRUW = 121 * MiB;
constexpr size_t WS_W13E = 122 * MiB;
constexpr size_t WS_W2E = 234 * MiB;
constexpr size_t WS_PB = 290 * MiB;
constexpr size_t WS_HB = 306 * MiB;
constexpr size_t WS_SSQ = 370 * MiB;
constexpr size_t WS_SEL = 371 * MiB;
constexpr size_t WS_SLOT = 372 * MiB;
constexpr size_t WS_PP = 373 * MiB;
constexpr size_t WS_R = 437 * MiB;
constexpr size_t R_U = 0, R_YA = 352 * MiB, R_YB = 416 * MiB, R_MB = 480 * MiB, R_NA = 544 * MiB, R_NU = 576 * MiB;
constexpr size_t R_G = 0;
constexpr size_t R_XG = 0, R_GM = 132 * MiB;
constexpr size_t WS_END = 437 * MiB + 608 * MiB;

__host__ __device__ __forceinline__ float bf2f(bf16 x) { return __builtin_bit_cast(float, (unsigned)x << 16); }
__host__ __device__ __forceinline__ bf16 f2bf(float f) { unsigned u = __builtin_bit_cast(unsigned, f); return (bf16)((u + 0x7fffu + ((u >> 16) & 1u)) >> 16); }
__device__ __forceinline__ unsigned pk2(float lo, float hi) { return (unsigned)f2bf(lo) | ((unsigned)f2bf(hi) << 16); }
__device__ __forceinline__ float sigmoidf_(float x) { return 1.f / (1.f + __expf(-x)); }
__device__ __forceinline__ float gelu_tanh(float x) { const float z = 0.7978845608028654f * (x + 0.044715f * x * x * x); return x / (1.f + __expf(-2.f * z)); }
__device__ __forceinline__ float wave_sum(float v) {
#pragma unroll
    for (int o = 1; o < 64; o <<= 1) v += __shfl_xor(v, o);
    return v;
}
__device__ __forceinline__ float rstd_of(const float* ssq4, int m) { const f32x4 s = *(const f32x4*)(ssq4 + 4 * (size_t)m); return rsqrtf(((s.x + s.y) + (s.z + s.w)) * (1.f / 1024.f) + EPS); }

namespace pg8 {
typedef unsigned short bf16_t;
constexpr int BM = 256, BK = 64, HALF = 128, HTB = HALF * BK * 2, STAGE_BYTES = 8 * HTB, NXCD = 8, WGM = 8;
__host__ __device__ __forceinline__ int lds_byte(int r, int c) { const int st = (r >> 4) * 2 + (c >> 5), rr = r & 15, cc = c & 31, ob = rr * 64 + cc * 2; return st * 1024 + (ob ^ (((ob >> 9) & 1) << 5)); }
__host__ __device__ __forceinline__ void stage_rc(int b, int& R, int& C) { const int st = b / 1024, sb = b % 1024, swz = sb ^ (((sb >> 9) & 1) << 5); R = (st >> 1) * 16 + swz / 64; C = (st & 1) * 32 + (swz % 64) / 2; }
__host__ __device__ __forceinline__ int perm32(int rho) { const int n = rho >> 4, i = rho & 15; return 8 * (i >> 2) + 4 * n + (i & 3); }

struct Unit { int pm, pn; };
struct Gemm { const bf16_t* A; const bf16_t* Bt; int K; int pad; };

struct StaticOrder {
    int nM, nN, nwg, G, c, pad;
    __host__ __device__ void init(int M_, int N_, int G_, int c_) { nM = M_ / BM; nN = N_ / BM; nwg = nM * nN; G = G_; c = c_; pad = 0; }
    __device__ __forceinline__ void setup(int G_, int c_) { G = G_; c = c_; }
    __host__ __device__ bool next(int i, Unit& u) const {
        const long L = (long)i * G + c; if (L >= nwg) return false;
        int wgid = (int)L; { const int q = nwg / NXCD, r = nwg % NXCD, xcd = wgid % NXCD, off = wgid / NXCD; wgid = (xcd < r ? xcd * (q + 1) : r * (q + 1) + (xcd - r) * q) + off; }
        const int nig = WGM * nN, gid = wgid / nig, fm = gid * WGM, gsz = (nM - fm) < WGM ? (nM - fm) : WGM;
        u.pm = fm + ((wgid % nig) % gsz); u.pn = (wgid % nig) / gsz; return true;
    }
    __device__ __forceinline__ const char* a_ptr(const Unit& u, const Gemm& g) const { return (const char*)g.A + (size_t)u.pm * (size_t)(BM * 2) * g.K; }
    __device__ __forceinline__ const char* b_ptr(const Unit& u, const Gemm& g) const { return (const char*)g.Bt + (size_t)u.pn * (size_t)(BM * 2) * g.K; }
    __device__ __forceinline__ void a_ready(const Unit&) const {}
    __device__ __forceinline__ void done(const Unit&) const {}
};
struct MoeOrder {
    const int* meta; size_t wstride; int N, pad0;
    StaticOrder so; int ts[10];
    __device__ __forceinline__ void setup(int G_, int c_) {
#pragma unroll
        for (int e = 0; e < 9; ++e) ts[e] = __builtin_amdgcn_readfirstlane(__hip_atomic_load(meta + e, __ATOMIC_RELAXED, __HIP_MEMORY_SCOPE_AGENT));
        so.init(ts[8] * BM, N, G_, c_);
    }
    __device__ __forceinline__ bool next(int i, Unit& u) const { return so.next(i, u); }
    __device__ __forceinline__ const char* a_ptr(const Unit& u, const Gemm& g) const { return (const char*)g.A + (size_t)u.pm * (size_t)(BM * 2) * g.K; }
    __device__ __forceinline__ const char* b_ptr(const Unit& u, const Gemm& g) const {
        int e = 0;
#pragma unroll
        for (int j = 1; j < 8; ++j) e += (u.pm >= ts[j]) ? 1 : 0;
        return (const char*)(g.Bt + (size_t)e * wstride) + (size_t)u.pn * (size_t)(BM * 2) * g.K;
    }
    __device__ __forceinline__ void a_ready(const Unit&) const {}
    __device__ __forceinline__ void done(const Unit&) const {}
};

template <class F> struct EpiElem {
    static constexpr bool PERM = false, AFTER_DRAIN = false;
    F f;
    __device__ __forceinline__ void operator()(const f32x4 (&acc)[2][2][4][2], const Unit& u, int wr, int wc, int fr, int fq) const {
#pragma unroll
        for (int ai = 0; ai < 2; ++ai)
#pragma unroll
            for (int m = 0; m < 4; ++m) {
                const int row = u.pm * BM + ai * HALF + wr * 64 + m * 16 + fr; const auto ctx = f.row(row);
#pragma unroll
                for (int bj = 0; bj < 2; ++bj)
#pragma unroll
                    for (int n = 0; n < 2; ++n) { const int c0 = u.pn * BM + bj * HALF + wc * 32 + n * 16 + 4 * fq;
#pragma unroll
                        for (int e = 0; e < 4; ++e) f(ctx, row, c0 + e, acc[ai][bj][m][n][e]); }
            }
    }
};
template <class F> struct EpiPair {
    static constexpr bool PERM = true, AFTER_DRAIN = false;
    F f;
    __device__ __forceinline__ void operator()(const f32x4 (&acc)[2][2][4][2], const Unit& u, int wr, int wc, int fr, int fq) const {
#pragma unroll
        for (int ai = 0; ai < 2; ++ai)
#pragma unroll
            for (int m = 0; m < 4; ++m) {
                const int row = u.pm * BM + ai * HALF + wr * 64 + m * 16 + fr; const auto ctx = f.row(row);
#pragma unroll
                for (int bj = 0; bj < 2; ++bj) { const int c0 = u.pn * BM + bj * HALF + wc * 32 + 8 * fq, oc0 = c0 >> 1;
#pragma unroll
                    for (int e = 0; e < 4; ++e) f(ctx, row, oc0 + e, acc[ai][bj][m][0][e], acc[ai][bj][m][1][e]); }
            }
    }
};

template <class Epi, class Sched, bool ALIGN_EPI = false, bool SP2 = false>
__device__ __forceinline__ void gemm_phase(LAS unsigned char* lds, const Gemm g, const Sched& S, const Epi& E) {
    const int tid = threadIdx.x, wid = __builtin_amdgcn_readfirstlane(tid >> 6), lane = tid & 63, wr = wid >> 2, wc = wid & 3, fr = lane & 15, fq = lane >> 4;
    const int K = g.K, nt = K / BK;
    unsigned voffA[2], voffB[2];
#pragma unroll
    for (int i = 0; i < 2; ++i) { int R, C; stage_rc(tid * 16 + i * 8192, R, C); const int Rb = Epi::PERM ? ((R & ~31) + perm32(R & 31)) : R;
        voffA[i] = (unsigned)(R * K + C) * 2u; voffB[i] = (unsigned)(Rb * K + C) * 2u; }
    const size_t kstep = (size_t)(BK * 2);
    const size_t hstep = (size_t)HALF * K * 2;
    const unsigned ldsw = (unsigned)wid * 1024u;
    const int aoff = lds_byte(wr * 64 + fr, fq * 8), boff = lds_byte(wc * 32 + fr, fq * 8);
#define PG8_SA(b, h) (((b) * 2 + (h)) * HTB)
#define PG8_SB(b, h) ((4 + (b) * 2 + (h)) * HTB)
#define PG8_STAGE(bufoff, gbase, voff) do { _Pragma("unroll") for (int _i = 0; _i < 2; ++_i) \
        __builtin_amdgcn_global_load_lds((const unsigned*)((const char*)(gbase) + (voff)[_i]), (LAS unsigned*)(lds + (bufoff) + ldsw + _i * 8192), 16, 0, 0); } while (0)
#define PG8_LDA(dst, b, h) do { _Pragma("unroll") for (int m = 0; m < 4; ++m) _Pragma("unroll") for (int k = 0; k < 2; ++k) dst[m][k] = *(const LAS bf16x8*)(lds + PG8_SA(b, h) + aoff + m * 2048 + k * 1024); } while (0)
#define PG8_LDB(dst, b, h) do { _Pragma("unroll") for (int n = 0; n < 2; ++n) _Pragma("unroll") for (int k = 0; k < 2; ++k) dst[n][k] = *(const LAS bf16x8*)(lds + PG8_SB(b, h) + boff + n * 2048 + k * 1024); } while (0)
#define PG8_MMA(ai, bj, At, Bt) do { __builtin_amdgcn_s_setprio(1); _Pragma("unroll") for (int m = 0; m < 4; ++m) _Pragma("unroll") for (int n = 0; n < 2; ++n) _Pragma("unroll") for (int k = 0; k < 2; ++k) \
        acc[ai][bj][m][n] = __builtin_amdgcn_mfma_f32_16x16x32_bf16(Bt[n][k], At[m][k], acc[ai][bj][m][n], 0, 0, 0); __builtin_amdgcn_s_setprio(0); } while (0)
#define PG8_WAIT_V(n) asm volatile("s_waitcnt vmcnt(" #n ")" ::: "memory")
#define PG8_WAIT_L(n) asm volatile("s_waitcnt lgkmcnt(" #n ")" ::: "memory")
#define PG8_BAR __builtin_amdgcn_s_barrier()
#define PG8_SCHED __builtin_amdgcn_sched_barrier(0)
    Unit cur, nxt; int ui = 0;
    if (!S.next(0, cur)) return;
    f32x4 acc[2][2][4][2];
#pragma unroll
    for (int a = 0; a < 2; ++a)
#pragma unroll
        for (int b = 0; b < 2; ++b)
#pragma unroll
            for (int m = 0; m < 4; ++m)
#pragma unroll
                for (int n = 0; n < 2; ++n) acc[a][b][m][n] = (f32x4){0.f, 0.f, 0.f, 0.f};
    bf16x8 At[4][2], B0[2][2], B1[2][2];
    const char* cA = S.a_ptr(cur, g); const char* cB = S.b_ptr(cur, g);
    S.a_ready(cur);
    if constexpr (SP2) {
        PG8_STAGE(PG8_SB(0, 0), cB, voffB); PG8_STAGE(PG8_SB(0, 1), cB + hstep, voffB); PG8_STAGE(PG8_SA(0, 0), cA, voffA); PG8_STAGE(PG8_SA(0, 1), cA + hstep, voffA);
        if (wr == 1) PG8_BAR;
        PG8_WAIT_V(2); PG8_BAR;
        PG8_STAGE(PG8_SB(1, 0), cB + kstep, voffB); PG8_STAGE(PG8_SA(1, 0), cA + kstep, voffA); PG8_STAGE(PG8_SB(1, 1), cB + hstep + kstep, voffB);
        PG8_WAIT_V(6); PG8_BAR;
    } else {
        PG8_STAGE(PG8_SB(0, 0), cB, voffB); PG8_STAGE(PG8_SA(0, 0), cA, voffA); PG8_STAGE(PG8_SB(0, 1), cB + hstep, voffB); PG8_STAGE(PG8_SA(0, 1), cA + hstep, voffA);
        if (wr == 1) PG8_BAR;
        PG8_WAIT_V(4); PG8_BAR;
        PG8_STAGE(PG8_SB(1, 0), cB + kstep, voffB); PG8_STAGE(PG8_SA(1, 0), cA + kstep, voffA); PG8_STAGE(PG8_SB(1, 1), cB + hstep + kstep, voffB);
        PG8_WAIT_V(6); PG8_BAR;
    }
    for (;;) {
        const bool has_next = S.next(ui + 1, nxt);
        const char* nA = has_next ? S.a_ptr(nxt, g) : cA; const char* nB = has_next ? S.b_ptr(nxt, g) : cB;
        for (int t = 0; t < nt; t += 2) {
            const bool last = (t == nt - 2);
            const char* a1 = cA + (size_t)(t + 1) * kstep;
            const char* a2 = last ? nA : cA + (size_t)(t + 2) * kstep; const char* b2 = last ? nB : cB + (size_t)(t + 2) * kstep;
            const char* a3 = a2 + kstep; const char* b3 = b2 + kstep;
            if (last && has_next) S.a_ready(nxt);
            if constexpr (SP2) {
            PG8_LDB(B0, 0, 0); PG8_LDB(B1, 0, 1); PG8_SCHED; PG8_LDA(At, 0, 0); PG8_STAGE(PG8_SA(1, 1), a1 + hstep, voffA);
            PG8_WAIT_V(8); PG8_WAIT_L(0); PG8_BAR; PG8_MMA(0, 0, At, B0); PG8_MMA(0, 1, At, B1); PG8_BAR; PG8_SCHED;
            PG8_LDA(At, 0, 1); PG8_STAGE(PG8_SB(0, 0), b2, voffB); PG8_STAGE(PG8_SB(0, 1), b2 + hstep, voffB); PG8_STAGE(PG8_SA(0, 0), a2, voffA);
            PG8_WAIT_V(8); PG8_WAIT_L(0); PG8_BAR; PG8_MMA(1, 0, At, B0); PG8_MMA(1, 1, At, B1); PG8_BAR; PG8_SCHED;
            PG8_LDB(B0, 1, 0); PG8_LDB(B1, 1, 1); PG8_SCHED; PG8_LDA(At, 1, 0); PG8_STAGE(PG8_SA(0, 1), a2 + hstep, voffA);
            PG8_WAIT_V(8); PG8_WAIT_L(0); PG8_BAR; PG8_MMA(0, 0, At, B0); PG8_MMA(0, 1, At, B1); PG8_BAR; PG8_SCHED;
            PG8_LDA(At, 1, 1); PG8_STAGE(PG8_SB(1, 0), b3, voffB); PG8_STAGE(PG8_SB(1, 1), b3 + hstep, voffB); PG8_STAGE(PG8_SA(1, 0), a3, voffA);
            PG8_WAIT_V(8); PG8_WAIT_L(0); PG8_BAR; PG8_MMA(1, 0, At, B0); PG8_MMA(1, 1, At, B1); PG8_BAR; PG8_SCHED;
            } else {
            PG8_LDB(B0, 0, 0); PG8_SCHED; PG8_LDA(At, 0, 0); PG8_STAGE(PG8_SA(1, 1), a1 + hstep, voffA);
            PG8_WAIT_L(8); PG8_BAR; PG8_WAIT_L(0); PG8_MMA(0, 0, At, B0); PG8_BAR; PG8_SCHED;
            PG8_LDB(B1, 0, 1); PG8_STAGE(PG8_SB(0, 0), b2, voffB);
            PG8_BAR; PG8_WAIT_L(0); PG8_MMA(0, 1, At, B1); PG8_BAR;
            PG8_LDA(At, 0, 1); PG8_STAGE(PG8_SA(0, 0), a2, voffA);
            PG8_BAR; PG8_WAIT_L(0); PG8_MMA(1, 0, At, B0); PG8_BAR; PG8_SCHED;
            PG8_STAGE(PG8_SB(0, 1), b2 + hstep, voffB);
            PG8_WAIT_V(6); PG8_BAR; PG8_MMA(1, 1, At, B1); PG8_BAR;
            PG8_LDB(B0, 1, 0); PG8_SCHED; PG8_LDA(At, 1, 0); PG8_STAGE(PG8_SA(0, 1), a2 + hstep, voffA);
            PG8_WAIT_L(8); PG8_BAR; PG8_WAIT_L(0); PG8_MMA(0, 0, At, B0); PG8_BAR; PG8_SCHED;
            PG8_LDB(B1, 1, 1); PG8_STAGE(PG8_SB(1, 0), b3, voffB);
            PG8_BAR; PG8_WAIT_L(0); PG8_MMA(0, 1, At, B1); PG8_BAR;
            PG8_LDA(At, 1, 1); PG8_STAGE(PG8_SA(1, 0), a3, voffA);
            PG8_BAR; PG8_WAIT_L(0); PG8_MMA(1, 0, At, B0); PG8_BAR; PG8_SCHED;
            PG8_STAGE(PG8_SB(1, 1), b3 + hstep, voffB);
            PG8_WAIT_V(6); PG8_BAR; PG8_MMA(1, 1, At, B1); PG8_BAR;
            }
        }
        if constexpr (ALIGN_EPI) { if (wr == 0) PG8_BAR; }
        E(acc, cur, wr, wc, fr, fq); S.done(cur);
        if (!has_next) break;
#pragma unroll
        for (int a = 0; a < 2; ++a)
#pragma unroll
            for (int b = 0; b < 2; ++b)
#pragma unroll
                for (int m = 0; m < 4; ++m)
#pragma unroll
                    for (int n = 0; n < 2; ++n) acc[a][b][m][n] = (f32x4){0.f, 0.f, 0.f, 0.f};
        cur = nxt; cA = nA; cB = nB; ++ui;
        if constexpr (ALIGN_EPI) { if (wr == 1) PG8_BAR; }
    }
    PG8_WAIT_V(0);
    if constexpr (!ALIGN_EPI) { if (wr == 0) PG8_BAR; }
    PG8_BAR;
#undef PG8_SA
#undef PG8_SB
#undef PG8_STAGE
#undef PG8_LDA
#undef PG8_LDB
#undef PG8_MMA
#undef PG8_WAIT_V
#undef PG8_WAIT_L
#undef PG8_BAR
#undef PG8_SCHED
}
}

struct F_inproj {
    bf16* U; const float* ssq4;
    __device__ __forceinline__ float row(int m) const { return rstd_of(ssq4, m); }
    __device__ __forceinline__ void operator()(float rs, int m, int n, float v) const {
        const float u = v * rs; float o;
        if (n < C_LG) o = u; else if (n < C_GA) o = gelu_tanh(u); else o = sigmoidf_(u);
        U[(size_t)m * NIN + n] = f2bf(o);
    }
};
struct F_store {
    bf16* O; int ld, pad;
    __device__ __forceinline__ int row(int) const { return 0; }
    __device__ __forceinline__ void operator()(int, int m, int n, float v) const { O[(size_t)m * ld + n] = f2bf(v); }
};
struct F_merge1 {
    bf16* MB; const bf16* U;
    __device__ __forceinline__ int row(int) const { return 0; }
    __device__ __forceinline__ void operator()(int, int m, int n, float v) const { MB[(size_t)m * DM + n] = f2bf(bf2f(U[(size_t)m * NIN + C_GA + n]) * v); }
};
struct F_merge2 {
    bf16* MB; const bf16* U;
    __device__ __forceinline__ int row(int) const { return 0; }
    __device__ __forceinline__ void operator()(int, int m, int n, float v) const { const size_t i = (size_t)m * DM + n; MB[i] = f2bf(bf2f(MB[i]) + bf2f(U[(size_t)m * NIN + C_GB + n]) * v); }
};
struct F_resid {
    const float* base; float* out;
    __device__ __forceinline__ int row(int) const { return 0; }
    __device__ __forceinline__ void operator()(int, int m, int n, float v) const { const size_t i = (size_t)m * DM + n; out[i] = base[i] + v; }
};
struct F_swiglu {
    bf16* G; const float* ssq4;
    __device__ __forceinline__ float row(int m) const { return rstd_of(ssq4, m); }
    __device__ __forceinline__ void operator()(float rs, int m, int oc, float a, float b) const { const float x = a * rs; G[(size_t)m * DFF + oc] = f2bf(x * sigmoidf_(x) * (b * rs)); }
};
struct F_swiglu_moe {
    bf16* G; const float* srs; const float* sgw;
    __device__ __forceinline__ f32x2 row(int s) const { return (f32x2){srs[s], sgw[s]}; }
    __device__ __forceinline__ void operator()(f32x2 c, int s, int oc, float a, float b) const { const float x = a * c.x; G[(size_t)s * DFF + oc] = f2bf(x * sigmoidf_(x) * (b * c.x) * c.y); }
};
struct F_ple {
    float* h; const bf16* PP; const float* ssq4;
    __device__ __forceinline__ float row(int m) const { return rstd_of(ssq4, m); }
    __device__ __forceinline__ void operator()(float rs, int m, int n, float v) const { const size_t i = (size_t)m * DM + n; h[i] += sigmoidf_(v * rs) * bf2f(PP[i]); }
};

constexpr int GEMM_LDS = 131072;
template <class Epi, class Sched>
__global__ void __launch_bounds__(512, 2) k_gemm(pg8::Gemm g, Sched S0, Epi E) {
    extern __shared__ __attribute__((aligned(16))) unsigned char lds[];
    Sched S = S0; S.setup((int)gridDim.x, (int)blockIdx.x);
    pg8::gemm_phase<Epi, Sched, true, true>((LAS unsigned char*)lds, g, S, E);
}
template <class Epi, class Sched>
static void launch_gemm(hipStream_t st, const bf16* A, const bf16* Bt, int K, Sched S, Epi E) {
    static bool init = false;
    auto kern = k_gemm<Epi, Sched>;
    if (!init) { (void)hipFuncSetAttribute((const void*)kern, hipFuncAttributeMaxDynamicSharedMemorySize, GEMM_LDS); init = true; }
    pg8::Gemm g; g.A = A; g.Bt = Bt; g.K = K; g.pad = 0;
    hipLaunchKernelGGL(kern, dim3(256), dim3(512), GEMM_LDS, st, g, S, E);
}
static pg8::StaticOrder mk_static(int Mrows, int N) { pg8::StaticOrder s; s.init(Mrows, N, 256, 0); return s; }
static pg8::MoeOrder mk_moe(const int* meta, size_t wstride, int N) { pg8::MoeOrder s; memset(&s, 0, sizeof(s)); s.meta = meta; s.wstride = wstride; s.N = N; return s; }

struct CJob { const float* W; const float* gain; bf16* dst; int K, N, mode, pad; };
struct Ptrs { const float* in[30]; float* out; unsigned char* ws; };

__device__ __forceinline__ void conv_item(const CJob& jb, LAS float* scr, int item, int lane) {
    const int nblk = jb.N / 32, kb = item / nblk, nb = item % nblk, k0 = 64 * kb, n0 = 32 * nb;
#pragma unroll 8
    for (int i = 0; i < 32; ++i) { const int kk = 2 * i + (lane >> 5); float w = jb.W[(size_t)(k0 + kk) * jb.N + n0 + (lane & 31)]; if (jb.gain) w *= jb.gain[k0 + kk]; scr[kk * 33 + (lane & 31)] = w; }
    asm volatile("s_waitcnt lgkmcnt(0)" ::: "memory");
    const int c = lane & 7;
#pragma unroll
    for (int j = 0; j < 4; ++j) { const int n = (lane >> 3) + 8 * j; const LAS float* s = scr + (8 * c) * 33 + n;
        u32x4 o; o.x = pk2(s[0 * 33], s[1 * 33]); o.y = pk2(s[2 * 33], s[3 * 33]); o.z = pk2(s[4 * 33], s[5 * 33]); o.w = pk2(s[6 * 33], s[7 * 33]);
        const int nn = n0 + n; const int row = jb.mode == 0 ? nn : (8 * (nn >> 2) + (nn & 3) + (jb.mode == 2 ? 4 : 0));
        *(u32x4*)(jb.dst + (size_t)row * jb.K + k0 + 8 * c) = o; }
    asm volatile("s_waitcnt lgkmcnt(0)" ::: "memory");
}
__device__ __forceinline__ void conv_job(const CJob& jb, LAS float* scr, int gw, int ngw, int lane) {
    const int nit = (jb.K / 64) * (jb.N / 32);
    for (int it = gw; it < nit; it += ngw) conv_item(jb, scr, it, lane);
}
__device__ __forceinline__ CJob static_job(const Ptrs& P, int j) {
    CJob jb; jb.pad = 0; jb.gain = nullptr; jb.mode = 0;
    if (j < 24) { const int l = j / 6, k = j % 6;
        if (k == 0) { jb.W = P.in[3] + (size_t)l * DM * NIN; jb.gain = P.in[2] + l * DM; jb.dst = (bf16*)(P.ws + WS_WIN) + (size_t)l * NIN * DM; jb.K = DM; jb.N = NIN; }
        else if (k == 1) { jb.W = P.in[15] + (size_t)l * DM * DM; jb.dst = (bf16*)(P.ws + WS_WPA) + (size_t)l * DM * DM; jb.K = DM; jb.N = DM; }
        else if (k == 2) { jb.W = P.in[16] + (size_t)l * DM * DM; jb.dst = (bf16*)(P.ws + WS_WPB) + (size_t)l * DM * DM; jb.K = DM; jb.N = DM; }
        else if (k == 3) { jb.W = P.in[17] + (size_t)l * DM * DM; jb.dst = (bf16*)(P.ws + WS_WOUT) + (size_t)l * DM * DM; jb.K = DM; jb.N = DM; }
        else if (k == 4) { jb.W = P.in[28] + (size_t)l * DM * DM; jb.gain = P.in[27] + l * DM; jb.dst = (bf16*)(P.ws + WS_WPG) + (size_t)l * DM * DM; jb.K = DM; jb.N = DM; }
        else { jb.W = P.in[29] + (size_t)l * PLE * DM; jb.dst = (bf16*)(P.ws + WS_WPP) + (size_t)l * DM * PLE; jb.K = PLE; jb.N = DM; }
    } else { const int j2 = (j - 24) / 3, k = (j - 24) % 3;
        if (k < 2) { jb.W = P.in[19 + k] + (size_t)j2 * DM * DFF; jb.gain = P.in[18] + (2 * j2) * DM; jb.dst = (bf16*)(P.ws + WS_W13D) + (size_t)j2 * 2 * DFF * DM; jb.K = DM; jb.N = DFF; jb.mode = 1 + k; }
        else { jb.W = P.in[21] + (size_t)j2 * DFF * DM; jb.dst = (bf16*)(P.ws + WS_W2D) + (size_t)j2 * DM * DFF; jb.K = DFF; jb.N = DM; }
    }
    return jb;
}
__device__ __forceinline__ CJob moe_job(const Ptrs& P, int j2, int j) {
    CJob jb; jb.pad = 0; jb.gain = nullptr; jb.mode = 0; const int e = j / 3, k = j % 3;
    if (k < 2) { jb.W = P.in[24 + k] + ((size_t)j2 * NEXP + e) * DM * DFF; jb.gain = P.in[18] + (2 * j2 + 1) * DM; jb.dst = (bf16*)(P.ws + WS_W13E) + (size_t)e * 2 * DFF * DM; jb.K = DM; jb.N = DFF; jb.mode = 1 + k; }
    else { jb.W = P.in[26] + ((size_t)j2 * NEXP + e) * DFF * DM; jb.dst = (bf16*)(P.ws + WS_W2E) + (size_t)e * DM * DFF; jb.K = DFF; jb.N = DM; }
    return jb;
}
__device__ __forceinline__ void rowstats_row(const float* hrow, bf16* hbrow, float* ssq, int lane) {
    const f32x4* xr = (const f32x4*)hrow + lane; float s[4];
#pragma unroll
    for (int j = 0; j < 4; ++j) { const f32x4 v = xr[64 * j]; s[j] = (v.x * v.x + v.y * v.y) + (v.z * v.z + v.w * v.w);
        u32x2 o; o.x = pk2(v.x, v.y); o.y = pk2(v.z, v.w); *((u32x2*)hbrow + lane + 64 * j) = o; }
#pragma unroll
    for (int j = 0; j < 4; ++j) s[j] = wave_sum(s[j]);
    if (lane == 0) *(f32x4*)ssq = (f32x4){s[0], s[1], s[2], s[3]};
}
__global__ void __launch_bounds__(512, 2) k_prologue(Ptrs P) {
    extern __shared__ __attribute__((aligned(16))) unsigned char lds[];
    const int lane = threadIdx.x & 63, wave = threadIdx.x >> 6, gw = blockIdx.x * 8 + wave, ngw = gridDim.x * 8;
    LAS float* scr = (LAS float*)((LAS unsigned char*)lds + wave * 16384);
    for (int j = 0; j < 30; ++j) { const CJob jb = static_job(P, j); conv_job(jb, scr, gw, ngw, lane); }
    bf16* hb = (bf16*)(P.ws + WS_HB); float* ssq = (float*)(P.ws + WS_SSQ);
    for (int m = gw; m < M; m += ngw) rowstats_row(P.in[0] + (size_t)m * DM, hb + (size_t)m * DM, ssq + 4 * (size_t)m, lane);
}
__global__ void __launch_bounds__(512, 2) k_convmoe(Ptrs P, int j2) {
    extern __shared__ __attribute__((aligned(16))) unsigned char lds[];
    const int lane = threadIdx.x & 63, wave = threadIdx.x >> 6, gw = blockIdx.x * 8 + wave, ngw = gridDim.x * 8;
    LAS float* scr = (LAS float*)((LAS unsigned char*)lds + wave * 16384);
    for (int j = 0; j < 24; ++j) { const CJob jb = moe_job(P, j2, j); conv_job(jb, scr, gw, ngw, lane); }
}
__global__ void __launch_bounds__(256) k_convp(const float* p, bf16* pb) {
    const size_t i = (size_t)blockIdx.x * 256 + threadIdx.x; const f32x4 v = ((const f32x4*)p)[i]; u32x2 o; o.x = pk2(v.x, v.y); o.y = pk2(v.z, v.w); ((u32x2*)pb)[i] = o;
}
__global__ void __launch_bounds__(256) k_rowstats(const float* h, bf16* hb, float* ssq) {
    const int lane = threadIdx.x & 63, m = blockIdx.x * 4 + (threadIdx.x >> 6);
    rowstats_row(h + (size_t)m * DM, hb + (size_t)m * DM, ssq + 4 * (size_t)m, lane);
}

__device__ __forceinline__ int t5_bucket(int d) {
    if (d < 16) return d;
    int l = 16 + (int)(logf((float)d / 16.f) / logf(8.f) * 16.f);
    return l < 31 ? l : 31;
}
__global__ void __launch_bounds__(256) nv_headnorm(bf16* U, const float* qg, const float* kg) {
    const int idx = blockIdx.x * 256 + threadIdx.x; const int m = idx / 20, hh = idx % 20;
    const int col0 = hh < 16 ? hh * 64 : C_K + (hh - 16) * 64; const float* g = hh < 16 ? qg : kg; const float sc = hh < 16 ? QSCALE : 1.f;
    bf16* p = U + (size_t)m * NIN + col0; float x[64]; float ss = 0.f;
#pragma unroll
    for (int c = 0; c < 8; ++c) { const u32x4 w = *(const u32x4*)(p + 8 * c);
#pragma unroll
        for (int j = 0; j < 4; ++j) { x[8 * c + 2 * j] = bf2f((bf16)(w[j] & 0xffffu)); x[8 * c + 2 * j + 1] = bf2f((bf16)(w[j] >> 16)); } }
#pragma unroll
    for (int d = 0; d < 64; ++d) ss += x[d] * x[d];
    const float r = rsqrtf(ss * (1.f / 64.f) + EPS) * sc;
#pragma unroll
    for (int c = 0; c < 8; ++c) { u32x4 w;
#pragma unroll
        for (int j = 0; j < 4; ++j) w[j] = pk2(x[8 * c + 2 * j] * r * g[8 * c + 2 * j], x[8 * c + 2 * j + 1] * r * g[8 * c + 2 * j + 1]);
        *(u32x4*)(p + 8 * c) = w; }
}
__global__ void __launch_bounds__(256) nv_attn(const bf16* U, bf16* YA, const float* sinks, const float* rel_bias) {
    __shared__ float btab[128];
    const int h = blockIdx.x & 15, chunk = blockIdx.x >> 4;
    if (threadIdx.x < 128) btab[threadIdx.x] = rel_bias[t5_bucket((int)threadIdx.x) * 16 + h] * LOG2E;
    __syncthreads();
    const int m = chunk * 256 + threadIdx.x, t = m & (SEQ - 1), kvh = h >> 2;
    float q[64];
    { const bf16* qp = U + (size_t)m * NIN + h * 64;
#pragma unroll
      for (int c = 0; c < 8; ++c) { const u32x4 w = *(const u32x4*)(qp + 8 * c);
#pragma unroll
          for (int j = 0; j < 4; ++j) { q[8 * c + 2 * j] = bf2f((bf16)(w[j] & 0xffffu)); q[8 * c + 2 * j + 1] = bf2f((bf16)(w[j] >> 16)); } } }
    float mx = sinks[h] * LOG2E, l = 1.f; float acc[64];
#pragma unroll
    for (int d = 0; d < 64; ++d) acc[d] = 0.f;
    const int dmax = t < 127 ? t : 127;
    for (int dist = 0; dist <= dmax; ++dist) {
        const bf16* kp = U + (size_t)(m - dist) * NIN + C_K + kvh * 64; const bf16* vp = kp + (C_V - C_K);
        float s = btab[dist];
#pragma unroll
        for (int c = 0; c < 8; ++c) { const u32x4 w = *(const u32x4*)(kp + 8 * c);
#pragma unroll
            for (int j = 0; j < 4; ++j) s += q[8 * c + 2 * j] * bf2f((bf16)(w[j] & 0xffffu)) + q[8 * c + 2 * j + 1] * bf2f((bf16)(w[j] >> 16)); }
        const float mn = fmaxf(mx, s), sc = exp2f(mx - mn), pr = exp2f(s - mn); l = l * sc + pr; mx = mn;
#pragma unroll
        for (int c = 0; c < 8; ++c) { const u32x4 w = *(const u32x4*)(vp + 8 * c);
#pragma unroll
            for (int j = 0; j < 4; ++j) { acc[8 * c + 2 * j] = acc[8 * c + 2 * j] * sc + pr * bf2f((bf16)(w[j] & 0xffffu)); acc[8 * c + 2 * j + 1] = acc[8 * c + 2 * j + 1] * sc + pr * bf2f((bf16)(w[j] >> 16)); } }
    }
    const float il = 1.f / l; bf16* op = YA + (size_t)m * DM + h * 64;
#pragma unroll
    for (int c = 0; c < 8; ++c) { u32x4 w;
#pragma unroll
        for (int j = 0; j < 4; ++j) w[j] = pk2(acc[8 * c + 2 * j] * il, acc[8 * c + 2 * j + 1] * il);
        *(u32x4*)(op + 8 * c) = w; }
}
__global__ void __launch_bounds__(256) nv_lru_gates(const bf16* U, float* NA, float* NU, const float* conv_w, const float* conv_b, const float* w_rg, const float* b_rg,
                                                    const float* w_ig, const float* b_ig, const float* lam, int b0) {
    __shared__ float xcs[4][64];
    const int nb = blockIdx.x & 15, mg = blockIdx.x >> 4, tl = threadIdx.x >> 6, d = threadIdx.x & 63;
    const int ml = mg * 4 + tl, m = b0 * SEQ + ml, t = m & (SEQ - 1), ch = nb * 64 + d;
    float xc = conv_b[ch];
#pragma unroll
    for (int j = 0; j < 4; ++j) { const int tt = t - 3 + j; if (tt >= 0) xc += conv_w[j * DM + ch] * bf2f(U[(size_t)(m - 3 + j) * NIN + C_LX + ch]); }
    xcs[tl][d] = xc; __syncthreads();
    float r = b_rg[ch], ig = b_ig[ch];
    for (int c = 0; c < 64; ++c) { const float x = xcs[tl][c]; r += x * w_rg[(size_t)(nb * 64 + c) * 64 + d]; ig += x * w_ig[(size_t)(nb * 64 + c) * 64 + d]; }
    r = 1.f / (1.f + expf(-r)); ig = 1.f / (1.f + expf(-ig));
    const float sp = log1pf(expf(-lam[ch])), log_a = -8.f * r * sp;
    NA[(size_t)ml * DM + ch] = expf(log_a); NU[(size_t)ml * DM + ch] = sqrtf(-expm1f(2.f * log_a)) * (ig * xc);
}
__global__ void __launch_bounds__(64) nv_lru_scan(const float* NA, const float* NU, const bf16* U, bf16* YB, int b0) {
    const int idx = blockIdx.x * 64 + threadIdx.x, bl = idx >> 10, ch = idx & 1023; float h = 0.f;
#pragma unroll 8
    for (int t = 0; t < SEQ; ++t) { const size_t ml = (size_t)bl * SEQ + t, m = (size_t)(b0 + bl) * SEQ + t;
        h = NA[ml * DM + ch] * h + NU[ml * DM + ch]; YB[m * DM + ch] = f2bf(h * bf2f(U[m * NIN + C_LG + ch])); }
}
__global__ void __launch_bounds__(256) nv_router(const float* h, const float* ssq4, const float* gain, const float* rw, const float* rb, int* sel, float* selw) {
    const int lane = threadIdx.x & 63, m = blockIdx.x * 4 + (threadIdx.x >> 6); float acc[8];
#pragma unroll
    for (int e = 0; e < 8; ++e) acc[e] = 0.f;
    for (int j = 0; j < 16; ++j) { const int k = lane + 64 * j; const float x = h[(size_t)m * DM + k] * gain[k]; const f32x4 w0 = *(const f32x4*)(rw + 8 * k), w1 = *(const f32x4*)(rw + 8 * k + 4);
        acc[0] += x * w0.x; acc[1] += x * w0.y; acc[2] += x * w0.z; acc[3] += x * w0.w; acc[4] += x * w1.x; acc[5] += x * w1.y; acc[6] += x * w1.z; acc[7] += x * w1.w; }
    const float rs = rstd_of(ssq4, m);
#pragma unroll
    for (int e = 0; e < 8; ++e) acc[e] = wave_sum(acc[e]) * rs + rb[e];
    int i1 = 0; float v1 = acc[0];
#pragma unroll
    for (int e = 1; e < 8; ++e) if (acc[e] > v1) { v1 = acc[e]; i1 = e; }
    int i2 = -1; float v2 = -3.0e38f;
#pragma unroll
    for (int e = 0; e < 8; ++e) if (e != i1 && acc[e] > v2) { v2 = acc[e]; i2 = e; }
    const float ex = __expf(v2 - v1), w1 = 1.f / (1.f + ex), w2 = ex / (1.f + ex);
    if (lane == 0) { sel[2 * m] = i1; sel[2 * m + 1] = i2; selw[2 * m] = w1; selw[2 * m + 1] = w2; }
}
__global__ void __launch_bounds__(1024) nv_slots(const int* sel, const float* selw, const float* ssq4, int* tok, float* srs, float* sgw, int* tslot, int* meta) {
    __shared__ int c[8][1024]; __shared__ int start[9]; __shared__ int tot[8];
    const int t = threadIdx.x;
#pragma unroll
    for (int e = 0; e < 8; ++e) c[e][t] = 0;
    for (int i = 0; i < 32; ++i) { const int m = 32 * t + i; c[sel[2 * m]][t]++; c[sel[2 * m + 1]][t]++; }
    __syncthreads();
    if (t < 8) { int run = 0; for (int j = 0; j < 1024; ++j) { const int v = c[t][j]; c[t][j] = run; run += v; } tot[t] = run; }
    __syncthreads();
    if (t == 0) { int s = 0; for (int e = 0; e < 8; ++e) { start[e] = s; s += ((tot[e] + 255) / 256) * 256; } start[8] = s; for (int e = 0; e < 9; ++e) meta[e] = start[e] / 256; }
    __syncthreads();
    for (int i = 0; i < 32; ++i) { const int m = 32 * t + i; const float rs = rstd_of(ssq4, m);
        for (int k = 0; k < 2; ++k) { const int e = sel[2 * m + k]; const int pos = start[e] + c[e][t]++; tok[pos] = m; srs[pos] = rs; sgw[pos] = selw[2 * m + k]; tslot[2 * m + k] = pos; } }
    for (int e = 0; e < 8; ++e) for (int s = start[e] + tot[e] + t; s < start[e + 1]; s += 1024) { tok[s] = 0; srs[s] = 0.f; sgw[s] = 0.f; }
}
__global__ void __launch_bounds__(256) nv_gather(const bf16* hb, const int* tok, const int* meta, bf16* XG) {
    const int lane = threadIdx.x & 63, s = blockIdx.x * 4 + (threadIdx.x >> 6); if (s >= meta[8] * 256) return;
    const u32x4* src = (const u32x4*)(hb + (size_t)tok[s] * DM); u32x4* dst = (u32x4*)(XG + (size_t)s * DM);
    dst[lane] = src[lane]; dst[lane + 64] = src[lane + 64];
}
__global__ void __launch_bounds__(256) nv_combine(float* h, const bf16* O, const int* tslot) {
    const int idx = blockIdx.x * 256 + threadIdx.x, m = idx >> 8, n = (idx & 255) * 4; const int s1 = tslot[2 * m], s2 = tslot[2 * m + 1];
    const u32x2 a = *(const u32x2*)(O + (size_t)s1 * DM + n), b = *(const u32x2*)(O + (size_t)s2 * DM + n); f32x4* hp = (f32x4*)(h + (size_t)m * DM + n); f32x4 v = *hp;
    v.x += bf2f((bf16)(a.x & 0xffffu)) + bf2f((bf16)(b.x & 0xffffu)); v.y += bf2f((bf16)(a.x >> 16)) + bf2f((bf16)(b.x >> 16));
    v.z += bf2f((bf16)(a.y & 0xffffu)) + bf2f((bf16)(b.y & 0xffffu)); v.w += bf2f((bf16)(a.y >> 16)) + bf2f((bf16)(b.y >> 16)); *hp = v;
}

extern "C" void kernel_launch(void* const* d_in, const int* in_sizes, int n_in, void* d_out, int out_size, void* d_ws, size_t ws_size, hipStream_t stream) {
    static int ok = 0;
    if (ok == 0) {
        if (n_in != 30 || in_sizes[0] != M * DM || out_size != M * DM || ws_size < WS_END) { fprintf(stderr, "kernel_launch: unexpected shapes (n_in %d, ws %zu < %zu)\n", n_in, ws_size, (size_t)WS_END); ok = -1; return; }
        (void)hipFuncSetAttribute((const void*)k_prologue, hipFuncAttributeMaxDynamicSharedMemorySize, GEMM_LDS);
        (void)hipFuncSetAttribute((const void*)k_convmoe, hipFuncAttributeMaxDynamicSharedMemorySize, GEMM_LDS);
        ok = 1;
    }
    if (ok < 0) return;
    unsigned char* ws = (unsigned char*)d_ws; float* out = (float*)d_out;
    Ptrs P; memset(&P, 0, sizeof(P)); for (int i = 0; i < 30; ++i) P.in[i] = (const float*)d_in[i]; P.out = out; P.ws = ws;
    const float* const* in = P.in;
    (void)hipMemsetAsync(ws + WS_CTL, 0, 1 * MiB, stream);
    bf16* HB = (bf16*)(ws + WS_HB); float* SSQ = (float*)(ws + WS_SSQ); bf16* PB = (bf16*)(ws + WS_PB); bf16* PP = (bf16*)(ws + WS_PP);
    bf16* U = (bf16*)(ws + WS_R + R_U); bf16* YA = (bf16*)(ws + WS_R + R_YA); bf16* YB = (bf16*)(ws + WS_R + R_YB); bf16* MB = (bf16*)(ws + WS_R + R_MB);
    float* NA = (float*)(ws + WS_R + R_NA); float* NU = (float*)(ws + WS_R + R_NU);
    bf16* G = (bf16*)(ws + WS_R + R_G); bf16* XG = (bf16*)(ws + WS_R + R_XG); bf16* GM = (bf16*)(ws + WS_R + R_GM);
    int* SEL = (int*)(ws + WS_SEL); float* SELW = (float*)(ws + WS_SEL + 256 * 1024); int* TSLOT = (int*)(ws + WS_SEL + 512 * 1024);
    int* TOK = (int*)(ws + WS_SLOT); float* SRS = (float*)(ws + WS_SLOT + 320 * 1024); float* SGW = (float*)(ws + WS_SLOT + 640 * 1024); int* META = (int*)(ws + WS_SLOT + 960 * 1024);

    hipLaunchKernelGGL(k_prologue, dim3(256), dim3(512), GEMM_LDS, stream, P);
    for (int l = 0; l < DEPTH; ++l) {
        hipLaunchKernelGGL(k_convp, dim3(M * PLE / 4 / 256), dim3(256), 0, stream, in[1] + (size_t)l * M * PLE, PB);
        if (l & 1) hipLaunchKernelGGL(k_convmoe, dim3(256), dim3(512), GEMM_LDS, stream, P, l / 2);
        { pg8::EpiElem<F_inproj> E{{U, SSQ}}; launch_gemm(stream, HB, (const bf16*)(ws + WS_WIN) + (size_t)l * NIN * DM, DM, mk_static(M, NIN), E); }
        { pg8::EpiElem<F_store> E{{PP, DM, 0}}; launch_gemm(stream, PB, (const bf16*)(ws + WS_WPP) + (size_t)l * DM * PLE, PLE, mk_static(M, DM), E); }
        hipLaunchKernelGGL(nv_headnorm, dim3(M * 20 / 256), dim3(256), 0, stream, U, in[4] + l * 64, in[5] + l * 64);
        hipLaunchKernelGGL(nv_attn, dim3((M / 256) * 16), dim3(256), 0, stream, (const bf16*)U, YA, in[6] + l * 16, in[7]);
        for (int b0 = 0; b0 < BATCH; b0 += 2) {
            hipLaunchKernelGGL(nv_lru_gates, dim3((2 * SEQ / 4) * 16), dim3(256), 0, stream, (const bf16*)U, NA, NU, in[8] + l * 4 * DM, in[9] + l * DM, in[10] + (size_t)l * 16 * 64 * 64, in[11] + l * DM,
                               in[12] + (size_t)l * 16 * 64 * 64, in[13] + l * DM, in[14] + l * DM, b0);
            hipLaunchKernelGGL(nv_lru_scan, dim3(2 * DM / 64), dim3(64), 0, stream, (const float*)NA, (const float*)NU, (const bf16*)U, YB, b0);
        }
        { pg8::EpiElem<F_merge1> E{{MB, U}}; launch_gemm(stream, YA, (const bf16*)(ws + WS_WPA) + (size_t)l * DM * DM, DM, mk_static(M, DM), E); }
        { pg8::EpiElem<F_merge2> E{{MB, U}}; launch_gemm(stream, YB, (const bf16*)(ws + WS_WPB) + (size_t)l * DM * DM, DM, mk_static(M, DM), E); }
        { pg8::EpiElem<F_resid> E{{l == 0 ? in[0] : (const float*)out, out}}; launch_gemm(stream, MB, (const bf16*)(ws + WS_WOUT) + (size_t)l * DM * DM, DM, mk_static(M, DM), E); }
        hipLaunchKernelGGL(k_rowstats, dim3(M / 4), dim3(256), 0, stream, (const float*)out, HB, SSQ);
        if (!(l & 1)) {
            { pg8::EpiPair<F_swiglu> E{{G, SSQ}}; launch_gemm(stream, HB, (const bf16*)(ws + WS_W13D) + (size_t)(l / 2) * 2 * DFF * DM, DM, mk_static(M, 2 * DFF), E); }
            { pg8::EpiElem<F_resid> E{{(const float*)out, out}}; launch_gemm(stream, G, (const bf16*)(ws + WS_W2D) + (size_t)(l / 2) * DM * DFF, DFF, mk_static(M, DM), E); }
        } else {
            hipLaunchKernelGGL(nv_router, dim3(M / 4), dim3(256), 0, stream, (const float*)out, (const float*)SSQ, in[18] + l * DM, in[22] + (size_t)(l / 2) * DM * NEXP, in[23] + (l / 2) * NEXP, SEL, SELW);
            hipLaunchKernelGGL(nv_slots, dim3(1), dim3(1024), 0, stream, (const int*)SEL, (const float*)SELW, (const float*)SSQ, TOK, SRS, SGW, TSLOT, META);
            hipLaunchKernelGGL(nv_gather, dim3(NSLOT / 4), dim3(256), 0, stream, (const bf16*)HB, (const int*)TOK, (const int*)META, XG);
            { pg8::EpiPair<F_swiglu_moe> E{{GM, SRS, SGW}}; launch_gemm(stream, XG, (const bf16*)(ws + WS_W13E), DM, mk_moe(META, (size_t)2 * DFF * DM, 2 * DFF), E); }
            { pg8::EpiElem<F_store> E{{XG, DM, 0}}; launch_gemm(stream, GM, (const bf16*)(ws + WS_W2E), DFF, mk_moe(META, (size_t)DM * DFF, DM), E); }
            hipLaunchKernelGGL(nv_combine, dim3(M * DM / 4 / 256), dim3(256), 0, stream, out, (const bf16*)XG, (const int*)TSLOT);
        }
        hipLaunchKernelGGL(k_rowstats, dim3(M / 4), dim3(256), 0, stream, (const float*)out, HB, SSQ);
        { pg8::EpiElem<F_ple> E{{out, PP, SSQ}}; launch_gemm(stream, HB, (const bf16*)(ws + WS_WPG) + (size_t)l * DM * DM, DM, mk_static(M, DM), E); }
        if (l + 1 < DEPTH) hipLaunchKernelGGL(k_rowstats, dim3(M / 4), dim3(256), 0, stream, (const float*)out, HB, SSQ);
    }
}
```

```cpp
#include <hip/hip_runtime.h>
#include <cstdio>
#include <cstdint>
#include <cstring>

#define LAS __attribute__((address_space(3)))
#define GAS __attribute__((address_space(1)))
typedef unsigned short bf16;
typedef short bf16x8 __attribute__((ext_vector_type(8)));
typedef float f32x4 __attribute__((ext_vector_type(4)));
typedef float f32x2 __attribute__((ext_vector_type(2)));
typedef unsigned u32x4 __attribute__((ext_vector_type(4)));
typedef unsigned u32x2 __attribute__((ext_vector_type(2)));

constexpr int BATCH = 8, SEQ = 4096, DM = 1024, DEPTH = 4, M = BATCH * SEQ;
constexpr int NIN = 5632, C_Q = 0, C_K = 1024, C_V = 1280, C_LX = 1536, C_LG = 2560, C_GA = 3584, C_GB = 4608;
constexpr int DFF = 3584, NEXP = 8, PLE = 256;
constexpr int NSLOT = 67584;
constexpr float EPS = 1e-6f, LOG2E = 1.4426950408889634f, QSCALE = 0.125f * LOG2E;

constexpr size_t MiB = 1u << 20;
constexpr size_t WS_CTL = 0;
constexpr size_t WS_WIN = 1 * MiB;
constexpr size_t WS_WPA = 45 * MiB, WS_WPB = 53 * MiB, WS_WOUT = 61 * MiB, WS_WPG = 69 * MiB;
constexpr size_t WS_WPP = 77 * MiB;
constexpr size_t WS_W13D = 79 * MiB;
constexpr size_t WS_W2D = 107 * MiB;
constexpr size_t WS_LRUW = 121 * MiB;
constexpr size_t WS_W13E = 122 * MiB;
constexpr size_t WS_W2E = 234 * MiB;
constexpr size_t WS_PB = 290 * MiB;
constexpr size_t WS_HB = 306 * MiB;
constexpr size_t WS_SSQ = 370 * MiB;
constexpr size_t WS_SEL = 374 * MiB;
constexpr size_t WS_SLOT = 375 * MiB;
constexpr size_t WS_PP = 376 * MiB;
constexpr size_t WS_HB2 = 440 * MiB;
constexpr size_t WS_R = 504 * MiB;
constexpr size_t R_U = 0, R_YA = 352 * MiB, R_YB = 416 * MiB, R_MB = 480 * MiB, R_NA = 544 * MiB, R_NU = 576 * MiB;
constexpr size_t R_G = 0;
constexpr size_t R_XG = 0, R_GM = 132 * MiB;
constexpr size_t WS_END = WS_R + 608 * MiB;

__host__ __device__ __forceinline__ float bf2f(bf16 x) { return __builtin_bit_cast(float, (unsigned)x << 16); }
__host__ __device__ __forceinline__ bf16 f2bf(float f) { unsigned u = __builtin_bit_cast(unsigned, f); return (bf16)((u + 0x7fffu + ((u >> 16) & 1u)) >> 16); }
__device__ __forceinline__ unsigned pk2(float lo, float hi) { return (unsigned)f2bf(lo) | ((unsigned)f2bf(hi) << 16); }
__device__ __forceinline__ float sigmoidf_(float x) { return 1.f / (1.f + __expf(-x)); }
__device__ __forceinline__ float gelu_tanh(float x) { const float z = 0.7978845608028654f * (x + 0.044715f * x * x * x); return x / (1.f + __expf(-2.f * z)); }
__device__ __forceinline__ float wave_sum(float v) {
#pragma unroll
    for (int o = 1; o < 64; o <<= 1) v += __shfl_xor(v, o);
    return v;
}
__device__ __forceinline__ float rstd_of(const float* ssq, int m) {
    const f32x4* p = (const f32x4*)(ssq + 16 * (size_t)m); const f32x4 a = p[0], b = p[1], c = p[2], d = p[3];
    const float s = (((a.x + a.y) + (a.z + a.w)) + ((b.x + b.y) + (b.z + b.w))) + (((c.x + c.y) + (c.z + c.w)) + ((d.x + d.y) + (d.z + d.w)));
    return rsqrtf(s * (1.f / 1024.f) + EPS);
}
__device__ __forceinline__ unsigned cvt_pk_bf16(float lo, float hi) { unsigned r; asm volatile("v_cvt_pk_bf16_f32 %0, %1, %2" : "=v"(r) : "v"(lo), "v"(hi)); return r; }
__device__ __forceinline__ float fast_sigmoid(float x) { return __builtin_amdgcn_rcpf(1.f + __builtin_amdgcn_exp2f(-LOG2E * x)); }
__device__ __forceinline__ float fast_gelu_tanh(float x) { const float z = (2.f * 0.7978845608028654f * LOG2E) * (x + 0.044715f * x * x * x); return x * __builtin_amdgcn_rcpf(1.f + __builtin_amdgcn_exp2f(-z)); }
__device__ __forceinline__ f32x4 unpack_lo(u32x2 w) { return (f32x4){__builtin_bit_cast(float, w.x << 16), __builtin_bit_cast(float, w.x & 0xffff0000u), __builtin_bit_cast(float, w.y << 16), __builtin_bit_cast(float, w.y & 0xffff0000u)}; }

namespace pg8 {
typedef unsigned short bf16_t;
constexpr int BM = 256, BK = 64, HALF = 128, HTB = HALF * BK * 2, STAGE_BYTES = 8 * HTB, NXCD = 8, WGM = 8;
__host__ __device__ __forceinline__ int lds_byte(int r, int c) { const int st = (r >> 4) * 2 + (c >> 5), rr = r & 15, cc = c & 31, ob = rr * 64 + cc * 2; return st * 1024 + (ob ^ (((ob >> 9) & 1) << 5)); }
__host__ __device__ __forceinline__ void stage_rc(int b, int& R, int& C) { const int st = b / 1024, sb = b % 1024, swz = sb ^ (((sb >> 9) & 1) << 5); R = (st >> 1) * 16 + swz / 64; C = (st & 1) * 32 + (swz % 64) / 2; }
__host__ __device__ __forceinline__ int perm32(int rho) { const int n = rho >> 4, i = rho & 15; return 8 * (i >> 2) + 4 * n + (i & 3); }

struct Unit { int pm, pn, part; };
struct Gemm { const bf16_t* A; const bf16_t* Bt; int K; int pad; };

struct StaticOrder {
    int nM, nN, nwg, G, c, pad;
    __host__ __device__ void init(int M_, int N_, int G_, int c_) { nM = M_ / BM; nN = N_ / BM; nwg = nM * nN; G = G_; c = c_; pad = 0; }
    __device__ __forceinline__ void setup(int G_, int c_) { G = G_; c = c_; }
    __host__ __device__ bool next(int i, Unit& u) const {
        const long L = (long)i * G + c; if (L >= nwg) return false;
        int wgid = (int)L; { const int q = nwg / NXCD, r = nwg % NXCD, xcd = wgid % NXCD, off = wgid / NXCD; wgid = (xcd < r ? xcd * (q + 1) : r * (q + 1) + (xcd - r) * q) + off; }
        const int nig = WGM * nN, gid = wgid / nig, fm = gid * WGM, gsz = (nM - fm) < WGM ? (nM - fm) : WGM;
        u.pm = fm + ((wgid % nig) % gsz); u.pn = (wgid % nig) / gsz; u.part = 0; return true;
    }
    __device__ __forceinline__ const char* a_ptr(const Unit& u, const Gemm& g) const { return (const char*)g.A + (size_t)u.pm * (size_t)(BM * 2) * g.K; }
    __device__ __forceinline__ const char* b_ptr(const Unit& u, const Gemm& g) const { return (const char*)g.Bt + (size_t)u.pn * (size_t)(BM * 2) * g.K; }
    __device__ __forceinline__ void a_ready(const Unit&) const {}
    __device__ __forceinline__ void done(const Unit&) const {}
};
struct MoeOrder {
    const int* meta; size_t wstride; int N, pad0;
    StaticOrder so; int ts[10];
    __device__ __forceinline__ void setup(int G_, int c_) {
#pragma unroll
        for (int e = 0; e < 9; ++e) ts[e] = __builtin_amdgcn_readfirstlane(__hip_atomic_load(meta + e, __ATOMIC_RELAXED, __HIP_MEMORY_SCOPE_AGENT));
        so.init(ts[8] * BM, N, G_, c_);
    }
    __device__ __forceinline__ bool next(int i, Unit& u) const { return so.next(i, u); }
    __device__ __forceinline__ const char* a_ptr(const Unit& u, const Gemm& g) const { return (const char*)g.A + (size_t)u.pm * (size_t)(BM * 2) * g.K; }
    __device__ __forceinline__ const char* b_ptr(const Unit& u, const Gemm& g) const {
        int e = 0;
#pragma unroll
        for (int j = 1; j < 8; ++j) e += (u.pm >= ts[j]) ? 1 : 0;
        return (const char*)(g.Bt + (size_t)e * wstride) + (size_t)u.pn * (size_t)(BM * 2) * g.K;
    }
    __device__ __forceinline__ void a_ready(const Unit&) const {}
    __device__ __forceinline__ void done(const Unit&) const {}
};

template <class F> struct EpiElem {
    static constexpr bool PERM = false, AFTER_DRAIN = false;
    F f;
    __device__ __forceinline__ bool reset(const Unit&) const { return true; }
    __device__ __forceinline__ void operator()(const f32x4 (&acc)[2][2][4][2], const Unit& u, int wr, int wc, int fr, int fq) const {
#pragma unroll
        for (int ai = 0; ai < 2; ++ai)
#pragma unroll
            for (int m = 0; m < 4; ++m) {
                const int row = u.pm * BM + ai * HALF + wr * 64 + m * 16 + fr; const auto ctx = f.row(row);
#pragma unroll
                for (int bj = 0; bj < 2; ++bj)
#pragma unroll
                    for (int n = 0; n < 2; ++n) { const int c0 = u.pn * BM + bj * HALF + wc * 32 + n * 16 + 4 * fq;
#pragma unroll
                        for (int e = 0; e < 4; ++e) f(ctx, row, c0 + e, acc[ai][bj][m][n][e]); }
            }
    }
};
template <class F> struct EpiPair {
    static constexpr bool PERM = true, AFTER_DRAIN = false;
    F f;
    __device__ __forceinline__ bool reset(const Unit&) const { return true; }
    __device__ __forceinline__ void operator()(const f32x4 (&acc)[2][2][4][2], const Unit& u, int wr, int wc, int fr, int fq) const {
#pragma unroll
        for (int ai = 0; ai < 2; ++ai)
#pragma unroll
            for (int m = 0; m < 4; ++m) {
                const int row = u.pm * BM + ai * HALF + wr * 64 + m * 16 + fr; const auto ctx = f.row(row);
#pragma unroll
                for (int bj = 0; bj < 2; ++bj) { const int c0 = u.pn * BM + bj * HALF + wc * 32 + 8 * fq, oc0 = c0 >> 1;
#pragma unroll
                    for (int e = 0; e < 4; ++e) f(ctx, row, oc0 + e, acc[ai][bj][m][0][e], acc[ai][bj][m][1][e]); }
            }
    }
};

#define EPI_ROWS(ai, m) (u.pm * BM + (ai) * HALF + wr * 64 + (m) * 16 + fr)
__device__ __forceinline__ u32x4 pack8(const f32x4 a, const f32x4 b) { u32x4 w; w.x = cvt_pk_bf16(a[0], a[1]); w.y = cvt_pk_bf16(a[2], a[3]); w.z = cvt_pk_bf16(b[0], b[1]); w.w = cvt_pk_bf16(b[2], b[3]); return w; }
__device__ __forceinline__ void unpack8(const u32x4 w, f32x4& a, f32x4& b) {
    a = (f32x4){__builtin_bit_cast(float, w.x << 16), __builtin_bit_cast(float, w.x & 0xffff0000u), __builtin_bit_cast(float, w.y << 16), __builtin_bit_cast(float, w.y & 0xffff0000u)};
    b = (f32x4){__builtin_bit_cast(float, w.z << 16), __builtin_bit_cast(float, w.z & 0xffff0000u), __builtin_bit_cast(float, w.w << 16), __builtin_bit_cast(float, w.w & 0xffff0000u)}; }
struct EpiInproj {
    static constexpr bool PERM = true, AFTER_DRAIN = false;
    bf16* U; const float* ssq; const float* qg; const float* kg;
    __device__ __forceinline__ bool reset(const Unit&) const { return true; }
    __device__ __forceinline__ void operator()(const f32x4 (&acc)[2][2][4][2], const Unit& u, int wr, int wc, int fr, int fq) const {
        const int pn = u.pn, type = pn < 4 ? 0 : pn == 4 ? 1 : pn < 10 ? 2 : pn < 14 ? 3 : 4;
        f32x4 g[2][2];
        if (type <= 1) { const float* gp = (type == 0 ? qg : kg) + 8 * fq; const float sc = type == 0 ? QSCALE : 1.f;
#pragma unroll
            for (int bj = 0; bj < 2; ++bj)
#pragma unroll
                for (int n = 0; n < 2; ++n) g[bj][n] = *(const f32x4*)(gp + 32 * bj + 4 * n) * sc; }
#pragma unroll
        for (int ai = 0; ai < 2; ++ai)
#pragma unroll
            for (int m = 0; m < 4; ++m) { const int row = EPI_ROWS(ai, m); const float rs = rstd_of(ssq, row); f32x4 v[2][2];
#pragma unroll
                for (int bj = 0; bj < 2; ++bj)
#pragma unroll
                    for (int n = 0; n < 2; ++n) v[bj][n] = acc[ai][bj][m][n] * rs;
                if (type <= 1) { float ss = 0.f;
#pragma unroll
                    for (int bj = 0; bj < 2; ++bj)
#pragma unroll
                        for (int n = 0; n < 2; ++n) ss += (v[bj][n][0] * v[bj][n][0] + v[bj][n][1] * v[bj][n][1]) + (v[bj][n][2] * v[bj][n][2] + v[bj][n][3] * v[bj][n][3]);
                    ss += __shfl_xor(ss, 16); ss += __shfl_xor(ss, 32);
                    const float r = rsqrtf(ss * (1.f / 64.f) + EPS);
#pragma unroll
                    for (int bj = 0; bj < 2; ++bj)
#pragma unroll
                        for (int n = 0; n < 2; ++n) v[bj][n] = v[bj][n] * r * g[bj][n];
                } else if (type == 3) {
#pragma unroll
                    for (int bj = 0; bj < 2; ++bj)
#pragma unroll
                        for (int n = 0; n < 2; ++n)
#pragma unroll
                            for (int e = 0; e < 4; ++e) v[bj][n][e] = fast_gelu_tanh(v[bj][n][e]);
                } else if (type == 4) {
#pragma unroll
                    for (int bj = 0; bj < 2; ++bj)
#pragma unroll
                        for (int n = 0; n < 2; ++n)
#pragma unroll
                            for (int e = 0; e < 4; ++e) v[bj][n][e] = fast_sigmoid(v[bj][n][e]);
                }
                bf16* rowp = U + (size_t)row * NIN + pn * BM + 64 * wc + 8 * fq;
#pragma unroll
                for (int bj = 0; bj < 2; ++bj) *(u32x4*)(rowp + 32 * bj) = pack8(v[bj][0], v[bj][1]);
            }
    }
};
struct EpiStore16 {
    static constexpr bool PERM = true, AFTER_DRAIN = false;
    bf16* O; int ld, pad;
    __device__ __forceinline__ bool reset(const Unit&) const { return true; }
    __device__ __forceinline__ void operator()(const f32x4 (&acc)[2][2][4][2], const Unit& u, int wr, int wc, int fr, int fq) const {
#pragma unroll
        for (int ai = 0; ai < 2; ++ai)
#pragma unroll
            for (int m = 0; m < 4; ++m) { bf16* rowp = O + (size_t)EPI_ROWS(ai, m) * ld + u.pn * BM + wc * 32 + 8 * fq;
#pragma unroll
                for (int bj = 0; bj < 2; ++bj) *(u32x4*)(rowp + bj * HALF) = pack8(acc[ai][bj][m][0], acc[ai][bj][m][1]); }
    }
};
struct EpiMerge {
    static constexpr bool PERM = true, AFTER_DRAIN = false;
    bf16* MB; const bf16* U;
    __device__ __forceinline__ bool reset(const Unit& u) const { return u.part != 0; }
    __device__ __forceinline__ void operator()(f32x4 (&acc)[2][2][4][2], const Unit& u, int wr, int wc, int fr, int fq) const {
#pragma unroll
        for (int ai = 0; ai < 2; ++ai)
#pragma unroll
            for (int m = 0; m < 4; ++m) { const int row = EPI_ROWS(ai, m);
#pragma unroll
                for (int bj = 0; bj < 2; ++bj) { const int col = u.pn * BM + bj * HALF + wc * 32 + 8 * fq;
                    f32x4 b0, b1; unpack8(*(const u32x4*)(U + (size_t)row * NIN + C_GB + col), b0, b1);
                    if (u.part == 0) { f32x4 a0, a1; unpack8(*(const u32x4*)(U + (size_t)row * NIN + C_GA + col), a0, a1);
#pragma unroll
                        for (int e = 0; e < 4; ++e) { acc[ai][bj][m][0][e] *= a0[e] * __builtin_amdgcn_rcpf(b0[e]); acc[ai][bj][m][1][e] *= a1[e] * __builtin_amdgcn_rcpf(b1[e]); }
                    } else *(u32x4*)(MB + (size_t)row * DM + col) = pack8(acc[ai][bj][m][0] * b0, acc[ai][bj][m][1] * b1);
                } }
    }
};
template <int MODE> struct EpiResid {
    static constexpr bool PERM = false, AFTER_DRAIN = false;
    const float* base; float* out; bf16* hb; float* ssq_out; const bf16* PP; const float* ssq_in;
    __device__ __forceinline__ bool reset(const Unit&) const { return true; }
    __device__ __forceinline__ void operator()(const f32x4 (&acc)[2][2][4][2], const Unit& u, int wr, int wc, int fr, int fq) const {
#pragma unroll
        for (int ai = 0; ai < 2; ++ai)
#pragma unroll
            for (int m = 0; m < 4; ++m) { const int row = EPI_ROWS(ai, m); float rs = 0.f; if (MODE == 1) rs = rstd_of(ssq_in, row); float ss = 0.f;
#pragma unroll
                for (int bj = 0; bj < 2; ++bj)
#pragma unroll
                    for (int n = 0; n < 2; ++n) { const size_t off = (size_t)row * DM + u.pn * BM + bj * HALF + wc * 32 + n * 16 + 4 * fq;
                        f32x4 v = *(const f32x4*)(base + off); const f32x4 a = acc[ai][bj][m][n];
                        if (MODE == 0) v = v + a;
                        else { const f32x4 pp = unpack_lo(*(const u32x2*)(PP + off));
#pragma unroll
                            for (int e = 0; e < 4; ++e) v[e] += fast_sigmoid(a[e] * rs) * pp[e]; }
                        *(f32x4*)(out + off) = v; u32x2 w; w.x = cvt_pk_bf16(v[0], v[1]); w.y = cvt_pk_bf16(v[2], v[3]); *(u32x2*)(hb + off) = w;
                        ss += (v[0] * v[0] + v[1] * v[1]) + (v[2] * v[2] + v[3] * v[3]); }
                ss += __shfl_xor(ss, 16); ss += __shfl_xor(ss, 32);
                if (fq == 0) ssq_out[(size_t)row * 16 + u.pn * 4 + wc] = ss; }
    }
};
template <bool MOE> struct EpiSwiglu {
    static constexpr bool PERM = true, AFTER_DRAIN = false;
    bf16* G; const float* ssq; const float* srs; const float* sgw;
    __device__ __forceinline__ bool reset(const Unit&) const { return true; }
    __device__ __forceinline__ void operator()(const f32x4 (&acc)[2][2][4][2], const Unit& u, int wr, int wc, int fr, int fq) const {
#pragma unroll
        for (int ai = 0; ai < 2; ++ai)
#pragma unroll
            for (int m = 0; m < 4; ++m) { const int row = EPI_ROWS(ai, m); float rs, gw = 1.f; if (MOE) { rs = srs[row]; gw = sgw[row]; } else rs = rstd_of(ssq, row);
                const float rs2 = rs * gw; f32x4 o[2];
#pragma unroll
                for (int bj = 0; bj < 2; ++bj)
#pragma unroll
                    for (int e = 0; e < 4; ++e) { const float a = acc[ai][bj][m][0][e] * rs, b = acc[ai][bj][m][1][e] * rs2; o[bj][e] = a * fast_sigmoid(a) * b; }
                *(u32x4*)(G + (size_t)row * DFF + u.pn * HALF + wc * 32 + 8 * fq) = pack8(o[0], o[1]); }
    }
};
struct MergeOrder {
    const bf16_t* A1; const bf16_t* Bt1; StaticOrder so;
    __device__ __forceinline__ void setup(int G_, int c_) { so.setup(G_, c_); }
    __device__ __forceinline__ bool next(int i, Unit& u) const { const bool ok = so.next(i >> 1, u); u.part = i & 1; return ok; }
    __device__ __forceinline__ const char* a_ptr(const Unit& u, const Gemm& g) const { return (const char*)(u.part ? A1 : g.A) + (size_t)u.pm * (size_t)(BM * 2) * g.K; }
    __device__ __forceinline__ const char* b_ptr(const Unit& u, const Gemm& g) const { return (const char*)(u.part ? Bt1 : g.Bt) + (size_t)u.pn * (size_t)(BM * 2) * g.K; }
    __device__ __forceinline__ void a_ready(const Unit&) const {}
    __device__ __forceinline__ void done(const Unit&) const {}
};

template <class Epi, class Sched, bool ALIGN_EPI = false, bool SP2 = false>
__device__ __forceinline__ void gemm_phase(LAS unsigned char* lds, const Gemm g, const Sched& S, const Epi& E) {
    const int tid = threadIdx.x, wid = __builtin_amdgcn_readfirstlane(tid >> 6), lane = tid & 63, wr = wid >> 2, wc = wid & 3, fr = lane & 15, fq = lane >> 4;
    const int K = g.K, nt = K / BK;
    unsigned voffA[2], voffB[2];
#pragma unroll
    for (int i = 0; i < 2; ++i) { int R, C; stage_rc(tid * 16 + i * 8192, R, C); const int Rb = Epi::PERM ? ((R & ~31) + perm32(R & 31)) : R;
        voffA[i] = (unsigned)(R * K + C) * 2u; voffB[i] = (unsigned)(Rb * K + C) * 2u; }
    const size_t kstep = (size_t)(BK * 2);
    const size_t hstep = (size_t)HALF * K * 2;
    const unsigned ldsw = (unsigned)wid * 1024u;
    const int aoff = lds_byte(wr * 64 + fr, fq * 8), boff = lds_byte(wc * 32 + fr, fq * 8);
#define PG8_SA(b, h) (((b) * 2 + (h)) * HTB)
#define PG8_SB(b, h) ((4 + (b) * 2 + (h)) * HTB)
#define PG8_STAGE(bufoff, gbase, voff) do { _Pragma("unroll") for (int _i = 0; _i < 2; ++_i) \
        __builtin_amdgcn_global_load_lds((const unsigned*)((const char*)(gbase) + (voff)[_i]), (LAS unsigned*)(lds + (bufoff) + ldsw + _i * 8192), 16, 0, 0); } while (0)
#define PG8_LDA(dst, b, h) do { _Pragma("unroll") for (int m = 0; m < 4; ++m) _Pragma("unroll") for (int k = 0; k < 2; ++k) dst[m][k] = *(const LAS bf16x8*)(lds + PG8_SA(b, h) + aoff + m * 2048 + k * 1024); } while (0)
#define PG8_LDB(dst, b, h) do { _Pragma("unroll") for (int n = 0; n < 2; ++n) _Pragma("unroll") for (int k = 0; k < 2; ++k) dst[n][k] = *(const LAS bf16x8*)(lds + PG8_SB(b, h) + boff + n * 2048 + k * 1024); } while (0)
#define PG8_MMA(ai, bj, At, Bt) do { __builtin_amdgcn_s_setprio(1); _Pragma("unroll") for (int m = 0; m < 4; ++m) _Pragma("unroll") for (int n = 0; n < 2; ++n) _Pragma("unroll") for (int k = 0; k < 2; ++k) \
        acc[ai][bj][m][n] = __builtin_amdgcn_mfma_f32_16x16x32_bf16(Bt[n][k], At[m][k], acc[ai][bj][m][n], 0, 0, 0); __builtin_amdgcn_s_setprio(0); } while (0)
#define PG8_WAIT_V(n) asm volatile("s_waitcnt vmcnt(" #n ")" ::: "memory")
#define PG8_WAIT_L(n) asm volatile("s_waitcnt lgkmcnt(" #n ")" ::: "memory")
#define PG8_BAR __builtin_amdgcn_s_barrier()
#define PG8_SCHED __builtin_amdgcn_sched_barrier(0)
    Unit cur, nxt; int ui = 0;
    if (!S.next(0, cur)) return;
    f32x4 acc[2][2][4][2];
#pragma unroll
    for (int a = 0; a < 2; ++a)
#pragma unroll
        for (int b = 0; b < 2; ++b)
#pragma unroll
            for (int m = 0; m < 4; ++m)
#pragma unroll
                for (int n = 0; n < 2; ++n) acc[a][b][m][n] = (f32x4){0.f, 0.f, 0.f, 0.f};
    bf16x8 At[4][2], B0[2][2], B1[2][2];
    const char* cA = S.a_ptr(cur, g); const char* cB = S.b_ptr(cur, g);
    S.a_ready(cur);
    if constexpr (SP2) {
        PG8_STAGE(PG8_SB(0, 0), cB, voffB); PG8_STAGE(PG8_SB(0, 1), cB + hstep, voffB); PG8_STAGE(PG8_SA(0, 0), cA, voffA); PG8_STAGE(PG8_SA(0, 1), cA + hstep, voffA);
        if (wr == 1) PG8_BAR;
        PG8_WAIT_V(2); PG8_BAR;
        PG8_STAGE(PG8_SB(1, 0), cB + kstep, voffB); PG8_STAGE(PG8_SA(1, 0), cA + kstep, voffA); PG8_STAGE(PG8_SB(1, 1), cB + hstep + kstep, voffB);
        PG8_WAIT_V(6); PG8_BAR;
    } else {
        PG8_STAGE(PG8_SB(0, 0), cB, voffB); PG8_STAGE(PG8_SA(0, 0), cA, voffA); PG8_STAGE(PG8_SB(0, 1), cB + hstep, voffB); PG8_STAGE(PG8_SA(0, 1), cA + hstep, voffA);
        if (wr == 1) PG8_BAR;
        PG8_WAIT_V(4); PG8_BAR;
        PG8_STAGE(PG8_SB(1, 0), cB + kstep, voffB); PG8_STAGE(PG8_SA(1, 0), cA + kstep, voffA); PG8_STAGE(PG8_SB(1, 1), cB + hstep + kstep, voffB);
        PG8_WAIT_V(6); PG8_BAR;
    }
    for (;;) {
        const bool has_next = S.next(ui + 1, nxt);
        const char* nA = has_next ? S.a_ptr(nxt, g) : cA; const char* nB = has_next ? S.b_ptr(nxt, g) : cB;
        for (int t = 0; t < nt; t += 2) {
            const bool last = (t == nt - 2);
            const char* a1 = cA + (size_t)(t + 1) * kstep;
            const char* a2 = last ? nA : cA + (size_t)(t + 2) * kstep; const char* b2 = last ? nB : cB + (size_t)(t + 2) * kstep;
            const char* a3 = a2 + kstep; const char* b3 = b2 + kstep;
            if (last && has_next) S.a_ready(nxt);
            if constexpr (SP2) {
            PG8_LDB(B0, 0, 0); PG8_LDB(B1, 0, 1); PG8_SCHED; PG8_LDA(At, 0, 0); PG8_STAGE(PG8_SA(1, 1), a1 + hstep, voffA);
            PG8_WAIT_V(8); PG8_WAIT_L(0); PG8_BAR; PG8_MMA(0, 0, At, B0); PG8_MMA(0, 1, At, B1); PG8_BAR; PG8_SCHED;
            PG8_LDA(At, 0, 1); PG8_STAGE(PG8_SB(0, 0), b2, voffB); PG8_STAGE(PG8_SB(0, 1), b2 + hstep, voffB); PG8_STAGE(PG8_SA(0, 0), a2, voffA);
            PG8_WAIT_V(8); PG8_WAIT_L(0); PG8_BAR; PG8_MMA(1, 0, At, B0); PG8_MMA(1, 1, At, B1); PG8_BAR; PG8_SCHED;
            PG8_LDB(B0, 1, 0); PG8_LDB(B1, 1, 1); PG8_SCHED; PG8_LDA(At, 1, 0); PG8_STAGE(PG8_SA(0, 1), a2 + hstep, voffA);
            PG8_WAIT_V(8); PG8_WAIT_L(0); PG8_BAR; PG8_MMA(0, 0, At, B0); PG8_MMA(0, 1, At, B1); PG8_BAR; PG8_SCHED;
            PG8_LDA(At, 1, 1); PG8_STAGE(PG8_SB(1, 0), b3, voffB); PG8_STAGE(PG8_SB(1, 1), b3 + hstep, voffB); PG8_STAGE(PG8_SA(1, 0), a3, voffA);
            PG8_WAIT_V(8); PG8_WAIT_L(0); PG8_BAR; PG8_MMA(1, 0, At, B0); PG8_MMA(1, 1, At, B1); PG8_BAR; PG8_SCHED;
            } else {
            PG8_LDB(B0, 0, 0); PG8_SCHED; PG8_LDA(At, 0, 0); PG8_STAGE(PG8_SA(1, 1), a1 + hstep, voffA);
            PG8_WAIT_L(8); PG8_BAR; PG8_WAIT_L(0); PG8_MMA(0, 0, At, B0); PG8_BAR; PG8_SCHED;
            PG8_LDB(B1, 0, 1); PG8_STAGE(PG8_SB(0, 0), b2, voffB);
            PG8_BAR; PG8_WAIT_L(0); PG8_MMA(0, 1, At, B1); PG8_BAR;
            PG8_LDA(At, 0, 1); PG8_STAGE(PG8_SA(0, 0), a2, voffA);
            PG8_BAR; PG8_WAIT_L(0); PG8_MMA(1, 0, At, B0); PG8_BAR; PG8_SCHED;
            PG8_STAGE(PG8_SB(0, 1), b2 + hstep, voffB);
            PG8_WAIT_V(6); PG8_BAR; PG8_MMA(1, 1, At, B1); PG8_BAR;
            PG8_LDB(B0, 1, 0); PG8_SCHED; PG8_LDA(At, 1, 0); PG8_STAGE(PG8_SA(0, 1), a2 + hstep, voffA);
            PG8_WAIT_L(8); PG8_BAR; PG8_WAIT_L(0); PG8_MMA(0, 0, At, B0); PG8_BAR; PG8_SCHED;
            PG8_LDB(B1, 1, 1); PG8_STAGE(PG8_SB(1, 0), b3, voffB);
            PG8_BAR; PG8_WAIT_L(0); PG8_MMA(0, 1, At, B1); PG8_BAR;
            PG8_LDA(At, 1, 1); PG8_STAGE(PG8_SA(1, 0), a3, voffA);
            PG8_BAR; PG8_WAIT_L(0); PG8_MMA(1, 0, At, B0); PG8_BAR; PG8_SCHED;
            PG8_STAGE(PG8_SB(1, 1), b3 + hstep, voffB);
            PG8_WAIT_V(6); PG8_BAR; PG8_MMA(1, 1, At, B1); PG8_BAR;
            }
        }
        if constexpr (ALIGN_EPI) { if (wr == 0) PG8_BAR; }
        E(acc, cur, wr, wc, fr, fq); S.done(cur);
        if (!has_next) break;
        if (E.reset(cur))
#pragma unroll
        for (int a = 0; a < 2; ++a)
#pragma unroll
            for (int b = 0; b < 2; ++b)
#pragma unroll
                for (int m = 0; m < 4; ++m)
#pragma unroll
                    for (int n = 0; n < 2; ++n) acc[a][b][m][n] = (f32x4){0.f, 0.f, 0.f, 0.f};
        cur = nxt; cA = nA; cB = nB; ++ui;
        if constexpr (ALIGN_EPI) { if (wr == 1) PG8_BAR; }
    }
    PG8_WAIT_V(0);
    if constexpr (!ALIGN_EPI) { if (wr == 0) PG8_BAR; }
    PG8_BAR;
#undef PG8_SA
#undef PG8_SB
#undef PG8_STAGE
#undef PG8_LDA
#undef PG8_LDB
#undef PG8_MMA
#undef PG8_WAIT_V
#undef PG8_WAIT_L
#undef PG8_BAR
#undef PG8_SCHED
}
}

struct F_inproj {
    bf16* U; const float* ssq4;
    __device__ __forceinline__ float row(int m) const { return rstd_of(ssq4, m); }
    __device__ __forceinline__ void operator()(float rs, int m, int n, float v) const {
        const float u = v * rs; float o;
        if (n < C_LG) o = u; else if (n < C_GA) o = gelu_tanh(u); else o = sigmoidf_(u);
        U[(size_t)m * NIN + n] = f2bf(o);
    }
};
struct F_store {
    bf16* O; int ld, pad;
    __device__ __forceinline__ int row(int) const { return 0; }
    __device__ __forceinline__ void operator()(int, int m, int n, float v) const { O[(size_t)m * ld + n] = f2bf(v); }
};
struct F_merge1 {
    bf16* MB; const bf16* U;
    __device__ __forceinline__ int row(int) const { return 0; }
    __device__ __forceinline__ void operator()(int, int m, int n, float v) const { MB[(size_t)m * DM + n] = f2bf(bf2f(U[(size_t)m * NIN + C_GA + n]) * v); }
};
struct F_merge2 {
    bf16* MB; const bf16* U;
    __device__ __forceinline__ int row(int) const { return 0; }
    __device__ __forceinline__ void operator()(int, int m, int n, float v) const { const size_t i = (size_t)m * DM + n; MB[i] = f2bf(bf2f(MB[i]) + bf2f(U[(size_t)m * NIN + C_GB + n]) * v); }
};
struct F_resid {
    const float* base; float* out;
    __device__ __forceinline__ int row(int) const { return 0; }
    __device__ __forceinline__ void operator()(int, int m, int n, float v) const { const size_t i = (size_t)m * DM + n; out[i] = base[i] + v; }
};
struct F_swiglu {
    bf16* G; const float* ssq4;
    __device__ __forceinline__ float row(int m) const { return rstd_of(ssq4, m); }
    __device__ __forceinline__ void operator()(float rs, int m, int oc, float a, float b) const { const float x = a * rs; G[(size_t)m * DFF + oc] = f2bf(x * sigmoidf_(x) * (b * rs)); }
};
struct F_swiglu_moe {
    bf16* G; const float* srs; const float* sgw;
    __device__ __forceinline__ f32x2 row(int s) const { return (f32x2){srs[s], sgw[s]}; }
    __device__ __forceinline__ void operator()(f32x2 c, int s, int oc, float a, float b) const { const float x = a * c.x; G[(size_t)s * DFF + oc] = f2bf(x * sigmoidf_(x) * (b * c.x) * c.y); }
};
struct F_ple {
    float* h; const bf16* PP; const float* ssq4;
    __device__ __forceinline__ float row(int m) const { return rstd_of(ssq4, m); }
    __device__ __forceinline__ void operator()(float rs, int m, int n, float v) const { const size_t i = (size_t)m * DM + n; h[i] += sigmoidf_(v * rs) * bf2f(PP[i]); }
};

constexpr int GEMM_LDS = 131072;
template <class Epi, class Sched>
__global__ void __launch_bounds__(512, 2) k_gemm(pg8::Gemm g, Sched S0, Epi E) {
    extern __shared__ __attribute__((aligned(16))) unsigned char lds[];
    Sched S = S0; S.setup((int)gridDim.x, (int)blockIdx.x);
    pg8::gemm_phase<Epi, Sched, true, true>((LAS unsigned char*)lds, g, S, E);
}
template <class Epi, class Sched>
static void launch_gemm(hipStream_t st, const bf16* A, const bf16* Bt, int K, Sched S, Epi E) {
    static bool init = false;
    auto kern = k_gemm<Epi, Sched>;
    if (!init) { (void)hipFuncSetAttribute((const void*)kern, hipFuncAttributeMaxDynamicSharedMemorySize, GEMM_LDS); init = true; }
    pg8::Gemm g; g.A = A; g.Bt = Bt; g.K = K; g.pad = 0;
    hipLaunchKernelGGL(kern, dim3(256), dim3(512), GEMM_LDS, st, g, S, E);
}
static pg8::StaticOrder mk_static(int Mrows, int N) { pg8::StaticOrder s; s.init(Mrows, N, 256, 0); return s; }
static pg8::MoeOrder mk_moe(const int* meta, size_t wstride, int N) { pg8::MoeOrder s; memset(&s, 0, sizeof(s)); s.meta = meta; s.wstride = wstride; s.N = N; return s; }

struct CJob { const float* W; const float* gain; bf16* dst; int K, N, mode, pad; };
struct Ptrs { const float* in[30]; float* out; unsigned char* ws; };

__device__ __forceinline__ void conv_item(const CJob& jb, LAS float* scr, int item, int lane) {
    const int nblk = jb.N / 32, kb = item / nblk, nb = item % nblk, k0 = 64 * kb, n0 = 32 * nb;
#pragma unroll 8
    for (int i = 0; i < 32; ++i) { const int kk = 2 * i + (lane >> 5); float w = jb.W[(size_t)(k0 + kk) * jb.N + n0 + (lane & 31)]; if (jb.gain) w *= jb.gain[k0 + kk]; scr[kk * 33 + (lane & 31)] = w; }
    asm volatile("s_waitcnt lgkmcnt(0)" ::: "memory");
    const int c = lane & 7;
#pragma unroll
    for (int j = 0; j < 4; ++j) { const int n = (lane >> 3) + 8 * j; const LAS float* s = scr + (8 * c) * 33 + n;
        u32x4 o; o.x = pk2(s[0 * 33], s[1 * 33]); o.y = pk2(s[2 * 33], s[3 * 33]); o.z = pk2(s[4 * 33], s[5 * 33]); o.w = pk2(s[6 * 33], s[7 * 33]);
        const int nn = n0 + n; int row = nn;
        if (jb.mode == 1 || jb.mode == 2) row = 8 * (nn >> 2) + (nn & 3) + (jb.mode == 2 ? 4 : 0);
        else if (jb.mode == 3) { const int w = nn & 255; row = (nn & ~255) + ((w >> 5) & 1) * 128 + (w >> 6) * 32 + (w & 31); }
        else if (jb.mode >= 4) { const int r = nn & 127; row = (nn >> 7) * 256 + ((r >> 2) & 1) * 128 + (r >> 5) * 32 + ((r >> 3) & 3) * 8 + (jb.mode == 5 ? 4 : 0) + (r & 3); }
        *(u32x4*)(jb.dst + (size_t)row * jb.K + k0 + 8 * c) = o; }
    asm volatile("s_waitcnt lgkmcnt(0)" ::: "memory");
}
__device__ __forceinline__ void conv_job(const CJob& jb, LAS float* scr, int gw, int ngw, int lane) {
    const int nit = (jb.K / 64) * (jb.N / 32);
    for (int it = gw; it < nit; it += ngw) conv_item(jb, scr, it, lane);
}
__device__ __forceinline__ CJob static_job(const Ptrs& P, int j) {
    CJob jb; jb.pad = 0; jb.gain = nullptr; jb.mode = 0;
    if (j < 24) { const int l = j / 6, k = j % 6;
        if (k == 0) { jb.W = P.in[3] + (size_t)l * DM * NIN; jb.gain = P.in[2] + l * DM; jb.dst = (bf16*)(P.ws + WS_WIN) + (size_t)l * NIN * DM; jb.K = DM; jb.N = NIN; jb.mode = 3; }
        else if (k == 1) { jb.W = P.in[15] + (size_t)l * DM * DM; jb.dst = (bf16*)(P.ws + WS_WPA) + (size_t)l * DM * DM; jb.K = DM; jb.N = DM; }
        else if (k == 2) { jb.W = P.in[16] + (size_t)l * DM * DM; jb.dst = (bf16*)(P.ws + WS_WPB) + (size_t)l * DM * DM; jb.K = DM; jb.N = DM; }
        else if (k == 3) { jb.W = P.in[17] + (size_t)l * DM * DM; jb.dst = (bf16*)(P.ws + WS_WOUT) + (size_t)l * DM * DM; jb.K = DM; jb.N = DM; }
        else if (k == 4) { jb.W = P.in[28] + (size_t)l * DM * DM; jb.gain = P.in[27] + l * DM; jb.dst = (bf16*)(P.ws + WS_WPG) + (size_t)l * DM * DM; jb.K = DM; jb.N = DM; }
        else { jb.W = P.in[29] + (size_t)l * PLE * DM; jb.dst = (bf16*)(P.ws + WS_WPP) + (size_t)l * DM * PLE; jb.K = PLE; jb.N = DM; }
    } else if (j >= 30) { const int idx = j - 30, l = idx >> 5, mat = (idx >> 4) & 1, n = idx & 15;
        jb.W = P.in[mat ? 12 : 10] + (size_t)(l * 16 + n) * 64 * 64; jb.dst = (bf16*)(P.ws + WS_LRUW) + (size_t)((l * 2 + mat) * 16 + n) * 64 * 64; jb.K = 64; jb.N = 64;
    } else { const int j2 = (j - 24) / 3, k = (j - 24) % 3;
        if (k < 2) { jb.W = P.in[19 + k] + (size_t)j2 * DM * DFF; jb.gain = P.in[18] + (2 * j2) * DM; jb.dst = (bf16*)(P.ws + WS_W13D) + (size_t)j2 * 2 * DFF * DM; jb.K = DM; jb.N = DFF; jb.mode = 4 + k; }
        else { jb.W = P.in[21] + (size_t)j2 * DFF * DM; jb.dst = (bf16*)(P.ws + WS_W2D) + (size_t)j2 * DM * DFF; jb.K = DFF; jb.N = DM; }
    }
    return jb;
}
__device__ __forceinline__ CJob moe_job(const Ptrs& P, int j2, int j) {
    CJob jb; jb.pad = 0; jb.gain = nullptr; jb.mode = 0; const int e = j / 3, k = j % 3;
    if (k < 2) { jb.W = P.in[24 + k] + ((size_t)j2 * NEXP + e) * DM * DFF; jb.gain = P.in[18] + (2 * j2 + 1) * DM; jb.dst = (bf16*)(P.ws + WS_W13E) + (size_t)e * 2 * DFF * DM; jb.K = DM; jb.N = DFF; jb.mode = 4 + k; }
    else { jb.W = P.in[26] + ((size_t)j2 * NEXP + e) * DFF * DM; jb.dst = (bf16*)(P.ws + WS_W2E) + (size_t)e * DM * DFF; jb.K = DFF; jb.N = DM; }
    return jb;
}
template <bool COMBINE> __device__ __forceinline__ void rowstats_row(const float* hrow, float* hout, bf16* hbrow, float* ssq, const bf16* o1, const bf16* o2, int lane) {
    const f32x4* xr = (const f32x4*)hrow + lane; float s[4];
#pragma unroll
    for (int j = 0; j < 4; ++j) { f32x4 v = xr[64 * j];
        if (COMBINE) { v = v + unpack_lo(*((const u32x2*)o1 + lane + 64 * j)) + unpack_lo(*((const u32x2*)o2 + lane + 64 * j)); *((f32x4*)hout + lane + 64 * j) = v; }
        s[j] = (v.x * v.x + v.y * v.y) + (v.z * v.z + v.w * v.w);
        u32x2 o; o.x = cvt_pk_bf16(v.x, v.y); o.y = cvt_pk_bf16(v.z, v.w); *((u32x2*)hbrow + lane + 64 * j) = o; }
#pragma unroll
    for (int j = 0; j < 4; ++j) s[j] = wave_sum(s[j]);
    const float v = lane == 0 ? s[0] : lane == 1 ? s[1] : lane == 2 ? s[2] : lane == 3 ? s[3] : 0.f;
    if (lane < 16) ssq[lane] = v;
}
__global__ void __launch_bounds__(512, 2) k_prologue(Ptrs P) {
    extern __shared__ __attribute__((aligned(16))) unsigned char lds[];
    const int lane = threadIdx.x & 63, wave = threadIdx.x >> 6, gw = blockIdx.x * 8 + wave, ngw = gridDim.x * 8;
    LAS float* scr = (LAS float*)((LAS unsigned char*)lds + wave * 16384);
    for (int j = 0; j < 30 + 128; ++j) { const CJob jb = static_job(P, j); conv_job(jb, scr, gw, ngw, lane); }
    bf16* hb = (bf16*)(P.ws + WS_HB); float* ssq = (float*)(P.ws + WS_SSQ);
    for (int m = gw; m < M; m += ngw) rowstats_row<false>(P.in[0] + (size_t)m * DM, nullptr, hb + (size_t)m * DM, ssq + 16 * (size_t)m, nullptr, nullptr, lane);
}
__global__ void __launch_bounds__(512, 2) k_convmoe(Ptrs P, int j2) {
    extern __shared__ __attribute__((aligned(16))) unsigned char lds[];
    const int lane = threadIdx.x & 63, wave = threadIdx.x >> 6, gw = blockIdx.x * 8 + wave, ngw = gridDim.x * 8;
    LAS float* scr = (LAS float*)((LAS unsigned char*)lds + wave * 16384);
    for (int j = 0; j < 24; ++j) { const CJob jb = moe_job(P, j2, j); conv_job(jb, scr, gw, ngw, lane); }
}
__global__ void __launch_bounds__(256) k_convp(const float* p, bf16* pb) {
    const size_t i = (size_t)blockIdx.x * 256 + threadIdx.x; const f32x4 v = ((const f32x4*)p)[i]; u32x2 o; o.x = pk2(v.x, v.y); o.y = pk2(v.z, v.w); ((u32x2*)pb)[i] = o;
}
__global__ void __launch_bounds__(256) k_combine(float* h, const bf16* O, const int* tslot, bf16* hb, float* ssq) {
    const int lane = threadIdx.x & 63, m = blockIdx.x * 4 + (threadIdx.x >> 6); const int s1 = tslot[2 * m], s2 = tslot[2 * m + 1];
    rowstats_row<true>(h + (size_t)m * DM, h + (size_t)m * DM, hb + (size_t)m * DM, ssq + 16 * (size_t)m, O + (size_t)s1 * DM, O + (size_t)s2 * DM, lane);
}

__device__ __forceinline__ int t5_bucket(int d) {
    if (d < 16) return d;
    int l = 16 + (int)(logf((float)d / 16.f) / logf(8.f) * 16.f);
    return l < 31 ? l : 31;
}
__global__ void __launch_bounds__(256) nv_attn(const bf16* U, bf16* YA, const float* sinks, const float* rel_bias) {
    __shared__ float btab[128];
    const int h = blockIdx.x & 15, chunk = blockIdx.x >> 4;
    if (threadIdx.x < 128) btab[threadIdx.x] = rel_bias[t5_bucket((int)threadIdx.x) * 16 + h] * LOG2E;
    __syncthreads();
    const int m = chunk * 256 + threadIdx.x, t = m & (SEQ - 1), kvh = h >> 2;
    float q[64];
    { const bf16* qp = U + (size_t)m * NIN + h * 64;
#pragma unroll
      for (int c = 0; c < 8; ++c) { const u32x4 w = *(const u32x4*)(qp + 8 * c);
#pragma unroll
          for (int j = 0; j < 4; ++j) { q[8 * c + 2 * j] = bf2f((bf16)(w[j] & 0xffffu)); q[8 * c + 2 * j + 1] = bf2f((bf16)(w[j] >> 16)); } } }
    float mx = sinks[h] * LOG2E, l = 1.f; float acc[64];
#pragma unroll
    for (int d = 0; d < 64; ++d) acc[d] = 0.f;
    const int dmax = t < 127 ? t : 127;
    for (int dist = 0; dist <= dmax; ++dist) {
        const bf16* kp = U + (size_t)(m - dist) * NIN + C_K + kvh * 64; const bf16* vp = kp + (C_V - C_K);
        float s = btab[dist];
#pragma unroll
        for (int c = 0; c < 8; ++c) { const u32x4 w = *(const u32x4*)(kp + 8 * c);
#pragma unroll
            for (int j = 0; j < 4; ++j) s += q[8 * c + 2 * j] * bf2f((bf16)(w[j] & 0xffffu)) + q[8 * c + 2 * j + 1] * bf2f((bf16)(w[j] >> 16)); }
        const float mn = fmaxf(mx, s), sc = exp2f(mx - mn), pr = exp2f(s - mn); l = l * sc + pr; mx = mn;
#pragma unroll
        for (int c = 0; c < 8; ++c) { const u32x4 w = *(const u32x4*)(vp + 8 * c);
#pragma unroll
            for (int j = 0; j < 4; ++j) { acc[8 * c + 2 * j] = acc[8 * c + 2 * j] * sc + pr * bf2f((bf16)(w[j] & 0xffffu)); acc[8 * c + 2 * j + 1] = acc[8 * c + 2 * j + 1] * sc + pr * bf2f((bf16)(w[j] >> 16)); } }
    }
    const float il = 1.f / l; bf16* op = YA + (size_t)m * DM + h * 64;
#pragma unroll
    for (int c = 0; c < 8; ++c) { u32x4 w;
#pragma unroll
        for (int j = 0; j < 4; ++j) w[j] = pk2(acc[8 * c + 2 * j] * il, acc[8 * c + 2 * j + 1] * il);
        *(u32x4*)(op + 8 * c) = w; }
}
__global__ void __launch_bounds__(256) nv_lru_gates(const bf16* U, float* NA, float* NU, const float* conv_w, const float* conv_b, const float* w_rg, const float* b_rg,
                                                    const float* w_ig, const float* b_ig, const float* lam, int b0) {
    __shared__ float xcs[4][64];
    const int nb = blockIdx.x & 15, mg = blockIdx.x >> 4, tl = threadIdx.x >> 6, d = threadIdx.x & 63;
    const int ml = mg * 4 + tl, m = b0 * SEQ + ml, t = m & (SEQ - 1), ch = nb * 64 + d;
    float xc = conv_b[ch];
#pragma unroll
    for (int j = 0; j < 4; ++j) { const int tt = t - 3 + j; if (tt >= 0) xc += conv_w[j * DM + ch] * bf2f(U[(size_t)(m - 3 + j) * NIN + C_LX + ch]); }
    xcs[tl][d] = xc; __syncthreads();
    float r = b_rg[ch], ig = b_ig[ch];
    for (int c = 0; c < 64; ++c) { const float x = xcs[tl][c]; r += x * w_rg[(size_t)(nb * 64 + c) * 64 + d]; ig += x * w_ig[(size_t)(nb * 64 + c) * 64 + d]; }
    r = 1.f / (1.f + expf(-r)); ig = 1.f / (1.f + expf(-ig));
    const float sp = log1pf(expf(-lam[ch])), log_a = -8.f * r * sp;
    NA[(size_t)ml * DM + ch] = expf(log_a); NU[(size_t)ml * DM + ch] = sqrtf(-expm1f(2.f * log_a)) * (ig * xc);
}
__global__ void __launch_bounds__(64) nv_lru_scan(const float* NA, const float* NU, const bf16* U, bf16* YB, int b0) {
    const int idx = blockIdx.x * 64 + threadIdx.x, bl = idx >> 10, ch = idx & 1023; float h = 0.f;
#pragma unroll 8
    for (int t = 0; t < SEQ; ++t) { const size_t ml = (size_t)bl * SEQ + t, m = (size_t)(b0 + bl) * SEQ + t;
        h = NA[ml * DM + ch] * h + NU[ml * DM + ch]; YB[m * DM + ch] = f2bf(h * bf2f(U[m * NIN + C_LG + ch])); }
}
__global__ void __launch_bounds__(256) nv_router(const float* h, const float* ssq4, const float* gain, const float* rw, const float* rb, int* sel, float* selw) {
    const int lane = threadIdx.x & 63, m = blockIdx.x * 4 + (threadIdx.x >> 6); float acc[8];
#pragma unroll
    for (int e = 0; e < 8; ++e) acc[e] = 0.f;
    for (int j = 0; j < 16; ++j) { const int k = lane + 64 * j; const float x = h[(size_t)m * DM + k] * gain[k]; const f32x4 w0 = *(const f32x4*)(rw + 8 * k), w1 = *(const f32x4*)(rw + 8 * k + 4);
        acc[0] += x * w0.x; acc[1] += x * w0.y; acc[2] += x * w0.z; acc[3] += x * w0.w; acc[4] += x * w1.x; acc[5] += x * w1.y; acc[6] += x * w1.z; acc[7] += x * w1.w; }
    const float rs = rstd_of(ssq4, m);
#pragma unroll
    for (int e = 0; e < 8; ++e) acc[e] = wave_sum(acc[e]) * rs + rb[e];
    int i1 = 0; float v1 = acc[0];
#pragma unroll
    for (int e = 1; e < 8; ++e) if (acc[e] > v1) { v1 = acc[e]; i1 = e; }
    int i2 = -1; float v2 = -3.0e38f;
#pragma unroll
    for (int e = 0; e < 8; ++e) if (e != i1 && acc[e] > v2) { v2 = acc[e]; i2 = e; }
    const float ex = __expf(v2 - v1), w1 = 1.f / (1.f + ex), w2 = ex / (1.f + ex);
    if (lane == 0) { sel[2 * m] = i1; sel[2 * m + 1] = i2; selw[2 * m] = w1; selw[2 * m + 1] = w2; }
}
__global__ void __launch_bounds__(1024) nv_slots(const int* sel, const float* selw, const float* ssq4, int* tok, float* srs, float* sgw, int* tslot, int* meta) {
    __shared__ int c[8][1024]; __shared__ int start[9]; __shared__ int tot[8];
    const int t = threadIdx.x;
#pragma unroll
    for (int e = 0; e < 8; ++e) c[e][t] = 0;
    for (int i = 0; i < 32; ++i) { const int m = 32 * t + i; c[sel[2 * m]][t]++; c[sel[2 * m + 1]][t]++; }
    __syncthreads();
    if (t < 8) { int run = 0; for (int j = 0; j < 1024; ++j) { const int v = c[t][j]; c[t][j] = run; run += v; } tot[t] = run; }
    __syncthreads();
    if (t == 0) { int s = 0; for (int e = 0; e < 8; ++e) { start[e] = s; s += ((tot[e] + 255) / 256) * 256; } start[8] = s; for (int e = 0; e < 9; ++e) meta[e] = start[e] / 256; }
    __syncthreads();
    for (int i = 0; i < 32; ++i) { const int m = 32 * t + i; const float rs = rstd_of(ssq4, m);
        for (int k = 0; k < 2; ++k) { const int e = sel[2 * m + k]; const int pos = start[e] + c[e][t]++; tok[pos] = m; srs[pos] = rs; sgw[pos] = selw[2 * m + k]; tslot[2 * m + k] = pos; } }
    for (int e = 0; e < 8; ++e) for (int s = start[e] + tot[e] + t; s < start[e + 1]; s += 1024) { tok[s] = 0; srs[s] = 0.f; sgw[s] = 0.f; }
}
__global__ void __launch_bounds__(256) nv_gather(const bf16* hb, const int* tok, const int* meta, bf16* XG) {
    const int lane = threadIdx.x & 63, s = blockIdx.x * 4 + (threadIdx.x >> 6); if (s >= meta[8] * 256) return;
    const u32x4* src = (const u32x4*)(hb + (size_t)tok[s] * DM); u32x4* dst = (u32x4*)(XG + (size_t)s * DM);
    dst[lane] = src[lane]; dst[lane + 64] = src[lane + 64];
}

namespace attn {
typedef float f32x16 __attribute__((ext_vector_type(16)));
typedef short s16x4 __attribute__((ext_vector_type(4)));
constexpr int KIMG = 0, VIMG = 32768, BTAB = 65536, LSCR = BTAB + 2048, LDS_BYTES = LSCR + 1024;
__device__ __forceinline__ int crow(int r, int hi) { return (r & 3) + 8 * (r >> 2) + 4 * hi; }
__device__ __forceinline__ s16x4 vtr(const LAS unsigned char* p) { return __builtin_bit_cast(s16x4, __builtin_amdgcn_ds_read_tr16_b64_v4i16((LAS s16x4*)p)); }
__device__ __forceinline__ void attn_phase(LAS unsigned char* lds, const bf16* U, bf16* YA, const float* sinks, const float* rel_bias, int G, int c) {
    const int tid = threadIdx.x, lane = tid & 63, wid = __builtin_amdgcn_readfirstlane(tid >> 6), r32 = lane & 31, hi = lane >> 5;
    const int g = wid >> 1, qh = wid & 1;
    LAS float* btab = (LAS float*)(lds + BTAB); LAS float* lscr = (LAS float*)(lds + LSCR) + wid * 32;
    for (int L = c; L < BATCH * 32 * 4; L += G) {
        const int kvh = L & 3, n = (L >> 2) & 31, b = L >> 7;
        const int tok0 = b * SEQ + (n - 1) * 128;
        btab[tid] = rel_bias[t5_bucket(tid & 127) * 16 + kvh * 4 + (tid >> 7)] * LOG2E;
#pragma unroll
        for (int kg = 0; kg < 4; ++kg) { const int key = 64 * kg + lane; int t = tok0 + key; if (t < b * SEQ) t = b * SEQ;
            __builtin_amdgcn_global_load_lds((const unsigned*)(U + (size_t)t * NIN + C_K + kvh * 64 + 8 * wid), (LAS unsigned*)(lds + KIMG + wid * 4096 + kg * 1024), 16, 0, 0); }
#pragma unroll
        for (int j = 0; j < 4; ++j) { const int kg16 = 4 * (wid & 3) + j, key = 16 * kg16 + (lane >> 2); int t = tok0 + key; if (t < b * SEQ) t = b * SEQ;
            __builtin_amdgcn_global_load_lds((const unsigned*)(U + (size_t)t * NIN + C_V + kvh * 64 + 32 * (wid >> 2) + 8 * (lane & 3)), (LAS unsigned*)(lds + VIMG + (wid >> 2) * 16384 + kg16 * 1024), 16, 0, 0); }
        asm volatile("s_waitcnt vmcnt(0)" ::: "memory"); __syncthreads();
        const float sink2 = sinks[kvh * 4 + g] * LOG2E; const LAS float* bt = btab + g * 128;
        for (int qt = 0; qt < 2; ++qt) {
            const int iq0 = 64 * qh + 32 * qt, kt0 = iq0 >> 5; const size_t mq = (size_t)b * SEQ + n * 128 + iq0;
            bf16x8 qf[4];
#pragma unroll
            for (int d0 = 0; d0 < 4; ++d0) qf[d0] = *(const bf16x8*)(U + (mq + r32) * NIN + (kvh * 4 + g) * 64 + 16 * d0 + 8 * hi);
            f32x16 p[5];
#pragma unroll
            for (int jt = 0; jt < 5; ++jt) { f32x16 a = {};
#pragma unroll
                for (int d0 = 0; d0 < 4; ++d0) { const bf16x8 kf = *(const LAS bf16x8*)(lds + KIMG + (2 * d0 + hi) * 4096 + (32 * (kt0 + jt) + r32) * 16); a = __builtin_amdgcn_mfma_f32_32x32x16_bf16(kf, qf[d0], a, 0, 0, 0); }
                p[jt] = a; }
            float mx = sink2;
#pragma unroll
            for (int jt = 0; jt < 5; ++jt)
#pragma unroll
                for (int r = 0; r < 16; ++r) { const int ik = crow(r, hi), dist = 128 - 32 * jt + r32 - ik; bool valid = true;
                    if (jt == 0) valid = ik > r32; if (jt == 4) valid = ik <= r32; if (n == 0) valid = valid && (32 * (kt0 + jt) + ik >= 128);
                    const int di = dist < 0 ? 0 : (dist > 127 ? 127 : dist); const float s = valid ? p[jt][r] + bt[di] : -1.0e30f; p[jt][r] = s; mx = fmaxf(mx, s); }
            mx = fmaxf(mx, __shfl_xor(mx, 32));
            float l = 0.f;
#pragma unroll
            for (int jt = 0; jt < 5; ++jt)
#pragma unroll
                for (int r = 0; r < 16; ++r) { const float e = __builtin_amdgcn_exp2f(p[jt][r] - mx); p[jt][r] = e; l += e; }
            l += __shfl_xor(l, 32); l += __builtin_amdgcn_exp2f(sink2 - mx);
            f32x16 o[2]; o[0] = (f32x16){}; o[1] = (f32x16){};
            const LAS unsigned char* vb = lds + VIMG + ((lane >> 4) & 1) * 32 + (lane & 3) * 8 + (4 * hi + ((lane & 15) >> 2)) * 64;
#pragma unroll
            for (int jt = 0; jt < 5; ++jt)
#pragma unroll
                for (int s = 0; s < 2; ++s) { u32x4 w; w.x = cvt_pk_bf16(p[jt][8 * s], p[jt][8 * s + 1]); w.y = cvt_pk_bf16(p[jt][8 * s + 2], p[jt][8 * s + 3]); w.z = cvt_pk_bf16(p[jt][8 * s + 4], p[jt][8 * s + 5]); w.w = cvt_pk_bf16(p[jt][8 * s + 6], p[jt][8 * s + 7]);
                    const bf16x8 pa = __builtin_bit_cast(bf16x8, w);
#pragma unroll
                    for (int d0 = 0; d0 < 2; ++d0) { const LAS unsigned char* vp = vb + d0 * 16384 + (32 * (kt0 + jt) + 16 * s) * 64; const s16x4 lo = vtr(vp), hv = vtr(vp + 8 * 64);
                        const bf16x8 vf = (bf16x8){lo[0], lo[1], lo[2], lo[3], hv[0], hv[1], hv[2], hv[3]};
                        o[d0] = __builtin_amdgcn_mfma_f32_32x32x16_bf16(pa, vf, o[d0], 0, 0, 0); } }
            if (hi == 0) lscr[r32] = l;
            asm volatile("s_waitcnt lgkmcnt(0)" ::: "memory");
            bf16* op = YA + mq * DM + (kvh * 4 + g) * 64 + r32;
#pragma unroll
            for (int r = 0; r < 16; ++r) { const int qi = crow(r, hi); const float rl = __builtin_amdgcn_rcpf(lscr[qi]);
                op[(size_t)qi * DM] = f2bf(o[0][r] * rl); op[(size_t)qi * DM + 32] = f2bf(o[1][r] * rl); }
        }
        __syncthreads();
    }
}
}
__global__ void __launch_bounds__(512, 2) k_attn(const bf16* U, bf16* YA, const float* sinks, const float* rel_bias) {
    extern __shared__ __attribute__((aligned(16))) unsigned char lds[];
    attn::attn_phase((LAS unsigned char*)lds, U, YA, sinks, rel_bias, (int)gridDim.x, (int)blockIdx.x);
}

namespace lru {
typedef float f32x16 __attribute__((ext_vector_type(16)));
constexpr int TC = 128, NCK = SEQ / TC, NUNIT = BATCH * 16 * NCK, CW_BYTES = 5 * 64 * 4;
__device__ __forceinline__ int crow(int r, int hi) { return (r & 3) + 8 * (r >> 2) + 4 * hi; }
template <int PASS>
__device__ __forceinline__ void lru_phase(LAS unsigned char* lds, const bf16* U, bf16* YB, float* AGG, const bf16* Wt, const float* conv_w, const float* conv_b,
                                          const float* b_rg, const float* b_ig, const float* lam, int G, int c) {
    const int tid = threadIdx.x, lane = tid & 63, wid = __builtin_amdgcn_readfirstlane(tid >> 6), r32 = lane & 31, hi = lane >> 5;
    LAS float* cw = (LAS float*)(lds + wid * CW_BYTES);
    for (int un = c * 8 + wid; un < NUNIT; un += G * 8) {
        const int ck = un & (NCK - 1), nb = (un >> 5) & 15, b = un >> 9, ch0 = nb * 64;
#pragma unroll
        for (int j = 0; j < 4; ++j) cw[j * 64 + lane] = conv_w[j * DM + ch0 + lane];
        cw[4 * 64 + lane] = conv_b[ch0 + lane];
        bf16x8 wr[2][4], wi[2][4];
#pragma unroll
        for (int ct = 0; ct < 2; ++ct)
#pragma unroll
            for (int ks = 0; ks < 4; ++ks) { const size_t o = (size_t)(nb * 64 + 32 * ct + r32) * 64 + 16 * ks + 8 * hi;
                wr[ct][ks] = *(const bf16x8*)(Wt + o); wi[ct][ks] = *(const bf16x8*)(Wt + (size_t)16 * 64 * 64 + o); }
        float brg[2], big[2], sp8[2], carry[2], prodA[2];
#pragma unroll
        for (int ct = 0; ct < 2; ++ct) { const int ch = ch0 + 32 * ct + r32; brg[ct] = b_rg[ch]; big[ct] = b_ig[ch]; sp8[ct] = -8.f * log1pf(__expf(-lam[ch])); carry[ct] = 0.f; prodA[ct] = 1.f; }
        if (PASS == 2) {
#pragma unroll
            for (int ct = 0; ct < 2; ++ct) { const int ch = ch0 + 32 * ct + r32; float C = 0.f;
                for (int j = 0; j < ck; ++j) { const f32x2 ah = *(const f32x2*)(AGG + ((size_t)(b * NCK + j) * DM + ch) * 2); C = ah.x * C + ah.y; }
                carry[ct] = C; }
        }
        asm volatile("s_waitcnt lgkmcnt(0)" ::: "memory");
        for (int st = 0; st < 4; ++st) {
            const int t0 = ck * TC + st * 32, t = t0 + r32; const size_t m = (size_t)b * SEQ + t;
            bf16x8 af[4];
#pragma unroll
            for (int ks = 0; ks < 4; ++ks) { const int cl = 16 * ks + 8 * hi; f32x4 x0 = *(const LAS f32x4*)(cw + 256 + cl), x1 = *(const LAS f32x4*)(cw + 256 + cl + 4);
#pragma unroll
                for (int j = 0; j < 4; ++j) { const int back = 3 - j; const bool ok = t >= back; const size_t mm = ok ? m - back : m;
                    f32x4 v0, v1; pg8::unpack8(*(const u32x4*)(U + mm * NIN + C_LX + ch0 + cl), v0, v1);
                    const f32x4 w0 = *(const LAS f32x4*)(cw + j * 64 + cl), w1 = *(const LAS f32x4*)(cw + j * 64 + cl + 4);
                    if (ok) { x0 = x0 + w0 * v0; x1 = x1 + w1 * v1; } }
                af[ks] = __builtin_bit_cast(bf16x8, pg8::pack8(x0, x1)); }
#pragma unroll
            for (int ct = 0; ct < 2; ++ct) {
                f32x16 R = {}, I = {}, X = {};
#pragma unroll
                for (int ks = 0; ks < 4; ++ks) { bf16x8 idf;
#pragma unroll
                    for (int j = 0; j < 8; ++j) idf[j] = (16 * ks + 8 * hi + j == 32 * ct + r32) ? (short)0x3F80 : (short)0;
                    R = __builtin_amdgcn_mfma_f32_32x32x16_bf16(af[ks], wr[ct][ks], R, 0, 0, 0); I = __builtin_amdgcn_mfma_f32_32x32x16_bf16(af[ks], wi[ct][ks], I, 0, 0, 0);
                    X = __builtin_amdgcn_mfma_f32_32x32x16_bf16(af[ks], idf, X, 0, 0, 0); }
                float P[16], H[16];
#pragma unroll
                for (int r = 0; r < 16; ++r) { const float rr = fast_sigmoid(R[r] + brg[ct]), ii = fast_sigmoid(I[r] + big[ct]); const float la = rr * sp8[ct];
                    const float a = __builtin_amdgcn_exp2f(la * LOG2E), y = 2.f * la;
                    float om = -y * (1.f + y * (0.5f + y * ((1.f / 6.f) + y * ((1.f / 24.f) + y * ((1.f / 120.f) + y * (1.f / 720.f))))));
                    P[r] = a; H[r] = __builtin_amdgcn_sqrtf(fmaxf(om, 0.f)) * (ii * X[r]); }
                float Ag[4], Hg[4], Ao[4], Ho[4];
#pragma unroll
                for (int g4 = 0; g4 < 4; ++g4) {
#pragma unroll
                    for (int j = 1; j < 4; ++j) { H[4 * g4 + j] = P[4 * g4 + j] * H[4 * g4 + j - 1] + H[4 * g4 + j]; P[4 * g4 + j] = P[4 * g4 + j] * P[4 * g4 + j - 1]; }
                    Ag[g4] = P[4 * g4 + 3]; Hg[g4] = H[4 * g4 + 3]; Ao[g4] = __shfl_xor(Ag[g4], 32); Ho[g4] = __shfl_xor(Hg[g4], 32); }
                float C = carry[ct], Cm[4];
#pragma unroll
                for (int g4 = 0; g4 < 4; ++g4) { const float A0 = hi ? Ao[g4] : Ag[g4], H0 = hi ? Ho[g4] : Hg[g4], A1 = hi ? Ag[g4] : Ao[g4], H1 = hi ? Hg[g4] : Ho[g4];
                    const float C1 = A0 * C + H0; Cm[g4] = hi ? C1 : C; C = A1 * C1 + H1; if (PASS == 1) prodA[ct] *= A0 * A1; }
                carry[ct] = C;
                if (PASS == 2) { const int ch = ch0 + 32 * ct + r32;
#pragma unroll
                    for (int r = 0; r < 16; ++r) { const size_t mt = (size_t)b * SEQ + t0 + crow(r, hi); const float h = H[r] + P[r] * Cm[r >> 2];
                        YB[mt * DM + ch] = f2bf(h * bf2f(U[mt * NIN + C_LG + ch])); } }
            }
        }
        if (PASS == 1 && hi == 0) {
#pragma unroll
            for (int ct = 0; ct < 2; ++ct) *(f32x2*)(AGG + ((size_t)(b * NCK + ck) * DM + ch0 + 32 * ct + r32) * 2) = (f32x2){prodA[ct], carry[ct]};
        }
    }
}
}
template <int PASS> __global__ void __launch_bounds__(512, 2) k_lru(const bf16* U, bf16* YB, float* AGG, const bf16* Wt, const float* conv_w, const float* conv_b, const float* b_rg, const float* b_ig, const float* lam) {
    extern __shared__ __attribute__((aligned(16))) unsigned char lds[];
    lru::lru_phase<PASS>((LAS unsigned char*)lds, U, YB, AGG, Wt, conv_w, conv_b, b_rg, b_ig, lam, (int)gridDim.x, (int)blockIdx.x);
}

namespace moe {
constexpr int NCHUNK = M / 128;
__device__ __forceinline__ void route_a(LAS unsigned char* lds, const float* h, const float* ssq, const float* gain, const float* rw, const float* rb, int* sel, float* selw, int* CNT, int G, int c) {
    const int tid = threadIdx.x, lane = tid & 63, wid = __builtin_amdgcn_readfirstlane(tid >> 6); LAS int* lc = (LAS int*)lds;
    for (int chunk = c; chunk < NCHUNK; chunk += G) {
        if (tid < 8) lc[tid] = 0;
        __syncthreads();
        for (int i = 0; i < 16; ++i) { const int m = chunk * 128 + wid * 16 + i; float acc[8];
#pragma unroll
            for (int e = 0; e < 8; ++e) acc[e] = 0.f;
#pragma unroll 4
            for (int j = 0; j < 16; ++j) { const int k = lane + 64 * j; const float x = h[(size_t)m * DM + k] * gain[k]; const f32x4 w0 = *(const f32x4*)(rw + 8 * k), w1 = *(const f32x4*)(rw + 8 * k + 4);
                acc[0] += x * w0.x; acc[1] += x * w0.y; acc[2] += x * w0.z; acc[3] += x * w0.w; acc[4] += x * w1.x; acc[5] += x * w1.y; acc[6] += x * w1.z; acc[7] += x * w1.w; }
            const float rs = rstd_of(ssq, m);
#pragma unroll
            for (int e = 0; e < 8; ++e) acc[e] = wave_sum(acc[e]) * rs + rb[e];
            int i1 = 0; float v1 = acc[0];
#pragma unroll
            for (int e = 1; e < 8; ++e) if (acc[e] > v1) { v1 = acc[e]; i1 = e; }
            int i2 = -1; float v2 = -3.0e38f;
#pragma unroll
            for (int e = 0; e < 8; ++e) if (e != i1 && acc[e] > v2) { v2 = acc[e]; i2 = e; }
            const float ex = __expf(v2 - v1), w1 = 1.f / (1.f + ex), w2 = ex / (1.f + ex);
            if (lane == 0) { sel[2 * m] = i1; sel[2 * m + 1] = i2; selw[2 * m] = w1; selw[2 * m + 1] = w2; atomicAdd((int*)(lc + i1), 1); atomicAdd((int*)(lc + i2), 1); }
        }
        __syncthreads();
        if (tid < 8) CNT[chunk * 8 + tid] = lc[tid];
        __syncthreads();
    }
}
__device__ __forceinline__ void route_b(LAS unsigned char* lds, const int* sel, const float* selw, const float* ssq, const int* CNT, const bf16* hb, int* tok, float* srs, float* sgw, int* tslot, int* meta, bf16* XG, int G, int c) {
    const int tid = threadIdx.x, lane = tid & 63, wid = __builtin_amdgcn_readfirstlane(tid >> 6);
    LAS int* tot = (LAS int*)lds; LAS int* pre = tot + 8; LAS int* start = tot + 16; LAS int* pos = tot + 32;
    for (int chunk = c; chunk < NCHUNK; chunk += G) {
        { int t = 0, p = 0;
#pragma unroll
          for (int j = 0; j < NCHUNK / 64; ++j) { const int ch = lane + 64 * j; const int v = CNT[ch * 8 + wid]; t += v; p += (ch < chunk) ? v : 0; }
#pragma unroll
          for (int o = 1; o < 64; o <<= 1) { t += __shfl_xor(t, o); p += __shfl_xor(p, o); }
          if (lane == 0) { tot[wid] = t; pre[wid] = p; } }
        __syncthreads();
        if (tid == 0) { int s = 0; for (int e = 0; e < 8; ++e) { start[e] = s; s += ((tot[e] + 255) >> 8) << 8; } start[8] = s; }
        __syncthreads();
        if (chunk == 0 && tid < 9) meta[tid] = start[tid] >> 8;
        if (wid == 0) {
            int run[8];
#pragma unroll
            for (int e = 0; e < 8; ++e) run[e] = start[e] + pre[e];
#pragma unroll
            for (int hf = 0; hf < 2; ++hf)
#pragma unroll
                for (int k = 0; k < 2; ++k) { const int m = chunk * 128 + hf * 64 + lane; const int e = sel[2 * m + k]; int p = 0;
#pragma unroll
                    for (int ee = 0; ee < 8; ++ee) { const unsigned long long mask = __ballot(e == ee); if (e == ee) p = run[ee] + __popcll(mask & ((1ull << lane) - 1ull)); run[ee] += __popcll(mask); }
                    tok[p] = m; srs[p] = rstd_of(ssq, m); sgw[p] = selw[2 * m + k]; tslot[2 * m + k] = p; pos[(hf * 2 + k) * 64 + lane] = p; }
        }
        __syncthreads();
        for (int q = wid * 32; q < wid * 32 + 32; ++q) { const int p = pos[q]; const int m = chunk * 128 + (q >> 7) * 64 + (q & 63);
            const u32x4* src = (const u32x4*)(hb + (size_t)m * DM); u32x4* dst = (u32x4*)(XG + (size_t)p * DM); dst[lane] = src[lane]; dst[lane + 64] = src[lane + 64]; }
        if (chunk == 0) {
            for (int e = 0; e < 8; ++e) { const int s0 = start[e] + tot[e], s1 = start[e + 1];
                for (int s = s0 + tid; s < s1; s += 512) { tok[s] = 0; srs[s] = 0.f; sgw[s] = 0.f; }
                for (int s = s0 + wid; s < s1; s += 8) { u32x4* dst = (u32x4*)(XG + (size_t)s * DM); dst[lane] = (u32x4){0u, 0u, 0u, 0u}; dst[lane + 64] = (u32x4){0u, 0u, 0u, 0u}; } }
        }
        __syncthreads();
    }
}
}
__global__ void __launch_bounds__(512, 2) k_route_a(const float* h, const float* ssq, const float* gain, const float* rw, const float* rb, int* sel, float* selw, int* CNT) {
    extern __shared__ __attribute__((aligned(16))) unsigned char lds[];
    moe::route_a((LAS unsigned char*)lds, h, ssq, gain, rw, rb, sel, selw, CNT, (int)gridDim.x, (int)blockIdx.x);
}
__global__ void __launch_bounds__(512, 2) k_route_b(const int* sel, const float* selw, const float* ssq, const int* CNT, const bf16* hb, int* tok, float* srs, float* sgw, int* tslot, int* meta, bf16* XG) {
    extern __shared__ __attribute__((aligned(16))) unsigned char lds[];
    moe::route_b((LAS unsigned char*)lds, sel, selw, ssq, CNT, hb, tok, srs, sgw, tslot, meta, XG, (int)gridDim.x, (int)blockIdx.x);
}

extern "C" void kernel_launch(void* const* d_in, const int* in_sizes, int n_in, void* d_out, int out_size, void* d_ws, size_t ws_size, hipStream_t stream) {
    static int ok = 0;
    if (ok == 0) {
        if (n_in != 30 || in_sizes[0] != M * DM || out_size != M * DM || ws_size < WS_END) { fprintf(stderr, "kernel_launch: unexpected shapes (n_in %d, ws %zu < %zu)\n", n_in, ws_size, (size_t)WS_END); ok = -1; return; }
        (void)hipFuncSetAttribute((const void*)k_prologue, hipFuncAttributeMaxDynamicSharedMemorySize, GEMM_LDS);
        (void)hipFuncSetAttribute((const void*)k_convmoe, hipFuncAttributeMaxDynamicSharedMemorySize, GEMM_LDS);
        (void)hipFuncSetAttribute((const void*)k_attn, hipFuncAttributeMaxDynamicSharedMemorySize, GEMM_LDS);
        ok = 1;
    }
    if (ok < 0) return;
    unsigned char* ws = (unsigned char*)d_ws; float* out = (float*)d_out;
    Ptrs P; memset(&P, 0, sizeof(P)); for (int i = 0; i < 30; ++i) P.in[i] = (const float*)d_in[i]; P.out = out; P.ws = ws;
    const float* const* in = P.in;
    (void)hipMemsetAsync(ws + WS_CTL, 0, 1 * MiB, stream);
    bf16* HB = (bf16*)(ws + WS_HB); float* SSQ = (float*)(ws + WS_SSQ); bf16* PB = (bf16*)(ws + WS_PB); bf16* PP = (bf16*)(ws + WS_PP);
    bf16* U = (bf16*)(ws + WS_R + R_U); bf16* YA = (bf16*)(ws + WS_R + R_YA); bf16* YB = (bf16*)(ws + WS_R + R_YB); bf16* MB = (bf16*)(ws + WS_R + R_MB);
    float* NA = (float*)(ws + WS_R + R_NA); float* NU = (float*)(ws + WS_R + R_NU);
    bf16* G = (bf16*)(ws + WS_R + R_G); bf16* XG = (bf16*)(ws + WS_R + R_XG); bf16* GM = (bf16*)(ws + WS_R + R_GM);
    int* SEL = (int*)(ws + WS_SEL); float* SELW = (float*)(ws + WS_SEL + 256 * 1024); int* TSLOT = (int*)(ws + WS_SEL + 512 * 1024);
    int* TOK = (int*)(ws + WS_SLOT); float* SRS = (float*)(ws + WS_SLOT + 320 * 1024); float* SGW = (float*)(ws + WS_SLOT + 640 * 1024); int* META = (int*)(ws + WS_SLOT + 960 * 1024); int* CNT = (int*)(ws + WS_SLOT + 964 * 1024);

    bf16* HBUF[2] = {HB, (bf16*)(ws + WS_HB2)}; float* SBUF[2] = {SSQ, SSQ + (size_t)16 * M}; int hc = 0, sc = 0;
    hipLaunchKernelGGL(k_prologue, dim3(256), dim3(512), GEMM_LDS, stream, P);
    for (int l = 0; l < DEPTH; ++l) {
        hipLaunchKernelGGL(k_convp, dim3(M * PLE / 4 / 256), dim3(256), 0, stream, in[1] + (size_t)l * M * PLE, PB);
        if (l & 1) hipLaunchKernelGGL(k_convmoe, dim3(256), dim3(512), GEMM_LDS, stream, P, l / 2);
        { pg8::EpiInproj E{U, SBUF[sc], in[4] + l * 64, in[5] + l * 64}; launch_gemm(stream, HBUF[hc], (const bf16*)(ws + WS_WIN) + (size_t)l * NIN * DM, DM, mk_static(M, NIN), E); }
        { pg8::EpiStore16 E{PP, DM, 0}; launch_gemm(stream, PB, (const bf16*)(ws + WS_WPP) + (size_t)l * DM * PLE, PLE, mk_static(M, DM), E); }
        hipLaunchKernelGGL(k_attn, dim3(256), dim3(512), GEMM_LDS, stream, (const bf16*)U, YA, in[6] + l * 16, in[7]);
        { const bf16* Wt = (const bf16*)(ws + WS_LRUW) + (size_t)l * 2 * 16 * 64 * 64; float* AGG = (float*)(ws + WS_R + R_NA);
          hipLaunchKernelGGL(k_lru<1>, dim3(256), dim3(512), 16384, stream, (const bf16*)U, YB, AGG, Wt, in[8] + l * 4 * DM, in[9] + l * DM, in[11] + l * DM, in[13] + l * DM, in[14] + l * DM);
          hipLaunchKernelGGL(k_lru<2>, dim3(256), dim3(512), 16384, stream, (const bf16*)U, YB, AGG, Wt, in[8] + l * 4 * DM, in[9] + l * DM, in[11] + l * DM, in[13] + l * DM, in[14] + l * DM); }
        { pg8::MergeOrder S; memset(&S, 0, sizeof(S)); S.A1 = YB; S.Bt1 = (const bf16*)(ws + WS_WPB) + (size_t)l * DM * DM; S.so = mk_static(M, DM);
          pg8::EpiMerge E{MB, U}; launch_gemm(stream, YA, (const bf16*)(ws + WS_WPA) + (size_t)l * DM * DM, DM, S, E); }
        { pg8::EpiResid<0> E{l == 0 ? in[0] : (const float*)out, out, HBUF[hc], SBUF[1 - sc], nullptr, nullptr}; launch_gemm(stream, MB, (const bf16*)(ws + WS_WOUT) + (size_t)l * DM * DM, DM, mk_static(M, DM), E); sc ^= 1; }
        if (!(l & 1)) {
            { pg8::EpiSwiglu<false> E{G, SBUF[sc], nullptr, nullptr}; launch_gemm(stream, HBUF[hc], (const bf16*)(ws + WS_W13D) + (size_t)(l / 2) * 2 * DFF * DM, DM, mk_static(M, 2 * DFF), E); }
            { pg8::EpiResid<0> E{(const float*)out, out, HBUF[hc], SBUF[1 - sc], nullptr, nullptr}; launch_gemm(stream, G, (const bf16*)(ws + WS_W2D) + (size_t)(l / 2) * DM * DFF, DFF, mk_static(M, DM), E); sc ^= 1; }
        } else {
            hipLaunchKernelGGL(k_route_a, dim3(256), dim3(512), 4096, stream, (const float*)out, (const float*)SBUF[sc], in[18] + l * DM, in[22] + (size_t)(l / 2) * DM * NEXP, in[23] + (l / 2) * NEXP, SEL, SELW, CNT);
            hipLaunchKernelGGL(k_route_b, dim3(256), dim3(512), 4096, stream, (const int*)SEL, (const float*)SELW, (const float*)SBUF[sc], (const int*)CNT, (const bf16*)HBUF[hc], TOK, SRS, SGW, TSLOT, META, XG);
            { pg8::EpiSwiglu<true> E{GM, nullptr, SRS, SGW}; launch_gemm(stream, XG, (const bf16*)(ws + WS_W13E), DM, mk_moe(META, (size_t)2 * DFF * DM, 2 * DFF), E); }
            { pg8::EpiStore16 E{XG, DM, 0}; launch_gemm(stream, GM, (const bf16*)(ws + WS_W2E), DFF, mk_moe(META, (size_t)DM * DFF, DM), E); }
            hipLaunchKernelGGL(k_combine, dim3(M / 4), dim3(256), 0, stream, out, (const bf16*)XG, (const int*)TSLOT, HBUF[hc], SBUF[1 - sc]); sc ^= 1;
        }
        { pg8::EpiResid<1> E{(const float*)out, out, HBUF[1 - hc], SBUF[1 - sc], PP, SBUF[sc]}; launch_gemm(stream, HBUF[hc], (const bf16*)(ws + WS_WPG) + (size_t)l * DM * DM, DM, mk_static(M, DM), E); sc ^= 1; hc ^= 1; }
    }
}
```

```cpp
#include <hip/hip_runtime.h>
#include <cstdio>
#include <cstdint>
#include <cstring>

#define LAS __attribute__((address_space(3)))
#define GAS __attribute__((address_space(1)))
typedef unsigned short bf16;
typedef short bf16x8 __attribute__((ext_vector_type(8)));
typedef float f32x4 __attribute__((ext_vector_type(4)));
typedef float f32x2 __attribute__((ext_vector_type(2)));
typedef unsigned u32x4 __attribute__((ext_vector_type(4)));
typedef unsigned u32x2 __attribute__((ext_vector_type(2)));

constexpr int BATCH = 8, SEQ = 4096, DM = 1024, DEPTH = 4, M = BATCH * SEQ;
constexpr int NIN = 5632, C_Q = 0, C_K = 1024, C_V = 1280, C_LX = 1536, C_LG = 2560, C_GA = 3584, C_GB = 4608;
constexpr int DFF = 3584, NEXP = 8, PLE = 256;
constexpr int NSLOT = 67584;
constexpr bool INPROJ_GATES_FP8 = false;
constexpr int NIN_A = C_LG, NIN_B = NIN - C_LG;
constexpr int INPROJ_FP8_MASK = 12;
constexpr int OUT_FP8_MASK = 12, MERGE_FP8_MASK = 12;
constexpr float Y8_SCALE = 8.f, MB8_SCALE = 16.f;
constexpr int PLE_FP8_MASK = 8;
constexpr bool INPROJ_FP8 = false;
constexpr float WIN_SCALE = 64.f;
constexpr int DENSE_FP8_MASK = 2;
constexpr bool MOE_FP8 = true;
constexpr bool LRU_FUSED = true;
constexpr size_t CTL_LRUFLAG = 262144;
static_assert(MOE_FP8 || !(INPROJ_FP8 || INPROJ_GATES_FP8), "WS_HB8 lives in the free half of the fp8 expert-weight region");
constexpr float W13_SCALE = 64.f, W2_SCALE = 128.f, G8_SCALE = 8.f;
constexpr float EPS = 1e-6f, LOG2E = 1.4426950408889634f, QSCALE = 0.125f * LOG2E;

constexpr size_t MiB = 1u << 20;
constexpr size_t WS_CTL = 0;
constexpr size_t WS_WIN = 1 * MiB;
constexpr size_t WS_WPA = 45 * MiB, WS_WPB = 53 * MiB, WS_WOUT = 61 * MiB, WS_WPG = 69 * MiB;
constexpr size_t WS_WPP = 77 * MiB;
constexpr size_t WS_W13D = 79 * MiB;
constexpr size_t WS_W2D = 107 * MiB;
constexpr size_t WS_LRUW = 121 * MiB;
constexpr size_t WS_W13E = 122 * MiB;
constexpr size_t WS_HB8 = 178 * MiB;
constexpr size_t WS_W2E = 234 * MiB;
constexpr size_t WS_PB = 290 * MiB;
constexpr size_t WS_HB = 306 * MiB;
constexpr size_t WS_SSQ = 370 * MiB;
constexpr size_t WS_SEL = 374 * MiB;
constexpr size_t WS_SLOT = 375 * MiB;
constexpr size_t WS_PP = 376 * MiB;
constexpr size_t WS_HB2 = 440 * MiB;
constexpr size_t WS_R = 504 * MiB;
constexpr size_t R_U = 0, R_YA = 352 * MiB, R_YB = 416 * MiB, R_MB = 480 * MiB, R_NA = 544 * MiB, R_NU = 576 * MiB;
constexpr size_t R_HR = R_MB, R_PQ = R_NA;
constexpr size_t WS_AGG = WS_SEL;
constexpr size_t R_G = 0;
constexpr size_t R_XG = 0, R_XG8 = 0, R_GM = 132 * MiB;
constexpr size_t WS_END = WS_R + 608 * MiB;

__host__ __device__ __forceinline__ float bf2f(bf16 x) { return __builtin_bit_cast(float, (unsigned)x << 16); }
__host__ __device__ __forceinline__ bf16 f2bf(float f) { unsigned u = __builtin_bit_cast(unsigned, f); return (bf16)((u + 0x7fffu + ((u >> 16) & 1u)) >> 16); }
__device__ __forceinline__ unsigned pk2(float lo, float hi) { return (unsigned)f2bf(lo) | ((unsigned)f2bf(hi) << 16); }
__device__ __forceinline__ float fast_exp(float x) { return __builtin_amdgcn_exp2f(x * LOG2E); }
__device__ __forceinline__ float sigmoidf_(float x) { return 1.f / (1.f + fast_exp(-x)); }
__device__ __forceinline__ float gelu_tanh(float x) { const float z = 0.7978845608028654f * (x + 0.044715f * x * x * x); return x / (1.f + fast_exp(-2.f * z)); }
__device__ __forceinline__ int lane_id() { unsigned ones = ~0u; asm volatile("" : "+s"(ones)); return (int)__builtin_amdgcn_mbcnt_hi(ones, __builtin_amdgcn_mbcnt_lo(ones, 0u)); }
__device__ __forceinline__ int opaque_tid(int wbase) { int t = wbase + lane_id(); asm volatile("" : "+v"(t)); return t; }
__device__ __forceinline__ int opaque_s(int x) { asm volatile("" : "+s"(x)); return x; }
__device__ __forceinline__ float opaque_f(float x) { asm volatile("" : "+v"(x)); return x; }
__device__ __forceinline__ unsigned opaque_u(unsigned x) { asm volatile("" : "+v"(x)); return x; }
template <int MASK> __device__ __forceinline__ float swz_f(float v) { return __builtin_bit_cast(float, __builtin_amdgcn_ds_swizzle(__builtin_bit_cast(int, v), (MASK << 10) | 0x1f)); }
template <int MASK> __device__ __forceinline__ int swz_i(int v) { return __builtin_amdgcn_ds_swizzle(v, (MASK << 10) | 0x1f); }
__device__ __forceinline__ float sum_x32(float v) { const unsigned u = __builtin_bit_cast(unsigned, v); auto rr = __builtin_amdgcn_permlane32_swap(u, u, false, false); return __builtin_bit_cast(float, (unsigned)rr[0]) + __builtin_bit_cast(float, (unsigned)rr[1]); }
__device__ __forceinline__ float max_x32(float v) { const unsigned u = __builtin_bit_cast(unsigned, v); auto rr = __builtin_amdgcn_permlane32_swap(u, u, false, false); return fmaxf(__builtin_bit_cast(float, (unsigned)rr[0]), __builtin_bit_cast(float, (unsigned)rr[1])); }
__device__ __forceinline__ int sum_x32i(int v) { auto rr = __builtin_amdgcn_permlane32_swap((unsigned)v, (unsigned)v, false, false); return (int)rr[0] + (int)rr[1]; }
__device__ __forceinline__ float get_x32(float v, int hi) { const unsigned u = __builtin_bit_cast(unsigned, v); auto rr = __builtin_amdgcn_permlane32_swap(u, u, false, false); return __builtin_bit_cast(float, hi ? (unsigned)rr[0] : (unsigned)rr[1]); }
__device__ __forceinline__ float wave_sum(float v) {
    v += swz_f<1>(v); v += swz_f<2>(v); v += swz_f<4>(v); v += swz_f<8>(v); v += swz_f<16>(v);
    return sum_x32(v);
}
__device__ __forceinline__ float rstd_of(const float* ssq, int m) {
    const f32x4* p = (const f32x4*)(ssq + 16 * (size_t)m); const f32x4 a = p[0], b = p[1], c = p[2], d = p[3];
    const float s = (((a.x + a.y) + (a.z + a.w)) + ((b.x + b.y) + (b.z + b.w))) + (((c.x + c.y) + (c.z + c.w)) + ((d.x + d.y) + (d.z + d.w)));
    return __builtin_amdgcn_rsqf(s * (1.f / 1024.f) + EPS);
}
__device__ __forceinline__ unsigned cvt_pk_bf16(float lo, float hi) { unsigned r; asm volatile("v_cvt_pk_bf16_f32 %0, %1, %2" : "=v"(r) : "v"(lo), "v"(hi)); return r; }
__device__ __forceinline__ unsigned pk4_fp8(float a, float b, float c, float d) {
    a = __builtin_amdgcn_fmed3f(a, -448.f, 448.f); b = __builtin_amdgcn_fmed3f(b, -448.f, 448.f); c = __builtin_amdgcn_fmed3f(c, -448.f, 448.f); d = __builtin_amdgcn_fmed3f(d, -448.f, 448.f);
    int w = __builtin_bit_cast(int, a); w = __builtin_amdgcn_cvt_pk_fp8_f32(a, b, w, false);
    w = __builtin_amdgcn_cvt_pk_fp8_f32(c, d, w, true); return (unsigned)w; }
__device__ __forceinline__ float fast_sigmoid(float x) { return __builtin_amdgcn_rcpf(1.f + __builtin_amdgcn_exp2f(-LOG2E * x)); }
__device__ __forceinline__ float fast_gelu_tanh(float x) { const float z = (2.f * 0.7978845608028654f * LOG2E) * (x + 0.044715f * x * x * x); return x * __builtin_amdgcn_rcpf(1.f + __builtin_amdgcn_exp2f(-z)); }
__device__ __forceinline__ f32x4 unpack_lo(u32x2 w) { return (f32x4){__builtin_bit_cast(float, w.x << 16), __builtin_bit_cast(float, w.x & 0xffff0000u), __builtin_bit_cast(float, w.y << 16), __builtin_bit_cast(float, w.y & 0xffff0000u)}; }

namespace pg8 {
typedef unsigned short bf16_t;
constexpr int BM = 256, BK = 64, HALF = 128, HTB = HALF * BK * 2, STAGE_BYTES = 8 * HTB, NXCD = 8, WGM = 8;
__host__ __device__ __forceinline__ int lds_byte(int r, int c) { const int st = (r >> 4) * 2 + (c >> 5), rr = r & 15, cc = c & 31, ob = rr * 64 + cc * 2; return st * 1024 + (ob ^ (((ob >> 9) & 1) << 5)); }
__host__ __device__ __forceinline__ void stage_rc(int b, int& R, int& C) { const int st = b / 1024, sb = b % 1024, swz = sb ^ (((sb >> 9) & 1) << 5); R = (st >> 1) * 16 + swz / 64; C = (st & 1) * 32 + (swz % 64) / 2; }
__host__ __device__ __forceinline__ int perm32(int rho) { const int n = rho >> 4, i = rho & 15; return 8 * (i >> 2) + 4 * n + (i & 3); }

struct Unit { int pm, pn, part; };
struct Gemm { const bf16_t* A; const bf16_t* Bt; int K; int pad; };

struct StaticOrder {
    int nM, nN, nwg, G, c, pad;
    __host__ __device__ void init(int M_, int N_, int G_, int c_) { nM = M_ / BM; nN = N_ / BM; nwg = nM * nN; G = G_; c = c_; pad = 0; }
    __device__ __forceinline__ void setup(int G_, int c_) { G = G_; c = c_; }
    __host__ __device__ bool next(int i, Unit& u) const {
        const int L = i * G + c; if (L >= nwg) return false;
        int wgid = L; { const int q = nwg / NXCD, r = nwg % NXCD, xcd = wgid % NXCD, off = wgid / NXCD; wgid = (xcd < r ? xcd * (q + 1) : r * (q + 1) + (xcd - r) * q) + off; }
        const int nig = WGM * nN, gid = wgid / nig, fm = gid * WGM, gsz = (nM - fm) < WGM ? (nM - fm) : WGM;
        u.pm = fm + ((wgid % nig) % gsz); u.pn = (wgid % nig) / gsz; u.part = 0; return true;
    }
    static constexpr bool TWO = false;
    __device__ __forceinline__ unsigned a_off(const Unit& u, const Gemm& g) const { return (unsigned)u.pm * (unsigned)(BM * 2) * (unsigned)g.K; }
    __device__ __forceinline__ unsigned b_off(const Unit& u, const Gemm& g) const { return (unsigned)u.pn * (unsigned)(BM * 2) * (unsigned)g.K; }
    __device__ __forceinline__ void a_ready(const Unit&) const {}
    __device__ __forceinline__ void done(const Unit&) const {}
};
struct MoeOrder {
    const int* meta; size_t wstride; int N, pad0;
    StaticOrder so; int ts[10];
    __device__ __forceinline__ void setup(int G_, int c_) {
#pragma unroll
        for (int e = 0; e < 9; ++e) ts[e] = __builtin_amdgcn_readfirstlane(__hip_atomic_load(meta + e, __ATOMIC_RELAXED, __HIP_MEMORY_SCOPE_AGENT));
        so.init(ts[8] * BM, N, G_, c_);
    }
    __device__ __forceinline__ bool next(int i, Unit& u) const { return so.next(i, u); }
    static constexpr bool TWO = false;
    __device__ __forceinline__ unsigned a_off(const Unit& u, const Gemm& g) const { return (unsigned)u.pm * (unsigned)(BM * 2) * (unsigned)g.K; }
    __device__ __forceinline__ unsigned b_off(const Unit& u, const Gemm& g) const {
        int e = 0;
#pragma unroll
        for (int j = 1; j < 8; ++j) e += (u.pm >= ts[j]) ? 1 : 0;
        return (unsigned)e * (unsigned)(wstride * 2) + (unsigned)u.pn * (unsigned)(BM * 2) * (unsigned)g.K;
    }
    __device__ __forceinline__ void a_ready(const Unit&) const {}
    __device__ __forceinline__ void done(const Unit&) const {}
};

#define EPI_ROWS(ai, m) (u.pm * BM + (ai) * HALF + wr * 64 + (m) * 16 + fr)
__device__ __forceinline__ float rstd_q(const float* ssq, int row, int fq) {
    const f32x4 p = *(const f32x4*)(ssq + 16 * (size_t)row + 4 * fq); float s = (p.x + p.y) + (p.z + p.w); s += swz_f<16>(s); s = sum_x32(s);
    return __builtin_amdgcn_rsqf(s * (1.f / 1024.f) + EPS);
}
__device__ __forceinline__ u32x4 pack8(const f32x4 a, const f32x4 b) { u32x4 w; w.x = cvt_pk_bf16(a[0], a[1]); w.y = cvt_pk_bf16(a[2], a[3]); w.z = cvt_pk_bf16(b[0], b[1]); w.w = cvt_pk_bf16(b[2], b[3]); return w; }
__device__ __forceinline__ void unpack8(const u32x4 w, f32x4& a, f32x4& b) {
    a = (f32x4){__builtin_bit_cast(float, w.x << 16), __builtin_bit_cast(float, w.x & 0xffff0000u), __builtin_bit_cast(float, w.y << 16), __builtin_bit_cast(float, w.y & 0xffff0000u)};
    b = (f32x4){__builtin_bit_cast(float, w.z << 16), __builtin_bit_cast(float, w.z & 0xffff0000u), __builtin_bit_cast(float, w.w << 16), __builtin_bit_cast(float, w.w & 0xffff0000u)}; }
template <bool GATES> struct EpiInproj {
    static constexpr bool PERM = true, AFTER_DRAIN = false, HAS_PRE = false;
    bf16* U; const float* ssq; const float* qg; const float* kg; int pn_off; float ascale;
    __device__ __forceinline__ bool reset(const Unit&) const { return true; }
    __device__ __forceinline__ void operator()(const f32x4 (&acc)[2][2][4][2], const Unit& u, int wr, int wc, int fr, int fq) const {
        const int pn = u.pn + pn_off, type = GATES ? (pn < 14 ? 3 : 4) : (pn < 4 ? 0 : pn == 4 ? 1 : pn < 10 ? 2 : pn < 14 ? 3 : 4);
        const float* gp = (type == 0 ? qg : kg) + 8 * fq; const float gsc = type == 0 ? QSCALE : 1.f;
        float rs8[2][4];
#pragma unroll
        for (int ai = 0; ai < 2; ++ai)
#pragma unroll
            for (int m = 0; m < 4; ++m) rs8[ai][m] = rstd_q(ssq, EPI_ROWS(ai, m), fq) * ascale;
#pragma unroll
        for (int ai = 0; ai < 2; ++ai)
#pragma unroll
            for (int m = 0; m < 4; ++m) { const int row = EPI_ROWS(ai, m); const float rs = rs8[ai][m]; f32x4 v[2][2];
#pragma unroll
                for (int bj = 0; bj < 2; ++bj)
#pragma unroll
                    for (int n = 0; n < 2; ++n) v[bj][n] = acc[ai][bj][m][n] * rs;
                if (!GATES && type <= 1) { float ss = 0.f;
#pragma unroll
                    for (int bj = 0; bj < 2; ++bj)
#pragma unroll
                        for (int n = 0; n < 2; ++n) ss += (v[bj][n][0] * v[bj][n][0] + v[bj][n][1] * v[bj][n][1]) + (v[bj][n][2] * v[bj][n][2] + v[bj][n][3] * v[bj][n][3]);
                    ss += swz_f<16>(ss); ss = sum_x32(ss);
                    const float r = __builtin_amdgcn_rsqf(ss * (1.f / 64.f) + EPS) * gsc;
#pragma unroll
                    for (int bj = 0; bj < 2; ++bj)
#pragma unroll
                        for (int n = 0; n < 2; ++n) v[bj][n] = v[bj][n] * r * *(const f32x4*)(gp + 32 * bj + 4 * n);
                } else if (type == 3) {
#pragma unroll
                    for (int bj = 0; bj < 2; ++bj)
#pragma unroll
                        for (int n = 0; n < 2; ++n)
#pragma unroll
                            for (int e = 0; e < 4; ++e) v[bj][n][e] = fast_gelu_tanh(v[bj][n][e]);
                } else if (type == 4) {
#pragma unroll
                    for (int bj = 0; bj < 2; ++bj)
#pragma unroll
                        for (int n = 0; n < 2; ++n)
#pragma unroll
                            for (int e = 0; e < 4; ++e) v[bj][n][e] = fmaxf(fast_sigmoid(v[bj][n][e]), 5.9604645e-8f);
                }
                bf16* rowp = U + (size_t)row * NIN + pn * BM + 64 * wc + 8 * fq;
#pragma unroll
                for (int bj = 0; bj < 2; ++bj) *(u32x4*)(rowp + 32 * bj) = pack8(v[bj][0], v[bj][1]);
            }
    }
};
struct EpiStore16 {
    static constexpr bool PERM = true, AFTER_DRAIN = false, HAS_PRE = false;
    bf16* O; int ld; float scale;
    __device__ __forceinline__ bool reset(const Unit&) const { return true; }
    __device__ __forceinline__ void operator()(const f32x4 (&acc)[2][2][4][2], const Unit& u, int wr, int wc, int fr, int fq) const {
#pragma unroll
        for (int ai = 0; ai < 2; ++ai)
#pragma unroll
            for (int m = 0; m < 4; ++m) { bf16* rowp = O + (size_t)EPI_ROWS(ai, m) * ld + u.pn * BM + wc * 32 + 8 * fq;
#pragma unroll
                for (int bj = 0; bj < 2; ++bj) *(u32x4*)(rowp + bj * HALF) = pack8(acc[ai][bj][m][0] * scale, acc[ai][bj][m][1] * scale); }
    }
};
template <bool F8> struct EpiMerge {
    static constexpr bool PERM = true, AFTER_DRAIN = false, HAS_PRE = false;
    bf16* MB; const bf16* U; float oscale; int pad_;
    __device__ __forceinline__ bool reset(const Unit& u) const { return u.part != 0; }
    __device__ __forceinline__ void operator()(f32x4 (&acc)[2][2][4][2], const Unit& u, int wr, int wc, int fr, int fq) const {
#pragma unroll
        for (int ai = 0; ai < 2; ++ai)
#pragma unroll
        for (int mb = 0; mb < 4; mb += 2) {
            u32x4 gbv[4][2], gav[4][2];
#pragma unroll
            for (int m = mb; m < mb + 2; ++m) { const int row = EPI_ROWS(ai, m);
#pragma unroll
                for (int bj = 0; bj < 2; ++bj) { const int col = u.pn * BM + bj * HALF + wc * 32 + 8 * fq; gbv[m][bj] = *(const u32x4*)(U + (size_t)row * NIN + C_GB + col);
                    if (u.part == 0) gav[m][bj] = *(const u32x4*)(U + (size_t)row * NIN + C_GA + col); } }
#pragma unroll
            for (int m = mb; m < mb + 2; ++m) { const int row = EPI_ROWS(ai, m);
#pragma unroll
                for (int bj = 0; bj < 2; ++bj) { const int col = u.pn * BM + bj * HALF + wc * 32 + 8 * fq;
                    f32x4 b0, b1; unpack8(gbv[m][bj], b0, b1);
                    if (u.part == 0) { f32x4 a0, a1; unpack8(gav[m][bj], a0, a1);
#pragma unroll
                        for (int e = 0; e < 4; ++e) { acc[ai][bj][m][0][e] *= a0[e] * __builtin_amdgcn_rcpf(b0[e]); acc[ai][bj][m][1][e] *= a1[e] * __builtin_amdgcn_rcpf(b1[e]); }
                    } else if (!F8) *(u32x4*)(MB + (size_t)row * DM + col) = pack8(acc[ai][bj][m][0] * b0, acc[ai][bj][m][1] * b1);
                    else { const f32x4 o0 = acc[ai][bj][m][0] * b0 * oscale, o1 = acc[ai][bj][m][1] * b1 * oscale;
                        { u32x2 w8; w8.x = pk4_fp8(o0[0], o0[1], o0[2], o0[3]); w8.y = pk4_fp8(o1[0], o1[1], o1[2], o1[3]); *(u32x2*)((unsigned char*)MB + (size_t)row * DM + col) = w8; }
                    }
                } }
        }
    }
};
template <int MODE, int MBAT_ = (MODE == 1 ? 2 : 4)> struct EpiResid {
    static constexpr bool PERM = true, AFTER_DRAIN = false, HAS_PRE = false;
    const bf16* hin; bf16* hout; float* outf; float* ssq_out; const bf16* PP; const float* ssq_in; unsigned char* h8; float ascale; int pad_;
    __device__ __forceinline__ bool reset(const Unit&) const { return true; }
    __device__ __forceinline__ void operator()(const f32x4 (&acc)[2][2][4][2], const Unit& u, int wr, int wc, int fr, int fq) const {
        constexpr int MBAT = MBAT_;
#pragma unroll
        for (int ai = 0; ai < 2; ++ai)
#pragma unroll
        for (int mb = 0; mb < 4; mb += MBAT) {
            u32x4 hv[4][2], pv[4][2]; float rs4[4];
#pragma unroll
            for (int m = mb; m < mb + MBAT; ++m) { const int row = EPI_ROWS(ai, m); rs4[m] = 0.f; if (MODE == 1) rs4[m] = rstd_q(ssq_in, row, fq) * ascale;
#pragma unroll
                for (int bj = 0; bj < 2; ++bj) { const size_t off = (size_t)row * DM + u.pn * BM + bj * HALF + wc * 32 + 8 * fq; hv[m][bj] = *(const u32x4*)(hin + off); if (MODE == 1) pv[m][bj] = *(const u32x4*)(PP + off); } }
#pragma unroll
            for (int m = mb; m < mb + MBAT; ++m) { const int row = EPI_ROWS(ai, m); const float rs = rs4[m]; float ss = 0.f;
#pragma unroll
                for (int bj = 0; bj < 2; ++bj) { const size_t off = (size_t)row * DM + u.pn * BM + bj * HALF + wc * 32 + 8 * fq;
                    f32x4 v0, v1; unpack8(hv[m][bj], v0, v1); const f32x4 a0 = acc[ai][bj][m][0], a1 = acc[ai][bj][m][1];
                    if (MODE == 0) { v0 = v0 + a0 * ascale; v1 = v1 + a1 * ascale; }
                    else { f32x4 p0, p1; unpack8(pv[m][bj], p0, p1);
#pragma unroll
                        for (int e = 0; e < 4; ++e) { v0[e] += fast_sigmoid(a0[e] * rs) * p0[e]; v1[e] += fast_sigmoid(a1[e] * rs) * p1[e]; } }
                    if (outf) { *(f32x4*)(outf + off) = v0; *(f32x4*)(outf + off + 4) = v1; }
                    else *(u32x4*)(hout + off) = pack8(v0, v1);
                    if (h8) { u32x2 w8; w8.x = pk4_fp8(v0[0], v0[1], v0[2], v0[3]); w8.y = pk4_fp8(v1[0], v1[1], v1[2], v1[3]); *(u32x2*)(h8 + off) = w8; }
                    ss += ((v0[0] * v0[0] + v0[1] * v0[1]) + (v0[2] * v0[2] + v0[3] * v0[3])) + ((v1[0] * v1[0] + v1[1] * v1[1]) + (v1[2] * v1[2] + v1[3] * v1[3])); }
                ss += swz_f<16>(ss); ss = sum_x32(ss);
                if (fq == 0) ssq_out[(size_t)row * 16 + u.pn * 4 + wc] = ss; }
        }
    }
};
template <bool MOE> struct EpiSwiglu {
    static constexpr bool PERM = true, AFTER_DRAIN = false, HAS_PRE = MOE && MOE_FP8;
    __device__ __forceinline__ void pre_load(float (&pre)[8], const Unit& u, int wr) const { const int fr = lane_id() & 15;
#pragma unroll
        for (int ai = 0; ai < 2; ++ai)
#pragma unroll
            for (int m = 0; m < 4; ++m) { const unsigned o4 = (unsigned)EPI_ROWS(ai, m) * 4u; asm volatile("global_load_dword %0, %1, %2" : "=v"(pre[ai * 4 + m]) : "v"(o4), "s"(sgw) : "memory"); } }
    bf16* G; const float* ssq; const float* srs; const float* sgw; int f8; float ascale;
    __device__ __forceinline__ bool reset(const Unit&) const { return true; }
    __device__ __forceinline__ void operator()(const f32x4 (&acc)[2][2][4][2], const Unit& u, int wr, int wc, int fr, int fq, const float* pre = nullptr) const {
        float rs8[2][4], gw8[2][4];
#pragma unroll
        for (int ai = 0; ai < 2; ++ai)
#pragma unroll
            for (int m = 0; m < 4; ++m) { const int row = EPI_ROWS(ai, m); float rs, gw = 1.f;
                if (MOE) { rs = (MOE_FP8 ? opaque_f(1.f / W13_SCALE) : srs[row]); gw = (HAS_PRE ? pre[ai * 4 + m] : sgw[row]) * (MOE_FP8 ? G8_SCALE : 1.f); } else { rs = rstd_q(ssq, row, fq) * ascale; if (f8) gw = G8_SCALE; }
                rs8[ai][m] = rs; gw8[ai][m] = gw; }
#pragma unroll
        for (int ai = 0; ai < 2; ++ai)
#pragma unroll
            for (int m = 0; m < 4; ++m) { const int row = EPI_ROWS(ai, m); const float rs = rs8[ai][m], gw = gw8[ai][m];
                const float rs2 = rs * gw; f32x4 o[2];
#pragma unroll
                for (int bj = 0; bj < 2; ++bj)
#pragma unroll
                    for (int e = 0; e < 4; ++e) { const float a = acc[ai][bj][m][0][e] * rs, b = acc[ai][bj][m][1][e] * rs2; o[bj][e] = a * fast_sigmoid(a) * b; }
                if ((MOE && MOE_FP8) || (!MOE && f8)) { u32x2 w; w.x = pk4_fp8(o[0][0], o[0][1], o[0][2], o[0][3]); w.y = pk4_fp8(o[1][0], o[1][1], o[1][2], o[1][3]);
                    *(u32x2*)((unsigned char*)G + (size_t)row * DFF + u.pn * HALF + wc * 32 + 8 * fq) = w; }
                else *(u32x4*)(G + (size_t)row * DFF + u.pn * HALF + wc * 32 + 8 * fq) = pack8(o[0], o[1]); }
    }
};
struct MergeOrder {
    const bf16_t* A1; const bf16_t* Bt1; StaticOrder so;
    __device__ __forceinline__ void setup(int G_, int c_) { so.setup(G_, c_); }
    __device__ __forceinline__ bool next(int i, Unit& u) const { const bool ok = so.next(i >> 1, u); u.part = i & 1; return ok; }
    static constexpr bool TWO = true;
    __device__ __forceinline__ unsigned a_off(const Unit& u, const Gemm& g) const { return (unsigned)u.pm * (unsigned)(BM * 2) * (unsigned)g.K; }
    __device__ __forceinline__ unsigned b_off(const Unit& u, const Gemm& g) const { return (unsigned)u.pn * (unsigned)(BM * 2) * (unsigned)g.K; }
    __device__ __forceinline__ void a_ready(const Unit&) const {}
    __device__ __forceinline__ void done(const Unit&) const {}
};

typedef int v8i_t __attribute__((ext_vector_type(8)));
__device__ __forceinline__ v8i_t cat8(const bf16x8 a, const bf16x8 b) { const u32x4 x = __builtin_bit_cast(u32x4, a), y = __builtin_bit_cast(u32x4, b); return (v8i_t){(int)x.x, (int)x.y, (int)x.z, (int)x.w, (int)y.x, (int)y.y, (int)y.z, (int)y.w}; }
template <class Epi, class Sched, bool ALIGN_EPI = false, bool SP2 = false, bool FP8 = false>
__device__ __forceinline__ void gemm_phase(LAS unsigned char* lds, const Gemm g, const Sched& S, const Epi& E, int wbase) {
    const int tid = opaque_tid(wbase), wid = __builtin_amdgcn_readfirstlane(tid >> 6), lane = tid & 63, wr = wid >> 2, wc = wid & 3, fr = lane & 15, fq = lane >> 4;
    const int K = opaque_s(g.K), nt = K / BK;
    unsigned voffA[2], voffB[2];
#pragma unroll
    for (int i = 0; i < 2; ++i) { int R, C; stage_rc(tid * 16 + i * 8192, R, C); const int Rb = Epi::PERM ? ((R & ~31) + perm32(R & 31)) : R;
        voffA[i] = (unsigned)(R * K + C) * 2u; voffB[i] = (unsigned)(Rb * K + C) * 2u; }
    const unsigned kstep = (unsigned)(BK * 2);
    const unsigned hstep = (unsigned)HALF * (unsigned)K * 2u;
    typedef __amdgpu_buffer_rsrc_t rsrc_t;
    const rsrc_t rA0 = __builtin_amdgcn_make_buffer_rsrc((void*)g.A, 0, 0xffffffff, 0x00020000), rB0 = __builtin_amdgcn_make_buffer_rsrc((void*)g.Bt, 0, 0xffffffff, 0x00020000);
    rsrc_t rA1 = rA0, rB1 = rB0;
    if constexpr (Sched::TWO) { rA1 = __builtin_amdgcn_make_buffer_rsrc((void*)S.A1, 0, 0xffffffff, 0x00020000); rB1 = __builtin_amdgcn_make_buffer_rsrc((void*)S.Bt1, 0, 0xffffffff, 0x00020000); }
    const unsigned ldsw = (unsigned)wid * 1024u;
    const int aoff = lds_byte(wr * 64 + fr, fq * 8), boff = lds_byte(wc * 32 + fr, fq * 8);
#define PG8_SA(b, h) (((b) * 2 + (h)) * HTB)
#define PG8_SB(b, h) ((4 + (b) * 2 + (h)) * HTB)
#define PG8_STAGE(bufoff, rs_, soff_, voff) do { _Pragma("unroll") for (int _i = 0; _i < 2; ++_i) \
        __builtin_amdgcn_raw_ptr_buffer_load_lds(rs_, (LAS void*)(lds + (bufoff) + ldsw + _i * 8192), 16, (int)(voff)[_i], (int)(soff_), 0, 0); } while (0)
#define PG8_LD2(p_) cat8(*(const LAS bf16x8*)(p_), *(const LAS bf16x8*)((p_) + 1024))
#define PG8_LDA(dst, b, h) do { _Pragma("unroll") for (int m = 0; m < 4; ++m) dst[m] = PG8_LD2(lds + PG8_SA(b, h) + aoff + m * 2048); } while (0)
#define PG8_LDB(dst, b, h) do { _Pragma("unroll") for (int n = 0; n < 2; ++n) dst[n] = PG8_LD2(lds + PG8_SB(b, h) + boff + n * 2048); } while (0)
#define PG8_LO(v_) __builtin_bit_cast(bf16x8, __builtin_shufflevector(v_, v_, 0, 1, 2, 3))
#define PG8_HI(v_) __builtin_bit_cast(bf16x8, __builtin_shufflevector(v_, v_, 4, 5, 6, 7))
#define PG8_MMA(ai, bj, At, Bt) do { __builtin_amdgcn_s_setprio(1); \
        if constexpr (FP8) { _Pragma("unroll") for (int m = 0; m < 4; ++m) _Pragma("unroll") for (int n = 0; n < 2; ++n) \
            acc[ai][bj][m][n] = __builtin_amdgcn_mfma_scale_f32_16x16x128_f8f6f4(Bt[n], At[m], acc[ai][bj][m][n], 0, 0, 0, 0x7f7f7f7f, 0, 0x7f7f7f7f); } \
        else { _Pragma("unroll") for (int m = 0; m < 4; ++m) _Pragma("unroll") for (int n = 0; n < 2; ++n) { \
            acc[ai][bj][m][n] = __builtin_amdgcn_mfma_f32_16x16x32_bf16(PG8_LO(Bt[n]), PG8_LO(At[m]), acc[ai][bj][m][n], 0, 0, 0); \
            acc[ai][bj][m][n] = __builtin_amdgcn_mfma_f32_16x16x32_bf16(PG8_HI(Bt[n]), PG8_HI(At[m]), acc[ai][bj][m][n], 0, 0, 0); } } \
        __builtin_amdgcn_s_setprio(0); } while (0)
#define PG8_WAIT_V(n) asm volatile("s_waitcnt vmcnt(" #n ")" ::: "memory")
#define PG8_WAIT_L(n) asm volatile("s_waitcnt lgkmcnt(" #n ")" ::: "memory")
#define PG8_BAR __builtin_amdgcn_s_barrier()
#define PG8_SCHED __builtin_amdgcn_sched_barrier(0)
    Unit cur, nxt; int ui = 0;
    if (!S.next(0, cur)) return;
    f32x4 acc[2][2][4][2];
#define PG8_ZERO_ACC() do { float z_; asm volatile("v_mov_b32 %0, 0" : "=v"(z_)); _Pragma("unroll") for (int a = 0; a < 2; ++a) _Pragma("unroll") for (int b = 0; b < 2; ++b) _Pragma("unroll") for (int m = 0; m < 4; ++m) \
        _Pragma("unroll") for (int n = 0; n < 2; ++n) acc[a][b][m][n] = (f32x4){z_, z_, z_, z_}; } while (0)
    PG8_ZERO_ACC();
    v8i_t At[4], B0[2], B1[2];
    unsigned cA = S.a_off(cur, g), cB = S.b_off(cur, g); rsrc_t rAc = (Sched::TWO && cur.part) ? rA1 : rA0, rBc = (Sched::TWO && cur.part) ? rB1 : rB0;
    S.a_ready(cur);
    if constexpr (SP2) {
        PG8_STAGE(PG8_SB(0, 0), rBc, cB, voffB); PG8_STAGE(PG8_SB(0, 1), rBc, cB + hstep, voffB); PG8_STAGE(PG8_SA(0, 0), rAc, cA, voffA); PG8_STAGE(PG8_SA(0, 1), rAc, cA + hstep, voffA);
        if (wr == 1) PG8_BAR;
        PG8_WAIT_V(2); PG8_BAR;
        PG8_STAGE(PG8_SB(1, 0), rBc, cB + kstep, voffB); PG8_STAGE(PG8_SA(1, 0), rAc, cA + kstep, voffA); PG8_STAGE(PG8_SB(1, 1), rBc, cB + hstep + kstep, voffB);
        PG8_WAIT_V(6); PG8_BAR;
    } else {
        PG8_STAGE(PG8_SB(0, 0), rBc, cB, voffB); PG8_STAGE(PG8_SA(0, 0), rAc, cA, voffA); PG8_STAGE(PG8_SB(0, 1), rBc, cB + hstep, voffB); PG8_STAGE(PG8_SA(0, 1), rAc, cA + hstep, voffA);
        if (wr == 1) PG8_BAR;
        PG8_WAIT_V(4); PG8_BAR;
        PG8_STAGE(PG8_SB(1, 0), rBc, cB + kstep, voffB); PG8_STAGE(PG8_SA(1, 0), rAc, cA + kstep, voffA); PG8_STAGE(PG8_SB(1, 1), rBc, cB + hstep + kstep, voffB);
        PG8_WAIT_V(6); PG8_BAR;
    }
    for (;;) {
        const bool has_next = S.next(ui + 1, nxt);
        const unsigned nA = has_next ? S.a_off(nxt, g) : cA, nB = has_next ? S.b_off(nxt, g) : cB;
        const rsrc_t rAn = (Sched::TWO && has_next) ? (nxt.part ? rA1 : rA0) : rAc, rBn = (Sched::TWO && has_next) ? (nxt.part ? rB1 : rB0) : rBc;
        float pre_[8] = {0.f, 0.f, 0.f, 0.f, 0.f, 0.f, 0.f, 0.f};
        if constexpr (Epi::HAS_PRE) E.pre_load(pre_, cur, wr);
        for (int t = 0; t < nt; t += 2) {
            const bool last = (t == nt - 2);
            const unsigned a1 = cA + (unsigned)(t + 1) * kstep;
            const unsigned a2 = last ? nA : cA + (unsigned)(t + 2) * kstep, b2 = last ? nB : cB + (unsigned)(t + 2) * kstep; const rsrc_t rA2 = (Sched::TWO && last) ? rAn : rAc, rB2 = (Sched::TWO && last) ? rBn : rBc;
            const unsigned a3 = a2 + kstep, b3 = b2 + kstep;
            if (last && has_next) S.a_ready(nxt);
            if constexpr (SP2) {
            PG8_LDB(B0, 0, 0); PG8_LDB(B1, 0, 1); PG8_SCHED; PG8_LDA(At, 0, 0); PG8_STAGE(PG8_SA(1, 1), rAc, a1 + hstep, voffA);
            PG8_WAIT_V(8); PG8_WAIT_L(0); PG8_BAR; PG8_MMA(0, 0, At, B0); PG8_MMA(0, 1, At, B1); PG8_BAR; PG8_SCHED;
            PG8_LDA(At, 0, 1); PG8_STAGE(PG8_SB(0, 0), rB2, b2, voffB); PG8_STAGE(PG8_SB(0, 1), rB2, b2 + hstep, voffB); PG8_STAGE(PG8_SA(0, 0), rA2, a2, voffA);
            PG8_WAIT_V(8); PG8_WAIT_L(0); PG8_BAR; PG8_MMA(1, 0, At, B0); PG8_MMA(1, 1, At, B1); PG8_BAR; PG8_SCHED;
            PG8_LDB(B0, 1, 0); PG8_LDB(B1, 1, 1); PG8_SCHED; PG8_LDA(At, 1, 0); PG8_STAGE(PG8_SA(0, 1), rA2, a2 + hstep, voffA);
            PG8_WAIT_V(8); PG8_WAIT_L(0); PG8_BAR; PG8_MMA(0, 0, At, B0); PG8_MMA(0, 1, At, B1); PG8_BAR; PG8_SCHED;
            PG8_LDA(At, 1, 1); PG8_STAGE(PG8_SB(1, 0), rB2, b3, voffB); PG8_STAGE(PG8_SB(1, 1), rB2, b3 + hstep, voffB); PG8_STAGE(PG8_SA(1, 0), rA2, a3, voffA);
            PG8_WAIT_V(8); PG8_WAIT_L(0); PG8_BAR; PG8_MMA(1, 0, At, B0); PG8_MMA(1, 1, At, B1); PG8_BAR; PG8_SCHED;
            } else {
            PG8_LDB(B0, 0, 0); PG8_SCHED; PG8_LDA(At, 0, 0); PG8_STAGE(PG8_SA(1, 1), rAc, a1 + hstep, voffA);
            PG8_WAIT_L(8); PG8_BAR; PG8_WAIT_L(0); PG8_MMA(0, 0, At, B0); PG8_BAR; PG8_SCHED;
            PG8_LDB(B1, 0, 1); PG8_STAGE(PG8_SB(0, 0), rB2, b2, voffB);
            PG8_BAR; PG8_WAIT_L(0); PG8_MMA(0, 1, At, B1); PG8_BAR;
            PG8_LDA(At, 0, 1); PG8_STAGE(PG8_SA(0, 0), rA2, a2, voffA);
            PG8_BAR; PG8_WAIT_L(0); PG8_MMA(1, 0, At, B0); PG8_BAR; PG8_SCHED;
            PG8_STAGE(PG8_SB(0, 1), rB2, b2 + hstep, voffB);
            PG8_WAIT_V(6); PG8_BAR; PG8_MMA(1, 1, At, B1); PG8_BAR;
            PG8_LDB(B0, 1, 0); PG8_SCHED; PG8_LDA(At, 1, 0); PG8_STAGE(PG8_SA(0, 1), rA2, a2 + hstep, voffA);
            PG8_WAIT_L(8); PG8_BAR; PG8_WAIT_L(0); PG8_MMA(0, 0, At, B0); PG8_BAR; PG8_SCHED;
            PG8_LDB(B1, 1, 1); PG8_STAGE(PG8_SB(1, 0), rB2, b3, voffB);
            PG8_BAR; PG8_WAIT_L(0); PG8_MMA(0, 1, At, B1); PG8_BAR;
            PG8_LDA(At, 1, 1); PG8_STAGE(PG8_SA(1, 0), rA2, a3, voffA);
            PG8_BAR; PG8_WAIT_L(0); PG8_MMA(1, 0, At, B0); PG8_BAR; PG8_SCHED;
            PG8_STAGE(PG8_SB(1, 1), rB2, b3 + hstep, voffB);
            PG8_WAIT_V(6); PG8_BAR; PG8_MMA(1, 1, At, B1); PG8_BAR;
            }
        }
        if constexpr (ALIGN_EPI) { if (wr == 0) PG8_BAR; }
        { int fr_ = fr, fq_ = fq; asm volatile("" : "+v"(fr_), "+v"(fq_));
          if constexpr (Epi::HAS_PRE) E(acc, cur, wr, wc, fr_, fq_, pre_); else E(acc, cur, wr, wc, fr_, fq_); } S.done(cur);
        if (!has_next) break;
        if (E.reset(cur)) PG8_ZERO_ACC();
        cur = nxt; cA = nA; cB = nB; rAc = rAn; rBc = rBn; ++ui;
        if constexpr (ALIGN_EPI) { if (wr == 1) PG8_BAR; }
    }
    PG8_WAIT_V(0);
    if constexpr (!ALIGN_EPI) { if (wr == 0) PG8_BAR; }
    PG8_BAR;
#undef PG8_SA
#undef PG8_SB
#undef PG8_STAGE
#undef PG8_LDA
#undef PG8_ZERO_ACC
#undef PG8_LD2
#undef PG8_LO
#undef PG8_HI
#undef PG8_LDB
#undef PG8_MMA
#undef PG8_WAIT_V
#undef PG8_WAIT_L
#undef PG8_BAR
#undef PG8_SCHED
}
}

struct CJob { const float* W; const float* gain; bf16* dst; int K, N, mode, fp8; float wscale; int ldw, col0, pad; };
struct Ptrs { const float* in[30]; float* out; unsigned char* ws; };
typedef const __attribute__((address_space(4))) Ptrs* KP;

__device__ __forceinline__ void conv_load(const CJob& jb, int item, int lane, f32x4 (&v)[8]) {
    const int nblk = jb.N / 32, kb = item / nblk, nb = item % nblk, k0 = 64 * kb, n0 = 32 * nb;
    const float* src = jb.W + (size_t)(k0 + (lane >> 3)) * jb.ldw + jb.col0 + n0 + 4 * (lane & 7);
#pragma unroll
    for (int i = 0; i < 8; ++i) v[i] = __builtin_nontemporal_load((const f32x4*)(src + (size_t)(8 * i) * jb.ldw));
}
__device__ __forceinline__ void conv_finish(const CJob& jb, LAS float* scr, int item, int lane, const f32x4 (&v)[8]) {
    const int nblk = jb.N / 32, kb = item / nblk, nb = item % nblk, k0 = 64 * kb, n0 = 32 * nb;
    const int c = lane & 7;
    f32x4 g0 = (f32x4){1.f, 1.f, 1.f, 1.f}, g1 = g0;
    if (jb.gain) { g0 = *(const f32x4*)(jb.gain + k0 + 8 * c); g1 = *(const f32x4*)(jb.gain + k0 + 8 * c + 4); }
#pragma unroll
    for (int i = 0; i < 8; ++i) { LAS float* d = scr + ((lane >> 3) + 8 * i) * 33 + 4 * (lane & 7); d[0] = v[i].x; d[1] = v[i].y; d[2] = v[i].z; d[3] = v[i].w; }
    asm volatile("s_waitcnt lgkmcnt(0)" ::: "memory");
#pragma unroll
    for (int j = 0; j < 4; ++j) { const int n = (lane >> 3) + 8 * j; const LAS float* s = scr + (8 * c) * 33 + n;
        u32x4 o; o.x = cvt_pk_bf16(s[0 * 33] * g0.x, s[1 * 33] * g0.y); o.y = cvt_pk_bf16(s[2 * 33] * g0.z, s[3 * 33] * g0.w); o.z = cvt_pk_bf16(s[4 * 33] * g1.x, s[5 * 33] * g1.y); o.w = cvt_pk_bf16(s[6 * 33] * g1.z, s[7 * 33] * g1.w);
        const int nn = n0 + n; int row = nn;
        if (jb.mode == 3) { const int w = nn & 255; row = (nn & ~255) + ((w >> 5) & 1) * 128 + (w >> 6) * 32 + (w & 31); }
        else if (jb.mode >= 4) { const int r = nn & 127; row = (nn >> 7) * 256 + ((r >> 2) & 1) * 128 + (r >> 5) * 32 + ((r >> 3) & 3) * 8 + (jb.mode == 5 ? 4 : 0) + (r & 3); }
        if (jb.fp8) { const float ws_ = jb.wscale; u32x2 o8; o8.x = pk4_fp8(s[0 * 33] * g0.x * ws_, s[1 * 33] * g0.y * ws_, s[2 * 33] * g0.z * ws_, s[3 * 33] * g0.w * ws_);
            o8.y = pk4_fp8(s[4 * 33] * g1.x * ws_, s[5 * 33] * g1.y * ws_, s[6 * 33] * g1.z * ws_, s[7 * 33] * g1.w * ws_); *(u32x2*)((unsigned char*)jb.dst + (size_t)row * jb.K + k0 + 8 * c) = o8; }
        else *(u32x4*)(jb.dst + (size_t)row * jb.K + k0 + 8 * c) = o; }
    asm volatile("s_waitcnt lgkmcnt(0)" ::: "memory");
}
__device__ __forceinline__ void conv_item(const CJob& jb, LAS float* scr, int item, int lane) { f32x4 v[8]; conv_load(jb, item, lane, v); conv_finish(jb, scr, item, lane, v); }
__device__ __forceinline__ void conv_job(const CJob& jb, LAS float* scr, int gw, int ngw, int lane, int& base) {
    const int nit = (jb.K / 64) * (jb.N / 32);
    int first = gw - base; if (first < 0) first += ngw;
    for (int it = first; it < nit; it += ngw) conv_item(jb, scr, it, lane);
    base = (base + nit) % ngw;
}
__device__ __forceinline__ CJob static_job(KP P, int j) {
    CJob jb; jb.pad = 0; jb.gain = nullptr; jb.mode = 0; jb.fp8 = 0; jb.wscale = 1.f; jb.ldw = 0; jb.col0 = 0;
    if (j >= 30 + 128) { const int l = j - (30 + 128);
        jb.W = P->in[3] + (size_t)l * DM * NIN; jb.gain = P->in[2] + l * DM; jb.dst = (bf16*)(P->ws + WS_WIN + (size_t)l * NIN * DM * 2 + (size_t)NIN_A * DM * 2); jb.K = DM; jb.N = NIN_B; jb.mode = 3; jb.fp8 = 1; jb.wscale = WIN_SCALE; jb.ldw = NIN; jb.col0 = C_LG; return jb; }
    if (j < 24) { const int l = j / 6, k = j % 6;
        if (k == 0) { jb.W = P->in[3] + (size_t)l * DM * NIN; jb.gain = P->in[2] + l * DM; jb.dst = (bf16*)(P->ws + WS_WIN + (size_t)l * NIN * DM * (INPROJ_FP8 ? 1 : 2)); jb.K = DM; jb.N = INPROJ_GATES_FP8 ? NIN_A : NIN; jb.ldw = NIN; jb.mode = 3; jb.fp8 = (INPROJ_FP8 || ((INPROJ_FP8_MASK >> l) & 1)) ? 1 : 0; jb.wscale = jb.fp8 ? WIN_SCALE : 1.f; }
        else if (k == 1) { jb.W = P->in[15] + (size_t)l * DM * DM; jb.dst = (bf16*)(P->ws + WS_WPA) + (size_t)l * DM * DM; jb.K = DM; jb.N = DM; jb.fp8 = (MERGE_FP8_MASK >> l) & 1; jb.wscale = jb.fp8 ? WIN_SCALE : 1.f; }
        else if (k == 2) { jb.W = P->in[16] + (size_t)l * DM * DM; jb.dst = (bf16*)(P->ws + WS_WPB) + (size_t)l * DM * DM; jb.K = DM; jb.N = DM; jb.fp8 = (MERGE_FP8_MASK >> l) & 1; jb.wscale = jb.fp8 ? WIN_SCALE : 1.f; }
        else if (k == 3) { jb.W = P->in[17] + (size_t)l * DM * DM; jb.dst = (bf16*)(P->ws + WS_WOUT) + (size_t)l * DM * DM; jb.K = DM; jb.N = DM; jb.fp8 = (OUT_FP8_MASK >> l) & 1; jb.wscale = jb.fp8 ? WIN_SCALE : 1.f; }
        else if (k == 4) { jb.W = P->in[28] + (size_t)l * DM * DM; jb.gain = P->in[27] + l * DM; jb.dst = (bf16*)(P->ws + WS_WPG) + (size_t)l * DM * DM; jb.K = DM; jb.N = DM; jb.fp8 = (PLE_FP8_MASK >> l) & 1; jb.wscale = jb.fp8 ? WIN_SCALE : 1.f; }
        else { jb.W = P->in[29] + (size_t)l * PLE * DM; jb.dst = (bf16*)(P->ws + WS_WPP) + (size_t)l * DM * PLE; jb.K = PLE; jb.N = DM; }
    } else if (j >= 30) { const int idx = j - 30, l = idx >> 5, mat = (idx >> 4) & 1, n = idx & 15;
        jb.W = P->in[mat ? 12 : 10] + (size_t)(l * 16 + n) * 64 * 64; jb.dst = (bf16*)(P->ws + WS_LRUW) + (size_t)((l * 2 + mat) * 16 + n) * 64 * 64; jb.K = 64; jb.N = 64;
    } else { const int j2 = (j - 24) / 3, k = (j - 24) % 3;
        const bool f8 = (DENSE_FP8_MASK >> j2) & 1;
        if (k < 2) { jb.W = P->in[19 + k] + (size_t)j2 * DM * DFF; jb.gain = P->in[18] + (2 * j2) * DM; jb.dst = (bf16*)(P->ws + WS_W13D) + (size_t)j2 * 2 * DFF * DM; jb.K = DM; jb.N = DFF; jb.mode = 4 + k; jb.fp8 = f8; jb.wscale = f8 ? W13_SCALE : 1.f; }
        else { jb.W = P->in[21] + (size_t)j2 * DFF * DM; jb.dst = (bf16*)(P->ws + WS_W2D) + (size_t)j2 * DM * DFF; jb.K = DFF; jb.N = DM; jb.fp8 = f8; jb.wscale = f8 ? W2_SCALE : 1.f; }
    }
    if (jb.ldw == 0) jb.ldw = jb.N;
    return jb;
}
__device__ __forceinline__ CJob moe_job(KP P, int j2, int j) {
    CJob jb; jb.pad = 0; jb.gain = nullptr; jb.mode = 0; jb.fp8 = MOE_FP8 ? 1 : 0; jb.wscale = 1.f; jb.col0 = 0; const int e = j / 3, k = j % 3;
    if (k < 2) { jb.W = P->in[24 + k] + ((size_t)j2 * NEXP + e) * DM * DFF; jb.gain = P->in[18] + (2 * j2 + 1) * DM; jb.dst = (bf16*)(P->ws + WS_W13E + (size_t)e * 2 * DFF * DM * (MOE_FP8 ? 1 : 2)); jb.K = DM; jb.N = DFF; jb.mode = 4 + k; jb.wscale = MOE_FP8 ? W13_SCALE : 1.f; }
    else { jb.W = P->in[26] + ((size_t)j2 * NEXP + e) * DFF * DM; jb.dst = (bf16*)(P->ws + WS_W2E + (size_t)e * DM * DFF * (MOE_FP8 ? 1 : 2)); jb.K = DFF; jb.N = DM; jb.wscale = MOE_FP8 ? W2_SCALE : 1.f; }
    jb.ldw = jb.N;
    return jb;
}
__device__ __forceinline__ void conv_static_all(KP P, const LAS int* pref, int njobs, LAS float* scr, int gw, int ngw, int lane) {
#define PREF_U(j_) __builtin_amdgcn_readfirstlane(pref[j_])
    const int NT = PREF_U(njobs); int fl = gw; if (fl >= NT) return;
    int job = 0; while (fl >= PREF_U(job + 1)) ++job;
    CJob jb = static_job(P, job); f32x4 v[8]; conv_load(jb, fl - PREF_U(job), lane, v);
    for (;;) { const int nx = fl + ngw; const bool has = nx < NT; CJob jn = jb; int jobn = job; f32x4 w[8];
        if (has) { while (nx >= PREF_U(jobn + 1)) ++jobn; jn = static_job(P, jobn); conv_load(jn, nx - PREF_U(jobn), lane, w); }
        conv_finish(jb, scr, fl - PREF_U(job), lane, v);
        if (!has) break;
        jb = jn; job = jobn; fl = nx;
#pragma unroll
        for (int i = 0; i < 8; ++i) v[i] = w[i]; }
#undef PREF_U
}
__device__ __forceinline__ void conv_moe_layer(KP P, int j2, LAS float* scr, int gw, int ngw, int lane) {
    constexpr int IT = (DM / 64) * (DFF / 32), NT = 24 * IT;
    int fl = gw; if (fl >= NT) return;
    CJob jb = moe_job(P, j2, fl / IT); f32x4 v[8]; conv_load(jb, fl % IT, lane, v);
    for (;;) { const int nx = fl + ngw; const bool has = nx < NT; CJob jn = jb; f32x4 w[8];
        if (has) { jn = moe_job(P, j2, nx / IT); conv_load(jn, nx % IT, lane, w); }
        conv_finish(jb, scr, fl % IT, lane, v);
        if (!has) break;
        jb = jn; fl = nx;
#pragma unroll
        for (int i = 0; i < 8; ++i) v[i] = w[i]; }
}
template <bool COMBINE> __device__ __forceinline__ void rowstats_row(const float* xrow, bf16* hbrow, float* ssq, const bf16* o1, const bf16* o2, int lane, unsigned char* h8row = nullptr) {
    float s[4];
#pragma unroll
    for (int j = 0; j < 4; ++j) { f32x4 v;
        if (COMBINE) v = unpack_lo(*((const u32x2*)hbrow + lane + 64 * j)) + unpack_lo(*((const u32x2*)o1 + lane + 64 * j)) + unpack_lo(*((const u32x2*)o2 + lane + 64 * j));
        else v = *((const f32x4*)xrow + lane + 64 * j);
        s[j] = (v.x * v.x + v.y * v.y) + (v.z * v.z + v.w * v.w);
        u32x2 o; o.x = cvt_pk_bf16(v.x, v.y); o.y = cvt_pk_bf16(v.z, v.w); *((u32x2*)hbrow + lane + 64 * j) = o;
        if (h8row) *((unsigned*)h8row + lane + 64 * j) = pk4_fp8(v.x, v.y, v.z, v.w); }
#pragma unroll
    for (int j = 0; j < 4; ++j) s[j] = wave_sum(s[j]);
    const float v = lane == 0 ? s[0] : lane == 1 ? s[1] : lane == 2 ? s[2] : lane == 3 ? s[3] : 0.f;
    if (lane < 16) ssq[lane] = v;
}

__device__ __forceinline__ void rowstats_x2(const float* xA, bf16* hA, float* ssqA, const float* xB, bf16* hB, float* ssqB, int lane) {
    f32x4 va[4], vb[4];
#pragma unroll
    for (int j = 0; j < 4; ++j) { va[j] = __builtin_nontemporal_load((const f32x4*)xA + lane + 64 * j); vb[j] = __builtin_nontemporal_load((const f32x4*)xB + lane + 64 * j); }
    float sa[4], sb[4];
#pragma unroll
    for (int j = 0; j < 4; ++j) { const f32x4 v = va[j], w = vb[j]; sa[j] = (v.x * v.x + v.y * v.y) + (v.z * v.z + v.w * v.w); sb[j] = (w.x * w.x + w.y * w.y) + (w.z * w.z + w.w * w.w);
        u32x2 o; o.x = cvt_pk_bf16(v.x, v.y); o.y = cvt_pk_bf16(v.z, v.w); *((u32x2*)hA + lane + 64 * j) = o; o.x = cvt_pk_bf16(w.x, w.y); o.y = cvt_pk_bf16(w.z, w.w); *((u32x2*)hB + lane + 64 * j) = o; }
#pragma unroll
    for (int j = 0; j < 4; ++j) { sa[j] = wave_sum(sa[j]); sb[j] = wave_sum(sb[j]); }
    const float ua = lane == 0 ? sa[0] : lane == 1 ? sa[1] : lane == 2 ? sa[2] : lane == 3 ? sa[3] : 0.f, ub = lane == 0 ? sb[0] : lane == 1 ? sb[1] : lane == 2 ? sb[2] : lane == 3 ? sb[3] : 0.f;
    if (lane < 16) { ssqA[lane] = ua; ssqB[lane] = ub; }
}
__device__ __forceinline__ void combine_rows2(bf16* hA, float* ssqA, const bf16* a1, const bf16* a2, bf16* hB, float* ssqB, const bf16* b1, const bf16* b2, int lane, unsigned char* h8A = nullptr, unsigned char* h8B = nullptr) {
    u32x2 ra[3][4], rb[3][4];
#pragma unroll
    for (int j = 0; j < 4; ++j) { ra[0][j] = *((const u32x2*)hA + lane + 64 * j); ra[1][j] = *((const u32x2*)a1 + lane + 64 * j); ra[2][j] = *((const u32x2*)a2 + lane + 64 * j);
                                  rb[0][j] = *((const u32x2*)hB + lane + 64 * j); rb[1][j] = *((const u32x2*)b1 + lane + 64 * j); rb[2][j] = *((const u32x2*)b2 + lane + 64 * j); }
    float sa[4], sb[4];
#pragma unroll
    for (int j = 0; j < 4; ++j) { const f32x4 v = unpack_lo(ra[0][j]) + unpack_lo(ra[1][j]) + unpack_lo(ra[2][j]), w = unpack_lo(rb[0][j]) + unpack_lo(rb[1][j]) + unpack_lo(rb[2][j]);
        sa[j] = (v.x * v.x + v.y * v.y) + (v.z * v.z + v.w * v.w); sb[j] = (w.x * w.x + w.y * w.y) + (w.z * w.z + w.w * w.w);
        u32x2 o; o.x = cvt_pk_bf16(v.x, v.y); o.y = cvt_pk_bf16(v.z, v.w); *((u32x2*)hA + lane + 64 * j) = o; o.x = cvt_pk_bf16(w.x, w.y); o.y = cvt_pk_bf16(w.z, w.w); *((u32x2*)hB + lane + 64 * j) = o;
        if (h8A) { *((unsigned*)h8A + lane + 64 * j) = pk4_fp8(v.x, v.y, v.z, v.w); *((unsigned*)h8B + lane + 64 * j) = pk4_fp8(w.x, w.y, w.z, w.w); } }
#pragma unroll
    for (int j = 0; j < 4; ++j) { sa[j] = wave_sum(sa[j]); sb[j] = wave_sum(sb[j]); }
    const float va = lane == 0 ? sa[0] : lane == 1 ? sa[1] : lane == 2 ? sa[2] : lane == 3 ? sa[3] : 0.f, vb = lane == 0 ? sb[0] : lane == 1 ? sb[1] : lane == 2 ? sb[2] : lane == 3 ? sb[3] : 0.f;
    if (lane < 16) { ssqA[lane] = va; ssqB[lane] = vb; }
}

__device__ __forceinline__ void cvt_p_bf16(const f32x4* src, u32x2* dst, int i0, int stride) {
    constexpr int N4 = M * PLE / 4; int i = i0;
    for (; i + 3 * stride < N4; i += 4 * stride) { f32x4 v[4];
#pragma unroll
        for (int k = 0; k < 4; ++k) v[k] = __builtin_nontemporal_load(src + i + k * stride);
#pragma unroll
        for (int k = 0; k < 4; ++k) { u32x2 o; o.x = cvt_pk_bf16(v[k].x, v[k].y); o.y = cvt_pk_bf16(v[k].z, v[k].w); dst[i + k * stride] = o; } }
    for (; i < N4; i += stride) { const f32x4 v = __builtin_nontemporal_load(src + i); u32x2 o; o.x = cvt_pk_bf16(v.x, v.y); o.y = cvt_pk_bf16(v.z, v.w); dst[i] = o; }
}

__device__ __forceinline__ int t5_bucket(int d) {
    if (d < 16) return d;
    return 16 + (d >= 19) + (d >= 21) + (d >= 24) + (d >= 27) + (d >= 31) + (d >= 35) + (d >= 40) + (d >= 46) + (d >= 52) + (d >= 59) + (d >= 67) + (d >= 77) + (d >= 87) + (d >= 99) + (d >= 113);
}
namespace attn {
typedef float f32x16 __attribute__((ext_vector_type(16)));
typedef short s16x4 __attribute__((ext_vector_type(4)));
constexpr int KIMG = 0, VIMG = 32768, RBT = 65536, LSCR = RBT + 3072, OST = RBT + 4096, LDS_BYTES = OST + 8 * 4096;
__device__ __forceinline__ int crow(int r, int hi) { return (r & 3) + 8 * (r >> 2) + 4 * hi; }
__device__ __forceinline__ s16x4 vtr(const LAS unsigned char* p) { return __builtin_bit_cast(s16x4, __builtin_amdgcn_ds_read_tr16_b64_v4i16((LAS s16x4*)p)); }
__device__ __forceinline__ void attn_phase(LAS unsigned char* lds, const bf16* U, bf16* YA, const float* sinks, const float* rel_bias, int G, int c, int wbase, int y8) {
    const int tid = opaque_tid(wbase), lane = tid & 63, wid = __builtin_amdgcn_readfirstlane(tid >> 6), r32 = lane & 31, hi = lane >> 5;
    const int g = wid >> 1, qh = wid & 1; G = opaque_s(G); c = opaque_s(c);
    LAS float* rbt = (LAS float*)(lds + RBT); LAS float* lscr = (LAS float*)(lds + LSCR) + wid * 32; LAS bf16* stg = (LAS bf16*)(lds + OST + wid * 4096);
    int kvh_tab = -1;
    for (int L = c; L < BATCH * 32 * 4; L += G) {
        const int kvh = L & 3, n = (L >> 2) & 31, b = L >> 7;
        const int tok0 = b * SEQ + (n - 1) * 128;
        if (kvh != kvh_tab) { kvh_tab = kvh;
            for (int e = tid; e < 4 * 192; e += 512) { const int gg = e / 192, jj = e % 192, dist = 159 - jj;
                rbt[e] = (dist >= 0 && dist < 128) ? rel_bias[t5_bucket(dist) * 16 + kvh * 4 + gg] * LOG2E : -1.0e30f; } }
#pragma unroll
        for (int kg = 0; kg < 4; ++kg) { const int key = 64 * kg + lane; int t = tok0 + key; if (t < b * SEQ) t = b * SEQ;
            __builtin_amdgcn_global_load_lds((const unsigned*)(U + (size_t)t * NIN + C_K + kvh * 64 + 8 * wid), (LAS unsigned*)(lds + KIMG + wid * 4096 + kg * 1024), 16, 0, 0); }
#pragma unroll
        for (int j = 0; j < 4; ++j) { const int kg16 = 4 * (wid & 3) + j, key = 16 * kg16 + (lane >> 2); int t = tok0 + key; if (t < b * SEQ) t = b * SEQ;
            __builtin_amdgcn_global_load_lds((const unsigned*)(U + (size_t)t * NIN + C_V + kvh * 64 + 32 * (wid >> 2) + 8 * (lane & 3)), (LAS unsigned*)(lds + VIMG + (wid >> 2) * 16384 + kg16 * 1024), 16, 0, 0); }
        const size_t mq0 = (size_t)b * SEQ + n * 128 + 64 * qh;
        bf16x8 qf[2][4];
#pragma unroll
        for (int qt = 0; qt < 2; ++qt)
#pragma unroll
            for (int d0 = 0; d0 < 4; ++d0) qf[qt][d0] = *(const bf16x8*)(U + (mq0 + 32 * qt + r32) * NIN + (kvh * 4 + g) * 64 + 16 * d0 + 8 * hi);
        asm volatile("s_waitcnt vmcnt(0)" ::: "memory"); __syncthreads();
        const float sink2 = sinks[kvh * 4 + g] * LOG2E; const LAS float* bt = rbt + g * 192 + 31 - r32 + 4 * hi;
#pragma unroll
        for (int qt = 0; qt < 2; ++qt) {
            const int iq0 = 64 * qh + 32 * qt, kt0 = iq0 >> 5; const size_t mq = mq0 + 32 * qt;
            f32x16 p[5];
#pragma unroll
            for (int jt = 0; jt < 5; ++jt) { f32x16 a = {};
#pragma unroll
                for (int d0 = 0; d0 < 4; ++d0) { const bf16x8 kf = *(const LAS bf16x8*)(lds + KIMG + (2 * d0 + hi) * 4096 + (32 * (kt0 + jt) + r32) * 16); a = __builtin_amdgcn_mfma_f32_32x32x16_bf16(kf, qf[qt][d0], a, 0, 0, 0); }
                p[jt] = a; }
            float mx = sink2;
#pragma unroll
            for (int jt = 0; jt < 5; ++jt)
#pragma unroll
                for (int r = 0; r < 16; ++r) { float s = p[jt][r] + bt[32 * jt + (r & 3) + 8 * (r >> 2)];
                    if (n == 0) { if (32 * (kt0 + jt) + crow(r, hi) < 128) s = -1.0e30f; }
                    p[jt][r] = s; mx = fmaxf(mx, s); }
            mx = max_x32(mx);
            float l = 0.f;
#pragma unroll
            for (int jt = 0; jt < 5; ++jt)
#pragma unroll
                for (int r = 0; r < 16; ++r) { const float e = __builtin_amdgcn_exp2f(p[jt][r] - mx); p[jt][r] = e; l += e; }
            l = sum_x32(l); l += __builtin_amdgcn_exp2f(sink2 - mx);
            f32x16 o[2]; o[0] = (f32x16){}; o[1] = (f32x16){};
            const LAS unsigned char* vb = lds + VIMG + ((lane >> 4) & 1) * 32 + (lane & 3) * 8 + (4 * hi + ((lane & 15) >> 2)) * 64;
#pragma unroll
            for (int jt = 0; jt < 5; ++jt)
#pragma unroll
                for (int s = 0; s < 2; ++s) { u32x4 w; w.x = cvt_pk_bf16(p[jt][8 * s], p[jt][8 * s + 1]); w.y = cvt_pk_bf16(p[jt][8 * s + 2], p[jt][8 * s + 3]); w.z = cvt_pk_bf16(p[jt][8 * s + 4], p[jt][8 * s + 5]); w.w = cvt_pk_bf16(p[jt][8 * s + 6], p[jt][8 * s + 7]);
                    const bf16x8 pa = __builtin_bit_cast(bf16x8, w);
#pragma unroll
                    for (int d0 = 0; d0 < 2; ++d0) { const LAS unsigned char* vp = vb + d0 * 16384 + (32 * (kt0 + jt) + 16 * s) * 64; const s16x4 lo = vtr(vp), hv = vtr(vp + 8 * 64);
                        const bf16x8 vf = (bf16x8){lo[0], lo[1], lo[2], lo[3], hv[0], hv[1], hv[2], hv[3]};
                        o[d0] = __builtin_amdgcn_mfma_f32_32x32x16_bf16(pa, vf, o[d0], 0, 0, 0); } }
            if (hi == 0) lscr[r32] = l;
            asm volatile("s_waitcnt lgkmcnt(0)" ::: "memory");
#pragma unroll
            for (int r = 0; r < 16; r += 2) { const int qi = crow(r, hi); const float rl0 = __builtin_amdgcn_rcpf(lscr[qi]), rl1 = __builtin_amdgcn_rcpf(lscr[qi + 1]);
                const unsigned w0 = cvt_pk_bf16(o[0][r] * rl0, o[0][r + 1] * rl1), w1 = cvt_pk_bf16(o[1][r] * rl0, o[1][r + 1] * rl1);
                stg[qi * 64 + r32] = (bf16)(w0 & 0xffffu); stg[(qi + 1) * 64 + r32] = (bf16)(w0 >> 16); stg[qi * 64 + 32 + r32] = (bf16)(w1 & 0xffffu); stg[(qi + 1) * 64 + 32 + r32] = (bf16)(w1 >> 16); }
            asm volatile("s_waitcnt lgkmcnt(0)" ::: "memory");
#pragma unroll
            for (int i = 0; i < 4; ++i) { const int row = 8 * i + (lane >> 3), chn = lane & 7;
                const u32x4 sv = *(const LAS u32x4*)(stg + row * 64 + 8 * chn);
                if (y8) { f32x4 a0, a1; pg8::unpack8(sv, a0, a1); a0 = a0 * Y8_SCALE; a1 = a1 * Y8_SCALE; u32x2 w8; w8.x = pk4_fp8(a0[0], a0[1], a0[2], a0[3]); w8.y = pk4_fp8(a1[0], a1[1], a1[2], a1[3]);
                    *(u32x2*)((unsigned char*)YA + (mq + row) * DM + (kvh * 4 + g) * 64 + 8 * chn) = w8; }
                else *(u32x4*)(YA + (mq + row) * DM + (kvh * 4 + g) * 64 + 8 * chn) = sv; }
            asm volatile("s_waitcnt lgkmcnt(0)" ::: "memory");
        }
        __syncthreads();
    }
}
}

namespace lru {
typedef float f32x16 __attribute__((ext_vector_type(16)));
constexpr int TC = 128, NCK = SEQ / TC, NUNIT = BATCH * 16 * NCK, CW_BYTES = 5 * 64 * 4, ST_BYTES = 2 * 32 * 128, WAVE_LDS = ST_BYTES + CW_BYTES + 256, WL_OFF = 8 * WAVE_LDS, WL_ROW = 144, LA_OFF = 98304;
__device__ __forceinline__ int crow(int r, int hi) { return (r & 3) + 8 * (r >> 2) + 4 * hi; }
__device__ __forceinline__ void lru_scan(LAS unsigned char* lds, const bf16* U, bf16* HR, bf16* PQ, float* AGG, const bf16* Wt, const float* conv_w, const float* conv_b,
                                         const float* b_rg, const float* b_ig, const float* lam, int G, int c, int wbase, bf16* YB, unsigned* flags, unsigned epoch, unsigned* tmo, int y8) {
    const int tid = opaque_tid(wbase), lane = tid & 63, wid = __builtin_amdgcn_readfirstlane(tid >> 6), r32 = lane & 31, hi = lane >> 5; G = opaque_s(G); c = opaque_s(c);
    LAS unsigned char* wl = lds + wid * WAVE_LDS; LAS bf16* stH = (LAS bf16*)wl; LAS bf16* stP = (LAS bf16*)(wl + 32 * 128);
    LAS float* cw = (LAS float*)(wl + ST_BYTES);
    int nb_l = -1;
    LAS float* const aggl = (LAS float*)(lds + LA_OFF); LAS float* const carl = aggl + 16 * 64 * 2;
    for (int un = LRU_FUSED ? 0 : c * 8 + wid; un < (LRU_FUSED ? 2 : NUNIT); un += LRU_FUSED ? 1 : G * 8) {
        const int ck = LRU_FUSED ? (c & 1) * 16 + un * 8 + wid : (un & (NCK - 1)), nb = LRU_FUSED ? ((c >> 1) & 15) : ((un >> 5) & 15), b = LRU_FUSED ? (c >> 5) : (un >> 9), ch0 = nb * 64;
        if (nb != nb_l) {
            __syncthreads();
#pragma unroll
            for (int j = 0; j < 2; ++j) { const int p = tid + 512 * j, row = p >> 3, seg = p & 7;
                *(LAS u32x4*)(lds + WL_OFF + row * WL_ROW + seg * 16) = *(const u32x4*)(Wt + (size_t)(row >> 6) * 16 * 64 * 64 + (size_t)(nb * 64 + (row & 63)) * 64 + seg * 8); }
            __syncthreads(); nb_l = nb; }
#pragma unroll
        for (int j = 0; j < 4; ++j) cw[j * 64 + lane] = conv_w[j * DM + ch0 + lane];
        cw[4 * 64 + lane] = conv_b[ch0 + lane];
        float brg[2], big[2], sp8[2], carry[2], prodA[2];
#pragma unroll
        for (int ct = 0; ct < 2; ++ct) { const int ch = ch0 + 32 * ct + r32; brg[ct] = b_rg[ch] * -LOG2E; big[ct] = b_ig[ch] * -LOG2E; { const float x = fast_exp(-lam[ch]); sp8[ct] = (-8.f * LOG2E) * (x < 0.25f ? x * (1.f - x * (0.5f - x * ((1.f / 3.f) - x * (0.25f - x * (0.2f - x * (1.f / 6.f)))))) : (__builtin_amdgcn_logf(1.f + x) * 0.6931471805599453f)); } carry[ct] = 0.f; prodA[ct] = 1.f; }
        asm volatile("s_waitcnt lgkmcnt(0)" ::: "memory");
        u32x4 raw[4][4];
#define LRU_LOAD_RAW(st_) do { const int t_ = ck * TC + (st_) * 32 + r32; const size_t m_ = (size_t)b * SEQ + t_; _Pragma("unroll") for (int ks = 0; ks < 4; ++ks) _Pragma("unroll") for (int j = 0; j < 4; ++j) { \
            const int back_ = 3 - j; const size_t mm_ = (t_ >= back_) ? m_ - back_ : m_; raw[ks][j] = *(const u32x4*)(U + mm_ * NIN + C_LX + ch0 + 16 * ks + 8 * hi); } } while (0)
        LRU_LOAD_RAW(0);
        for (int st = 0; st < 4; ++st) {
            const int t0 = ck * TC + st * 32, t = t0 + r32;
            bf16x8 af[4];
#pragma unroll
            for (int ks = 0; ks < 4; ++ks) { const int cl = 16 * ks + 8 * hi; f32x4 x0 = *(const LAS f32x4*)(cw + 256 + cl), x1 = *(const LAS f32x4*)(cw + 256 + cl + 4);
#pragma unroll
                for (int j = 0; j < 4; ++j) { const int back = 3 - j; const bool ok = t >= back;
                    f32x4 v0, v1; pg8::unpack8(raw[ks][j], v0, v1);
                    const f32x4 w0 = *(const LAS f32x4*)(cw + j * 64 + cl), w1 = *(const LAS f32x4*)(cw + j * 64 + cl + 4);
                    if (ok) { x0 = x0 + w0 * v0; x1 = x1 + w1 * v1; } }
                af[ks] = __builtin_bit_cast(bf16x8, pg8::pack8(x0, x1)); }
            if (st < 3) LRU_LOAD_RAW(st + 1);
#pragma unroll
            for (int ct = 0; ct < 2; ++ct) {
                f32x16 R = {}, I = {}, X = {};
                int zoff; asm volatile("v_mov_b32 %0, 0" : "=v"(zoff)); const LAS unsigned char* Wp = lds + WL_OFF + zoff;
                bf16x8 wr[4], wi[4];
#pragma unroll
                for (int ks = 0; ks < 4; ++ks) { const int o = (32 * ct + r32) * WL_ROW + (16 * ks + 8 * hi) * 2; wr[ks] = *(const LAS bf16x8*)(Wp + o); wi[ks] = *(const LAS bf16x8*)(Wp + 64 * WL_ROW + o); }
#pragma unroll
                for (int ks = 0; ks < 4; ++ks) { bf16x8 idf;
#pragma unroll
                    for (int j = 0; j < 8; ++j) idf[j] = (16 * ks + 8 * hi + j == 32 * ct + r32) ? (short)0x3F80 : (short)0;
                    R = __builtin_amdgcn_mfma_f32_32x32x16_bf16(af[ks], wr[ks], R, 0, 0, 0); I = __builtin_amdgcn_mfma_f32_32x32x16_bf16(af[ks], wi[ks], I, 0, 0, 0);
                    X = __builtin_amdgcn_mfma_f32_32x32x16_bf16(af[ks], idf, X, 0, 0, 0); }
                float P[16], H[16];
#pragma unroll
                for (int r = 0; r < 16; ++r) { const float er = __builtin_amdgcn_exp2f(R[r] * -LOG2E + brg[ct]), ei = __builtin_amdgcn_exp2f(I[r] * -LOG2E + big[ct]);
                    const float e1 = 1.f + er, e2 = 1.f + ei, qq = __builtin_amdgcn_rcpf(e1 * e2), rr = qq * e2, ii = qq * e1;
                    const float a = __builtin_amdgcn_exp2f(rr * sp8[ct]);
                    P[r] = a; H[r] = __builtin_amdgcn_sqrtf(fmaxf(1.f - a * a, 0.f)) * (ii * X[r]); }
                float Ag[4], Hg[4], Ao[4], Ho[4];
#pragma unroll
                for (int g4 = 0; g4 < 4; ++g4) {
#pragma unroll
                    for (int j = 1; j < 4; ++j) { H[4 * g4 + j] = P[4 * g4 + j] * H[4 * g4 + j - 1] + H[4 * g4 + j]; P[4 * g4 + j] = P[4 * g4 + j] * P[4 * g4 + j - 1]; }
                    Ag[g4] = P[4 * g4 + 3]; Hg[g4] = H[4 * g4 + 3]; Ao[g4] = get_x32(Ag[g4], hi); Ho[g4] = get_x32(Hg[g4], hi); }
                float C = carry[ct], PC = prodA[ct], Cm[4], Pm[4];
#pragma unroll
                for (int g4 = 0; g4 < 4; ++g4) { const float A0 = hi ? Ao[g4] : Ag[g4], H0 = hi ? Ho[g4] : Hg[g4], A1 = hi ? Ag[g4] : Ao[g4], H1 = hi ? Hg[g4] : Ho[g4];
                    const float C1 = A0 * C + H0, P1 = PC * A0; Cm[g4] = hi ? C1 : C; Pm[g4] = hi ? P1 : PC; C = A1 * C1 + H1; PC = P1 * A1; }
                carry[ct] = C; prodA[ct] = PC;
#pragma unroll
                for (int r = 0; r < 16; r += 2) { const int o = crow(r, hi) * 64 + 32 * ct + r32;
                    const unsigned wh = cvt_pk_bf16(H[r] + P[r] * Cm[r >> 2], H[r + 1] + P[r + 1] * Cm[r >> 2]), wp = cvt_pk_bf16(P[r] * Pm[r >> 2], P[r + 1] * Pm[r >> 2]);
                    stH[o] = (bf16)(wh & 0xffffu); stH[o + 64] = (bf16)(wh >> 16); stP[o] = (bf16)(wp & 0xffffu); stP[o + 64] = (bf16)(wp >> 16); }
            }
            asm volatile("s_waitcnt lgkmcnt(0)" ::: "memory");
#pragma unroll
            for (int i = 0; i < 4; ++i) { const int row = (lane >> 3) + 8 * i, chn = lane & 7; const size_t go = ((size_t)b * SEQ + t0 + row) * DM + ch0 + 8 * chn;
                *(u32x4*)(HR + go) = *(const LAS u32x4*)(stH + row * 64 + 8 * chn); *(u32x4*)(PQ + go) = *(const LAS u32x4*)(stP + row * 64 + 8 * chn); }
            asm volatile("s_waitcnt lgkmcnt(0)" ::: "memory");
        }
        if (!LRU_FUSED) { if (hi == 0) {
#pragma unroll
            for (int ct = 0; ct < 2; ++ct) *(f32x2*)(AGG + ((size_t)(b * NCK + ck) * DM + ch0 + 32 * ct + r32) * 2) = (f32x2){prodA[ct], carry[ct]};
        } } else if (hi == 0) {
#pragma unroll
            for (int ct = 0; ct < 2; ++ct) *(LAS f32x2*)(aggl + ((un * 8 + wid) * 64 + 32 * ct + r32) * 2) = (f32x2){prodA[ct], carry[ct]};
        }
    }
    if (LRU_FUSED) {
        const int half = c & 1, pr = c >> 1, b = c >> 5, ch0 = ((c >> 1) & 15) * 64;
        __syncthreads();
        float ht = 0.f;
#pragma unroll
        for (int j = 0; j < 16; ++j) { const f32x2 a = *(const LAS f32x2*)(aggl + (j * 64 + lane) * 2); ht = a.x * ht + a.y; }
        float cin = 0.f;
        if (half == 0) { if (wid == 0) {
            __hip_atomic_store((unsigned*)AGG + pr * 64 + lane, __builtin_bit_cast(unsigned, ht), __ATOMIC_RELAXED, __HIP_MEMORY_SCOPE_AGENT);
            asm volatile("s_waitcnt vmcnt(0)" ::: "memory");
            if (lane == 0) __hip_atomic_store(flags + (size_t)pr * 16, epoch, __ATOMIC_RELAXED, __HIP_MEMORY_SCOPE_AGENT); } }
        else { unsigned sp_ = 0;
            for (;;) { const unsigned v_ = __builtin_amdgcn_readfirstlane(__hip_atomic_load(flags + (size_t)pr * 16, __ATOMIC_RELAXED, __HIP_MEMORY_SCOPE_AGENT));
                if (v_ == epoch) break;
                __builtin_amdgcn_s_sleep(1);
                if ((++sp_ & 255u) == 0u) { if (__hip_atomic_load(tmo, __ATOMIC_RELAXED, __HIP_MEMORY_SCOPE_AGENT)) break; if (sp_ > (1u << 18)) { atomicAdd(tmo, 1u); break; } } }
            cin = __builtin_bit_cast(float, __hip_atomic_load((unsigned*)AGG + pr * 64 + lane, __ATOMIC_RELAXED, __HIP_MEMORY_SCOPE_AGENT)); }
#pragma unroll
        for (int r = 0; r < 2; ++r) { float cc = cin; const int nj = r * 8 + wid;
            for (int j = 0; j < nj; ++j) { const f32x2 a = *(const LAS f32x2*)(aggl + (j * 64 + lane) * 2); cc = a.x * cc + a.y; }
            carl[(wid * 2 + r) * 64 + lane] = cc; }
        asm volatile("s_waitcnt vmcnt(0) lgkmcnt(0)" ::: "memory");
        const int c8 = 8 * (lane & 7), rg = lane >> 3;
#pragma unroll
        for (int r = 0; r < 2; ++r) { const int ck = half * 16 + r * 8 + wid;
            const f32x4 c0 = *(const LAS f32x4*)(carl + (wid * 2 + r) * 64 + c8), c1 = *(const LAS f32x4*)(carl + (wid * 2 + r) * 64 + c8 + 4);
            for (int i = 0; i < 16; i += 4) { u32x4 hv[4], qv[4], gv[4];
#pragma unroll
                for (int k = 0; k < 4; ++k) { const size_t m = (size_t)b * SEQ + ck * TC + 8 * (i + k) + rg; hv[k] = *(const u32x4*)(HR + m * DM + ch0 + c8); qv[k] = *(const u32x4*)(PQ + m * DM + ch0 + c8); gv[k] = *(const u32x4*)(U + m * NIN + C_LG + ch0 + c8); }
#pragma unroll
                for (int k = 0; k < 4; ++k) { const size_t m = (size_t)b * SEQ + ck * TC + 8 * (i + k) + rg; f32x4 h0, h1, q0, q1, g0, g1; pg8::unpack8(hv[k], h0, h1); pg8::unpack8(qv[k], q0, q1); pg8::unpack8(gv[k], g0, g1);
                    if (y8) { const f32x4 y0 = (h0 + q0 * c0) * g0 * Y8_SCALE, y1 = (h1 + q1 * c1) * g1 * Y8_SCALE; u32x2 w8; w8.x = pk4_fp8(y0[0], y0[1], y0[2], y0[3]); w8.y = pk4_fp8(y1[0], y1[1], y1[2], y1[3]);
                        *(u32x2*)((unsigned char*)YB + m * DM + ch0 + c8) = w8; }
                    else *(u32x4*)(YB + m * DM + ch0 + c8) = pg8::pack8((h0 + q0 * c0) * g0, (h1 + q1 * c1) * g1); } } }
    }
}
#undef LRU_LOAD_RAW
template <bool F8> __device__ __forceinline__ void lru_apply(const bf16* U, const bf16* HR, const bf16* PQ, const float* AGG, bf16* YB, int G, int c, int wbase) {
    const int tid = opaque_tid(wbase); G = opaque_s(G); c = opaque_s(c); const int ch = 8 * (tid & 127), tq = tid >> 7;
    for (int cu = c; cu < BATCH * NCK; cu += G) { const int b = cu / NCK, ck = cu % NCK;
        f32x4 c0 = {}, c1 = {};
        int j = 0;
        for (; j + 8 <= ck; j += 8) { f32x4 p[8][4];
#pragma unroll
            for (int k = 0; k < 8; ++k) { const f32x4* ap = (const f32x4*)(AGG + ((size_t)(b * NCK + j + k) * DM + ch) * 2); p[k][0] = ap[0]; p[k][1] = ap[1]; p[k][2] = ap[2]; p[k][3] = ap[3]; }
#pragma unroll
            for (int k = 0; k < 8; ++k) { c0 = (f32x4){p[k][0].x * c0.x + p[k][0].y, p[k][0].z * c0.y + p[k][0].w, p[k][1].x * c0.z + p[k][1].y, p[k][1].z * c0.w + p[k][1].w};
                                          c1 = (f32x4){p[k][2].x * c1.x + p[k][2].y, p[k][2].z * c1.y + p[k][2].w, p[k][3].x * c1.z + p[k][3].y, p[k][3].z * c1.w + p[k][3].w}; } }
        for (; j < ck; ++j) { const f32x4* ap = (const f32x4*)(AGG + ((size_t)(b * NCK + j) * DM + ch) * 2); const f32x4 p0 = ap[0], p1 = ap[1], p2 = ap[2], p3 = ap[3];
            c0 = (f32x4){p0.x * c0.x + p0.y, p0.z * c0.y + p0.w, p1.x * c0.z + p1.y, p1.z * c0.w + p1.w}; c1 = (f32x4){p2.x * c1.x + p2.y, p2.z * c1.y + p2.w, p3.x * c1.z + p3.y, p3.z * c1.w + p3.w}; }
        for (int i = 0; i < 32; i += 4) { u32x4 hv[4], qv[4], gv[4];
#pragma unroll
            for (int k = 0; k < 4; ++k) { const size_t m = (size_t)b * SEQ + ck * TC + tq + 4 * (i + k); hv[k] = *(const u32x4*)(HR + m * DM + ch); qv[k] = *(const u32x4*)(PQ + m * DM + ch); gv[k] = *(const u32x4*)(U + m * NIN + C_LG + ch); }
#pragma unroll
            for (int k = 0; k < 4; ++k) { const size_t m = (size_t)b * SEQ + ck * TC + tq + 4 * (i + k); f32x4 h0, h1, q0, q1, g0, g1; pg8::unpack8(hv[k], h0, h1); pg8::unpack8(qv[k], q0, q1); pg8::unpack8(gv[k], g0, g1);
                if (F8) { const f32x4 y0 = (h0 + q0 * c0) * g0 * Y8_SCALE, y1 = (h1 + q1 * c1) * g1 * Y8_SCALE; u32x2 w8; w8.x = pk4_fp8(y0[0], y0[1], y0[2], y0[3]); w8.y = pk4_fp8(y1[0], y1[1], y1[2], y1[3]);
                    *(u32x2*)((unsigned char*)YB + m * DM + ch) = w8; }
                else *(u32x4*)(YB + m * DM + ch) = pg8::pack8((h0 + q0 * c0) * g0, (h1 + q1 * c1) * g1); } }
    }
}
}

namespace moe {
constexpr int NCHUNK = M / 128;
__device__ __forceinline__ void route_a(LAS unsigned char* lds, const bf16* h, const float* ssq, const float* gain, const float* rw, const float* rb, int* sel, float* selw, int* CNT, int G, int c, int wbase) {
    const int tid = opaque_tid(wbase), lane = tid & 63, wid = __builtin_amdgcn_readfirstlane(tid >> 6); LAS int* lc = (LAS int*)lds; G = opaque_s(G); c = opaque_s(c);
    f32x4 wg[4][4][2];
#pragma unroll
    for (int j = 0; j < 4; ++j) { const f32x4 gk = *(const f32x4*)(gain + 4 * lane + 256 * j);
#pragma unroll
        for (int q = 0; q < 4; ++q) { const float* wp = rw + (size_t)(4 * lane + 256 * j + q) * 8; wg[j][q][0] = *(const f32x4*)wp * gk[q]; wg[j][q][1] = *(const f32x4*)(wp + 4) * gk[q]; } }
    float rbv[8];
#pragma unroll
    for (int e = 0; e < 8; ++e) rbv[e] = rb[e];
    for (int chunk = c; chunk < NCHUNK; chunk += G) {
        if (tid < 8) lc[tid] = 0;
        __syncthreads();
        for (int i0 = 0; i0 < 16; i0 += 2) {
            u32x2 hx[2][4]; f32x4 sq[2];
#pragma unroll
            for (int u = 0; u < 2; ++u) { const int m = chunk * 128 + wid * 16 + i0 + u; const u32x2* hp = (const u32x2*)(h + (size_t)m * DM) + lane;
#pragma unroll
                for (int j = 0; j < 4; ++j) hx[u][j] = hp[64 * j];
                sq[u] = *(const f32x4*)(ssq + 16 * (size_t)m + 4 * (lane & 3)); }
#pragma unroll
            for (int u = 0; u < 2; ++u) { const int m = chunk * 128 + wid * 16 + i0 + u; f32x4 a0 = {}, a1 = {};
#pragma unroll
                for (int j = 0; j < 4; ++j) { const f32x4 x = unpack_lo(hx[u][j]);
#pragma unroll
                    for (int q = 0; q < 4; ++q) { a0 = a0 + wg[j][q][0] * x[q]; a1 = a1 + wg[j][q][1] * x[q]; } }
                float s = (sq[u].x + sq[u].y) + (sq[u].z + sq[u].w); s += swz_f<1>(s); s += swz_f<2>(s);
                const float rs = __builtin_amdgcn_rsqf(s * (1.f / 1024.f) + EPS); float acc[8] = {a0.x, a0.y, a0.z, a0.w, a1.x, a1.y, a1.z, a1.w};
#pragma unroll
                for (int e = 0; e < 8; ++e) acc[e] = wave_sum(acc[e]) * rs + rbv[e];
                int i1 = 0; float v1 = acc[0];
#pragma unroll
                for (int e = 1; e < 8; ++e) if (acc[e] > v1) { v1 = acc[e]; i1 = e; }
                int i2 = -1; float v2 = -3.0e38f;
#pragma unroll
                for (int e = 0; e < 8; ++e) if (e != i1 && acc[e] > v2) { v2 = acc[e]; i2 = e; }
                const float ex = fast_exp(v2 - v1), w1 = 1.f / (1.f + ex), w2 = ex / (1.f + ex);
                if (lane == 0) { sel[2 * m] = i1; sel[2 * m + 1] = i2; selw[2 * m] = w1; selw[2 * m + 1] = w2; atomicAdd((int*)(lc + i1), 1); atomicAdd((int*)(lc + i2), 1); }
            }
        }
        __syncthreads();
        if (tid < 8) CNT[chunk * 8 + tid] = lc[tid];
        __syncthreads();
    }
}
__device__ __forceinline__ void route_b(LAS unsigned char* lds, const int* sel, const float* selw, const float* ssq, const int* CNT, const bf16* hb, int* tok, float* srs, float* sgw, int* tslot, int* meta, bf16* XG, int G, int c, int wbase) {
    const int tid = opaque_tid(wbase), lane = tid & 63, wid = __builtin_amdgcn_readfirstlane(tid >> 6); G = opaque_s(G); c = opaque_s(c);
    LAS int* tot = (LAS int*)lds; LAS int* pre = tot + 8; LAS int* start = tot + 16; LAS int* pos = tot + 32; LAS float* rsl = (LAS float*)(tot + 32 + 256);
    for (int chunk = c; chunk < NCHUNK; chunk += G) {
        { int t = 0, p = 0;
#pragma unroll
          for (int j = 0; j < NCHUNK / 64; ++j) { const int ch = lane + 64 * j; const int v = CNT[ch * 8 + wid]; t += v; p += (ch < chunk) ? v : 0; }
          t += swz_i<1>(t); t += swz_i<2>(t); t += swz_i<4>(t); t += swz_i<8>(t); t += swz_i<16>(t); t = sum_x32i(t);
          p += swz_i<1>(p); p += swz_i<2>(p); p += swz_i<4>(p); p += swz_i<8>(p); p += swz_i<16>(p); p = sum_x32i(p);
          if (lane == 0) { tot[wid] = t; pre[wid] = p; } }
        __syncthreads();
        if (tid == 0) { int s = 0; for (int e = 0; e < 8; ++e) { start[e] = s; s += ((tot[e] + 255) >> 8) << 8; } start[8] = s; }
        __syncthreads();
        if (chunk == 0 && tid < 9) meta[tid] = start[tid] >> 8;
        if (wid == 0) {
            int run[8];
#pragma unroll
            for (int e = 0; e < 8; ++e) run[e] = start[e] + pre[e];
#pragma unroll
            for (int hf = 0; hf < 2; ++hf)
#pragma unroll
                for (int k = 0; k < 2; ++k) { const int m = chunk * 128 + hf * 64 + lane; const int e = sel[2 * m + k]; int p = 0;
#pragma unroll
                    for (int ee = 0; ee < 8; ++ee) { const unsigned long long mask = __ballot(e == ee); if (e == ee) p = run[ee] + __popcll(mask & ((1ull << lane) - 1ull)); run[ee] += __popcll(mask); }
                    const float rsm = rstd_of(ssq, m); tok[p] = m; srs[p] = rsm; sgw[p] = selw[2 * m + k]; tslot[2 * m + k] = p; pos[(hf * 2 + k) * 64 + lane] = p; rsl[(hf * 2 + k) * 64 + lane] = rsm; }
        }
        __syncthreads();
        for (int q0 = wid * 32; q0 < wid * 32 + 32; q0 += 4) {
            u32x4 r0[4], r1[4]; int pp[4]; float rr[4];
#pragma unroll
            for (int u = 0; u < 4; ++u) { const int q = q0 + u, m = chunk * 128 + (q >> 7) * 64 + (q & 63); pp[u] = pos[q]; rr[u] = rsl[q];
                if (MOE_FP8) { const u32x4* src = (const u32x4*)(hb + (size_t)m * DM) + 2 * lane; r0[u] = src[0]; r1[u] = src[1]; }
                else { const u32x4* src = (const u32x4*)(hb + (size_t)m * DM); r0[u] = src[lane]; r1[u] = src[lane + 64]; } }
#pragma unroll
            for (int u = 0; u < 4; ++u) {
                if (MOE_FP8) { const float rs = rr[u]; f32x4 a0, a1, b0, b1; pg8::unpack8(r0[u], a0, a1); pg8::unpack8(r1[u], b0, b1);
                    u32x4 o; o.x = pk4_fp8(a0.x * rs, a0.y * rs, a0.z * rs, a0.w * rs); o.y = pk4_fp8(a1.x * rs, a1.y * rs, a1.z * rs, a1.w * rs); o.z = pk4_fp8(b0.x * rs, b0.y * rs, b0.z * rs, b0.w * rs); o.w = pk4_fp8(b1.x * rs, b1.y * rs, b1.z * rs, b1.w * rs);
                    *((u32x4*)((unsigned char*)XG + (size_t)pp[u] * DM) + lane) = o; }
                else { u32x4* dst = (u32x4*)(XG + (size_t)pp[u] * DM); dst[lane] = r0[u]; dst[lane + 64] = r1[u]; } } }
        if (chunk == 0) {
            for (int e = 0; e < 8; ++e) { const int s0 = start[e] + tot[e], s1 = start[e + 1];
                for (int s = s0 + tid; s < s1; s += 512) { tok[s] = 0; srs[s] = 0.f; sgw[s] = 0.f; }
                unsigned z0; asm volatile("v_mov_b32 %0, 0" : "=v"(z0)); const u32x4 zz = (u32x4){z0, z0, z0, z0};
                for (int s = s0 + wid; s < s1; s += 8) { if (MOE_FP8) *((u32x4*)((unsigned char*)XG + (size_t)s * DM) + lane) = zz;
                    else { u32x4* dst = (u32x4*)(XG + (size_t)s * DM); dst[lane] = zz; dst[lane + 64] = zz; } } }
        }
        __syncthreads();
    }
}
}

#define XB_TMO      128
#define XB_XCNT(j)  (256  + 64 * (j))
#define XB_XSUB(j)  (1280 + 64 * (j))
#define XB_XGEN(j)  (2304 + 64 * (j))
#define XB_TOP      3328
#define XB_TOPGEN   3392
#define XCD_BAR_WORDS 3456
#define XB_SPIN_CAP (1u << 18)
__device__ __forceinline__ unsigned xb_ld(unsigned* p)              { return __hip_atomic_load(p, __ATOMIC_RELAXED, __HIP_MEMORY_SCOPE_AGENT); }
__device__ __forceinline__ unsigned xb_add(unsigned* p, unsigned v) { return __hip_atomic_fetch_add(p, v, __ATOMIC_RELAXED, __HIP_MEMORY_SCOPE_AGENT); }
__device__ __forceinline__ unsigned xb_xcc_id() { return (unsigned)__builtin_amdgcn_s_getreg((3 << 11) | 20) & 0xFu; }
#define XB_SPIN(cond, bar) do { unsigned _sp = 0; while (cond) { __builtin_amdgcn_s_sleep(1); \
    if ((++_sp & 255u) == 0u) { if (xb_ld(&(bar)[XB_TMO])) break; if (_sp > XB_SPIN_CAP) { atomicAdd(&(bar)[XB_TMO], 1u); break; } } } } while (0)
struct XcdBarrier { unsigned* bar; unsigned x; volatile LAS unsigned* st; };
__device__ __forceinline__ XcdBarrier xcd_barrier_post(unsigned* bar, volatile LAS unsigned* st) {
    XcdBarrier b; b.bar = bar; b.x = xb_xcc_id(); b.st = st;
    if (threadIdx.x == 0) (void)xb_add(&bar[XB_XCNT(b.x)], 1u);
    return b;
}
__device__ __forceinline__ void xcd_barrier_complete(unsigned* bar, unsigned x, unsigned& nloc, unsigned& nx) {
    const unsigned G = gridDim.x * gridDim.y * gridDim.z;
    unsigned sum, cnt, mine, sp = 0u;
    for (;;) {
        sum = 0u; cnt = 0u; mine = 0u;
#pragma unroll
        for (unsigned j = 0; j < 16; ++j) { const unsigned c = xb_ld(&bar[XB_XCNT(j)]); sum += c; cnt += (c > 0u) ? 1u : 0u; mine = (j == x) ? c : mine; }
        if (sum == G) break;
        __builtin_amdgcn_s_sleep(1);
        if ((++sp & 255u) == 0u) { if (xb_ld(&bar[XB_TMO])) break; if (sp > XB_SPIN_CAP) { atomicAdd(&bar[XB_TMO], 1u); break; } }
    }
    nloc = mine > 0u ? mine : 1u; nx = cnt > 0u ? cnt : 1u;
}
__device__ __forceinline__ void xcd_barrier(const XcdBarrier& b, bool leader) {
    asm volatile("s_waitcnt vmcnt(0)" ::: "memory");
    __syncthreads();
    if (leader) {
        unsigned zo_; asm volatile("v_mov_b32 %0, 0" : "=v"(zo_)); unsigned* bar = b.bar + zo_;
        __builtin_amdgcn_s_waitcnt(0);
        unsigned nloc = b.st[0], nx = b.st[1];
        if (nloc == 0u) { xcd_barrier_complete(bar, b.x, nloc, nx); b.st[0] = nloc; b.st[1] = nx; }
        const unsigned old = xb_add(&bar[XB_XSUB(b.x)], 1u);
        const unsigned gen = old / nloc;
        if (old + 1u == (gen + 1u) * nloc) {
            __builtin_amdgcn_fence(__ATOMIC_RELEASE, "agent");
            asm volatile("s_waitcnt vmcnt(0)" ::: "memory");
            const unsigned og = xb_add(&bar[XB_TOP], 1u);
            const unsigned tg = og / nx;
            if (og + 1u == (tg + 1u) * nx) xb_add(&bar[XB_TOPGEN], 1u);
            else XB_SPIN(xb_ld(&bar[XB_TOPGEN]) == tg, bar);
            __builtin_amdgcn_fence(__ATOMIC_ACQUIRE, "agent");
            xb_add(&bar[XB_XGEN(b.x)], 1u);
            asm volatile("s_waitcnt vmcnt(0)" ::: "memory");
        } else {
            XB_SPIN(xb_ld(&bar[XB_XGEN(b.x)]) == gen, bar);
            __builtin_amdgcn_fence(__ATOMIC_ACQUIRE, "agent");
            asm volatile("s_waitcnt vmcnt(0)" ::: "memory");
        }
    }
    __syncthreads();
}

constexpr int MEGA_LDS = 147456, LDSCTL_OFF = 131072;
constexpr int CW_BAR = 4096;
constexpr size_t CTL_ZERO_BYTES = 524288;

__device__ __forceinline__ KP kargs() { KP pp = (KP)__builtin_amdgcn_kernarg_segment_ptr(); asm volatile("" : "+s"(pp)); return pp; }
#define KIN(i) (kargs()->in[i])
#define KWS (kargs()->ws)
#define KOUT (kargs()->out)
#ifndef DUP_ID
#define DUP_ID 0
#define DUP_N 1
#endif
#define REP(id) for (int rep_ = 0; rep_ < ((DUP_ID == (id)) ? DUP_N : 1); ++rep_)
__global__ void __launch_bounds__(512, 2) mega(Ptrs Pdummy) {
    extern __shared__ __attribute__((aligned(16))) unsigned char lds_raw[];
    LAS unsigned char* lds = (LAS unsigned char*)lds_raw;
    const int G = (int)gridDim.x, c = (int)blockIdx.x, wbase = __builtin_amdgcn_readfirstlane((int)threadIdx.x) & ~63;
    { volatile LAS unsigned* MISC0 = (volatile LAS unsigned*)(lds + LDSCTL_OFF); if (threadIdx.x < 64) MISC0[threadIdx.x] = 0u; }
    __syncthreads();
    (void)xcd_barrier_post((unsigned*)(KWS + WS_CTL) + CW_BAR, (volatile LAS unsigned*)(lds + LDSCTL_OFF) + 8);
#define GRID_BAR() do { XcdBarrier b_; b_.bar = (unsigned*)(KWS + WS_CTL) + CW_BAR; b_.x = xb_xcc_id(); b_.st = (volatile LAS unsigned*)(lds + LDSCTL_OFF) + 8; xcd_barrier(b_, opaque_tid(wbase) == 0); } while (0)
#define HBUF(k) ((bf16*)(ws + ((k) ? WS_HB2 : WS_HB)))
#define SBUF(k) ((float*)(ws + WS_SSQ) + ((k) ? (size_t)16 * M : (size_t)0))
#define WAVE_IDS() const int tid = opaque_tid(wbase), lane = tid & 63, wid = __builtin_amdgcn_readfirstlane(tid >> 6), gw = c * 8 + wid, ngw = G * 8; (void)tid; (void)lane; (void)gw; (void)ngw

    REP(1) { WAVE_IDS(); const KP P = kargs(); unsigned char* ws = P->ws; LAS float* scr = (LAS float*)(lds + wid * 16384);
      { constexpr int NJ = 30 + 128 + (INPROJ_GATES_FP8 ? DEPTH : 0); LAS int* pref = (LAS int*)(lds + 9216);
        if (tid < NJ) { const CJob jb = static_job(P, tid); pref[512 + tid] = (jb.K / 64) * (jb.N / 32); }
        __syncthreads();
        if (tid == 0) { int s = 0; for (int j = 0; j < NJ; ++j) { pref[j] = s; s += pref[512 + j]; } pref[NJ] = s; }
        __syncthreads();
        conv_static_all(P, pref, NJ, scr, gw, ngw, lane); }
      if ((INPROJ_FP8 || INPROJ_GATES_FP8)) { for (int m = gw; m < M; m += ngw) rowstats_row<false>(P->in[0] + (size_t)m * DM, HBUF(0) + (size_t)m * DM, SBUF(0) + 16 * (size_t)m, nullptr, nullptr, lane, ws + WS_HB8 + (size_t)m * DM); }
      else for (int m = gw; m < M; m += 2 * ngw) { const int m2 = m + ngw;
          if (m2 >= M) { rowstats_row<false>(P->in[0] + (size_t)m * DM, HBUF(0) + (size_t)m * DM, SBUF(0) + 16 * (size_t)m, nullptr, nullptr, lane); break; }
          rowstats_x2(P->in[0] + (size_t)m * DM, HBUF(0) + (size_t)m * DM, SBUF(0) + 16 * (size_t)m, P->in[0] + (size_t)m2 * DM, HBUF(0) + (size_t)m2 * DM, SBUF(0) + 16 * (size_t)m2, lane); }
      bf16* PB = (bf16*)(ws + WS_PB);
      cvt_p_bf16((const f32x4*)P->in[1], (u32x2*)PB, c * 512 + tid, G * 512); }
    GRID_BAR();

    if (DUP_ID == 20) for (int rep_ = 0; rep_ < DUP_N; ++rep_) GRID_BAR();
    int hc = 0, sc = 0;
    for (int l = 0; l < DEPTH; ++l) {
        if ((INPROJ_FP8_MASK >> l) & 1) {
          REP(2) { unsigned char* ws = KWS; pg8::Gemm g{(const bf16*)(ws + WS_HB8), (const bf16*)(ws + WS_WIN + (size_t)l * NIN * DM * 2), DM / 2, 0}; pg8::StaticOrder S; S.init(M, NIN, opaque_s(G), opaque_s(c));
            pg8::EpiInproj<false> E{(bf16*)(ws + WS_R + R_U), SBUF(sc), KIN(4) + l * 64, KIN(5) + l * 64, 0, 1.f / WIN_SCALE}; pg8::gemm_phase<pg8::EpiInproj<false>, pg8::StaticOrder, true, true, true>(lds, g, S, E, wbase); }
        } else
        REP(2) { unsigned char* ws = KWS; pg8::Gemm g{HBUF(hc), (const bf16*)(ws + WS_WIN + (size_t)l * NIN * DM * 2), DM, 0}; pg8::StaticOrder S; S.init(M, INPROJ_GATES_FP8 ? NIN_A : NIN, opaque_s(G), opaque_s(c));
          pg8::EpiInproj<false> E{(bf16*)(ws + WS_R + R_U), SBUF(sc), KIN(4) + l * 64, KIN(5) + l * 64, 0, 1.f}; pg8::gemm_phase<pg8::EpiInproj<false>, pg8::StaticOrder, true, true>(lds, g, S, E, wbase); }
        if (INPROJ_GATES_FP8) REP(2) { unsigned char* ws = KWS; pg8::Gemm g{(const bf16*)(ws + WS_HB8), (const bf16*)(ws + WS_WIN + (size_t)l * NIN * DM * 2 + (size_t)NIN_A * DM * 2), DM / 2, 0}; pg8::StaticOrder S; S.init(M, NIN_B, opaque_s(G), opaque_s(c));
          pg8::EpiInproj<true> E{(bf16*)(ws + WS_R + R_U), SBUF(sc), nullptr, nullptr, NIN_A / 256, 1.f / WIN_SCALE}; pg8::gemm_phase<pg8::EpiInproj<true>, pg8::StaticOrder, true, true, true>(lds, g, S, E, wbase); }
        REP(3) { unsigned char* ws = KWS; pg8::Gemm g{(const bf16*)(ws + WS_PB), (const bf16*)(ws + WS_WPP) + (size_t)l * DM * PLE, PLE, 0}; pg8::StaticOrder S; S.init(M, DM, opaque_s(G), opaque_s(c));
          pg8::EpiStore16 E{(bf16*)(ws + WS_PP), DM, 1.f}; pg8::gemm_phase<pg8::EpiStore16, pg8::StaticOrder, true, true>(lds, g, S, E, wbase); }
        GRID_BAR();
        const bool cf_ = (l & 1) && ((opaque_s(c) >> 3) & 1);
        if (cf_) { __syncthreads(); WAVE_IDS(); const KP P = kargs(); LAS float* scr = (LAS float*)(lds + wid * 16384); conv_moe_layer(P, l >> 1, scr, gw, ngw, lane); __syncthreads(); }
        REP(4) { unsigned char* ws = KWS; attn::attn_phase(lds, (const bf16*)(ws + WS_R + R_U), (bf16*)(ws + WS_R + R_YA), KIN(6) + l * 16, KIN(7), G, c, wbase, (MERGE_FP8_MASK >> opaque_s(l)) & 1); }
        REP(5) { unsigned char* ws = KWS; const bf16* Wt = (const bf16*)(ws + WS_LRUW) + (size_t)l * 2 * 16 * 64 * 64; __syncthreads();
          lru::lru_scan(lds, (const bf16*)(ws + WS_R + R_U), (bf16*)(ws + WS_R + R_HR), (bf16*)(ws + WS_R + R_PQ), (float*)(ws + WS_AGG), Wt, KIN(8) + l * 4 * DM, KIN(9) + l * DM, KIN(11) + l * DM, KIN(13) + l * DM, KIN(14) + l * DM, G, c, wbase,
                        (bf16*)(ws + WS_R + R_YB), (unsigned*)(ws + WS_CTL + CTL_LRUFLAG), (unsigned)(l + 1), (unsigned*)(ws + WS_CTL) + CW_BAR + XB_TMO, (MERGE_FP8_MASK >> opaque_s(l)) & 1); }
        if (l + 1 < DEPTH) REP(6) { unsigned char* ws = KWS; const f32x4* src = (const f32x4*)(KIN(1) + (size_t)(l + 1) * M * PLE); bf16* PB = (bf16*)(ws + WS_PB);
            cvt_p_bf16(src, (u32x2*)PB, opaque_s(c) * 512 + opaque_tid(wbase), G * 512); }
        if ((l & 1) && !cf_) REP(7) { __syncthreads(); WAVE_IDS(); const KP P = kargs(); LAS float* scr = (LAS float*)(lds + wid * 16384);
            conv_moe_layer(P, l >> 1, scr, gw, ngw, lane); }
        GRID_BAR();
        if (!LRU_FUSED) {
        if ((MERGE_FP8_MASK >> opaque_s(l)) & 1) { unsigned char* ws = KWS; lru::lru_apply<true>((const bf16*)(ws + WS_R + R_U), (const bf16*)(ws + WS_R + R_HR), (const bf16*)(ws + WS_R + R_PQ), (const float*)(ws + WS_AGG), (bf16*)(ws + WS_R + R_YB), G, c, wbase); }
        else REP(8) { unsigned char* ws = KWS; lru::lru_apply<false>((const bf16*)(ws + WS_R + R_U), (const bf16*)(ws + WS_R + R_HR), (const bf16*)(ws + WS_R + R_PQ), (const float*)(ws + WS_AGG), (bf16*)(ws + WS_R + R_YB), G, c, wbase); }
        GRID_BAR();
        }
        {
        if ((MERGE_FP8_MASK >> opaque_s(l)) & 1) {
          REP(9) { unsigned char* ws = KWS; pg8::Gemm g{(const bf16*)(ws + WS_R + R_YA), (const bf16*)(ws + WS_WPA) + (size_t)l * DM * DM, DM / 2, 0};
            pg8::MergeOrder S; S.A1 = (const bf16*)(ws + WS_R + R_YB); S.Bt1 = (const bf16*)(ws + WS_WPB) + (size_t)l * DM * DM; S.so.init(M, DM, opaque_s(G), opaque_s(c));
            pg8::EpiMerge<true> E{(bf16*)(ws + WS_R + R_MB), (const bf16*)(ws + WS_R + R_U), MB8_SCALE / (WIN_SCALE * Y8_SCALE), 0}; pg8::gemm_phase<pg8::EpiMerge<true>, pg8::MergeOrder, true, true, true>(lds, g, S, E, wbase); }
        } else if ((OUT_FP8_MASK & ~MERGE_FP8_MASK) != 0 && ((OUT_FP8_MASK >> opaque_s(l)) & 1)) { unsigned char* ws = KWS; pg8::Gemm g{(const bf16*)(ws + WS_R + R_YA), (const bf16*)(ws + WS_WPA) + (size_t)l * DM * DM, DM, 0};
          pg8::MergeOrder S; S.A1 = (const bf16*)(ws + WS_R + R_YB); S.Bt1 = (const bf16*)(ws + WS_WPB) + (size_t)l * DM * DM; S.so.init(M, DM, opaque_s(G), opaque_s(c));
          pg8::EpiMerge<true> E{(bf16*)(ws + WS_R + R_MB), (const bf16*)(ws + WS_R + R_U), MB8_SCALE, 0}; pg8::gemm_phase<pg8::EpiMerge<true>, pg8::MergeOrder, true, true>(lds, g, S, E, wbase); }
        else
        REP(9) { unsigned char* ws = KWS; pg8::Gemm g{(const bf16*)(ws + WS_R + R_YA), (const bf16*)(ws + WS_WPA) + (size_t)l * DM * DM, DM, 0};
          pg8::MergeOrder S; S.A1 = (const bf16*)(ws + WS_R + R_YB); S.Bt1 = (const bf16*)(ws + WS_WPB) + (size_t)l * DM * DM; S.so.init(M, DM, opaque_s(G), opaque_s(c));
          pg8::EpiMerge<false> E{(bf16*)(ws + WS_R + R_MB), (const bf16*)(ws + WS_R + R_U), 1.f, 0}; pg8::gemm_phase<pg8::EpiMerge<false>, pg8::MergeOrder, true, true>(lds, g, S, E, wbase); }
        GRID_BAR();
        if ((OUT_FP8_MASK >> opaque_s(l)) & 1) { unsigned char* ws = KWS; pg8::Gemm g{(const bf16*)(ws + WS_R + R_MB), (const bf16*)(ws + WS_WOUT) + (size_t)l * DM * DM, DM / 2, 0}; pg8::StaticOrder S; S.init(M, DM, opaque_s(G), opaque_s(c));
          pg8::EpiResid<0, 2> E{HBUF(hc), HBUF(hc), nullptr, SBUF(sc ^ 1), nullptr, nullptr, (l & 1) ? nullptr : ws + WS_HB8, 1.f / (WIN_SCALE * MB8_SCALE), 0}; pg8::gemm_phase<pg8::EpiResid<0, 2>, pg8::StaticOrder, true, true, true>(lds, g, S, E, wbase); }
        else
        for (int rep_ = 0; rep_ < ((DUP_ID == 10 && l == 0) ? DUP_N : 1); ++rep_) { unsigned char* ws = KWS; pg8::Gemm g{(const bf16*)(ws + WS_R + R_MB), (const bf16*)(ws + WS_WOUT) + (size_t)l * DM * DM, DM, 0}; pg8::StaticOrder S; S.init(M, DM, opaque_s(G), opaque_s(c));
          pg8::EpiResid<0> E{HBUF(hc), HBUF(hc), nullptr, SBUF(sc ^ 1), nullptr, nullptr, (!(l & 1) && ((DENSE_FP8_MASK >> (l >> 1)) & 1)) ? ws + WS_HB8 : nullptr, 1.f, 0}; pg8::gemm_phase<pg8::EpiResid<0>, pg8::StaticOrder, true, true>(lds, g, S, E, wbase); }
        }
        sc ^= 1;
        GRID_BAR();
        if (!(l & 1)) {
            if ((DENSE_FP8_MASK >> (l >> 1)) & 1) {
                REP(11) { unsigned char* ws = KWS; pg8::Gemm g{(const bf16*)(ws + WS_HB8), (const bf16*)(ws + WS_W13D) + (size_t)(l >> 1) * 2 * DFF * DM, DM / 2, 0}; pg8::StaticOrder S; S.init(M, 2 * DFF, opaque_s(G), opaque_s(c));
                  pg8::EpiSwiglu<false> E{(bf16*)(ws + WS_R + R_G), SBUF(sc), nullptr, nullptr, 1, 1.f / W13_SCALE}; pg8::gemm_phase<pg8::EpiSwiglu<false>, pg8::StaticOrder, true, true, true>(lds, g, S, E, wbase); }
                GRID_BAR();
                { unsigned char* ws = KWS; pg8::Gemm g{(const bf16*)(ws + WS_R + R_G), (const bf16*)(ws + WS_W2D) + (size_t)(l >> 1) * DM * DFF, DFF / 2, 0}; pg8::StaticOrder S; S.init(M, DM, opaque_s(G), opaque_s(c));
                  pg8::EpiResid<0> E{HBUF(hc), HBUF(hc), nullptr, SBUF(sc ^ 1), nullptr, nullptr, nullptr, 1.f / (W2_SCALE * G8_SCALE), 0}; pg8::gemm_phase<pg8::EpiResid<0>, pg8::StaticOrder, true, true, true>(lds, g, S, E, wbase); sc ^= 1; }
                GRID_BAR();
            } else {
                REP(11) { unsigned char* ws = KWS; pg8::Gemm g{HBUF(hc), (const bf16*)(ws + WS_W13D) + (size_t)(l >> 1) * 2 * DFF * DM, DM, 0}; pg8::StaticOrder S; S.init(M, 2 * DFF, opaque_s(G), opaque_s(c));
                  pg8::EpiSwiglu<false> E{(bf16*)(ws + WS_R + R_G), SBUF(sc), nullptr, nullptr, 0, 1.f}; pg8::gemm_phase<pg8::EpiSwiglu<false>, pg8::StaticOrder, true, true>(lds, g, S, E, wbase); }
                GRID_BAR();
                { unsigned char* ws = KWS; pg8::Gemm g{(const bf16*)(ws + WS_R + R_G), (const bf16*)(ws + WS_W2D) + (size_t)(l >> 1) * DM * DFF, DFF, 0}; pg8::StaticOrder S; S.init(M, DM, opaque_s(G), opaque_s(c));
                  pg8::EpiResid<0> E{HBUF(hc), HBUF(hc), nullptr, SBUF(sc ^ 1), nullptr, nullptr, nullptr, 1.f, 0}; pg8::gemm_phase<pg8::EpiResid<0>, pg8::StaticOrder, true, true>(lds, g, S, E, wbase); sc ^= 1; }
                GRID_BAR();
            }
        } else {
            REP(12) { unsigned char* ws = KWS; moe::route_a(lds, HBUF(hc), SBUF(sc), KIN(18) + l * DM, KIN(22) + (size_t)(l >> 1) * DM * NEXP, KIN(23) + (l >> 1) * NEXP, (int*)(ws + WS_SEL), (float*)(ws + WS_SEL + 256 * 1024), (int*)(ws + WS_SLOT + 964 * 1024), G, c, wbase); }
            GRID_BAR();
            REP(13) { unsigned char* ws = KWS; moe::route_b(lds, (const int*)(ws + WS_SEL), (const float*)(ws + WS_SEL + 256 * 1024), SBUF(sc), (const int*)(ws + WS_SLOT + 964 * 1024), HBUF(hc), (int*)(ws + WS_SLOT), (float*)(ws + WS_SLOT + 320 * 1024),
                                             (float*)(ws + WS_SLOT + 640 * 1024), (int*)(ws + WS_SEL + 512 * 1024), (int*)(ws + WS_SLOT + 960 * 1024), (bf16*)(ws + WS_R + R_XG), G, c, wbase); }
            GRID_BAR();
            REP(14) { unsigned char* ws = KWS; pg8::Gemm g{(const bf16*)(ws + WS_R + R_XG8), (const bf16*)(ws + WS_W13E), MOE_FP8 ? DM / 2 : DM, 0}; pg8::MoeOrder S; S.meta = (const int*)(ws + WS_SLOT + 960 * 1024); S.wstride = (size_t)2 * DFF * DM / (MOE_FP8 ? 2 : 1); S.N = 2 * DFF; S.pad0 = 0; S.setup(opaque_s(G), opaque_s(c));
              pg8::EpiSwiglu<true> E{(bf16*)(ws + WS_R + R_GM), nullptr, (const float*)(ws + WS_SLOT + 320 * 1024), (const float*)(ws + WS_SLOT + 640 * 1024), 0, 1.f}; pg8::gemm_phase<pg8::EpiSwiglu<true>, pg8::MoeOrder, true, true, MOE_FP8>(lds, g, S, E, wbase); }
            GRID_BAR();
            REP(15) { unsigned char* ws = KWS; pg8::Gemm g{(const bf16*)(ws + WS_R + R_GM), (const bf16*)(ws + WS_W2E), MOE_FP8 ? DFF / 2 : DFF, 0}; pg8::MoeOrder S; S.meta = (const int*)(ws + WS_SLOT + 960 * 1024); S.wstride = (size_t)DM * DFF / (MOE_FP8 ? 2 : 1); S.N = DM; S.pad0 = 0; S.setup(opaque_s(G), opaque_s(c));
              pg8::EpiStore16 E{(bf16*)(ws + WS_R + R_XG), DM, MOE_FP8 ? 1.f / (W2_SCALE * G8_SCALE) : 1.f}; pg8::gemm_phase<pg8::EpiStore16, pg8::MoeOrder, true, true, MOE_FP8>(lds, g, S, E, wbase); }
            GRID_BAR();
            { WAVE_IDS(); unsigned char* ws = KWS; const int* TSLOT = (const int*)(ws + WS_SEL + 512 * 1024); const bf16* XG = (const bf16*)(ws + WS_R + R_XG);
              for (int m = gw; m < M; m += 2 * ngw) { const int m2 = m + ngw;
                  if (m2 >= M) { rowstats_row<true>(nullptr, HBUF(hc) + (size_t)m * DM, SBUF(sc ^ 1) + 16 * (size_t)m, XG + (size_t)TSLOT[2 * m] * DM, XG + (size_t)TSLOT[2 * m + 1] * DM, lane); break; }
                  const int s1 = TSLOT[2 * m], s2 = TSLOT[2 * m + 1], s3 = TSLOT[2 * m2], s4 = TSLOT[2 * m2 + 1];
                  const bool p8 = (PLE_FP8_MASK >> l) & 1;
                  combine_rows2(HBUF(hc) + (size_t)m * DM, SBUF(sc ^ 1) + 16 * (size_t)m, XG + (size_t)s1 * DM, XG + (size_t)s2 * DM,
                                HBUF(hc) + (size_t)m2 * DM, SBUF(sc ^ 1) + 16 * (size_t)m2, XG + (size_t)s3 * DM, XG + (size_t)s4 * DM, lane,
                                p8 ? ws + WS_HB8 + (size_t)m * DM : nullptr, p8 ? ws + WS_HB8 + (size_t)m2 * DM : nullptr); } }
            sc ^= 1;
            GRID_BAR();
        }
        if ((PLE_FP8_MASK >> l) & 1) {
          unsigned char* ws = KWS; pg8::Gemm g{(const bf16*)(ws + WS_HB8), (const bf16*)(ws + WS_WPG) + (size_t)l * DM * DM, DM / 2, 0}; pg8::StaticOrder S; S.init(M, DM, opaque_s(G), opaque_s(c));
          pg8::EpiResid<1> E{HBUF(hc), HBUF(hc ^ 1), l + 1 < DEPTH ? nullptr : KOUT, SBUF(sc ^ 1), (const bf16*)(ws + WS_PP), SBUF(sc), nullptr, 1.f / WIN_SCALE, 0}; pg8::gemm_phase<pg8::EpiResid<1>, pg8::StaticOrder, true, true, true>(lds, g, S, E, wbase); sc ^= 1; hc ^= 1; }
        else
        { unsigned char* ws = KWS; pg8::Gemm g{HBUF(hc), (const bf16*)(ws + WS_WPG) + (size_t)l * DM * DM, DM, 0}; pg8::StaticOrder S; S.init(M, DM, opaque_s(G), opaque_s(c));
          pg8::EpiResid<1> E{HBUF(hc), HBUF(hc ^ 1), l + 1 < DEPTH ? nullptr : KOUT, SBUF(sc ^ 1), (const bf16*)(ws + WS_PP), SBUF(sc), ((INPROJ_FP8 || INPROJ_GATES_FP8 || ((INPROJ_FP8_MASK >> (l + 1)) & 1)) && l + 1 < DEPTH) ? ws + WS_HB8 : nullptr, 1.f, 0}; pg8::gemm_phase<pg8::EpiResid<1>, pg8::StaticOrder, true, true>(lds, g, S, E, wbase); sc ^= 1; hc ^= 1; }
        if (l + 1 < DEPTH) GRID_BAR();
    }
    { WAVE_IDS(); if (xb_ld((unsigned*)(KWS + WS_CTL) + CW_BAR + XB_TMO) != 0u) { const float q = __builtin_nanf(""); float* out = KOUT;
        for (int m = gw; m < M; m += ngw) { f32x4* o = (f32x4*)(out + (size_t)m * DM) + lane;
#pragma unroll
            for (int j = 0; j < 4; ++j) o[64 * j] = (f32x4){q, q, q, q}; } } }
#undef GRID_BAR
}

extern "C" void kernel_launch(void* const* d_in, const int* in_sizes, int n_in, void* d_out, int out_size, void* d_ws, size_t ws_size, hipStream_t stream) {
    static int ok = 0, grid = 256;
    if (ok == 0) {
        if (n_in != 30 || in_sizes[0] != M * DM || out_size != M * DM || ws_size < WS_END) { fprintf(stderr, "kernel_launch: unexpected shapes (n_in %d, ws %zu < %zu)\n", n_in, ws_size, (size_t)WS_END); ok = -1; return; }
        if (hipFuncSetAttribute((const void*)mega, hipFuncAttributeMaxDynamicSharedMemorySize, MEGA_LDS) != hipSuccess) { fprintf(stderr, "kernel_launch: hipFuncSetAttribute failed\n"); ok = -1; return; }
        int dev = 0, cus = 0;
        if (hipGetDevice(&dev) == hipSuccess && hipDeviceGetAttribute(&cus, hipDeviceAttributeMultiprocessorCount, dev) == hipSuccess && cus > 0 && cus < 256) grid = cus;
        (void)hipGetLastError();
        if (LRU_FUSED && grid != 256) { fprintf(stderr, "kernel_launch: the fused RG-LRU mapping needs a 256-workgroup grid (device has %d CUs)\n", cus); ok = -1; return; }
        ok = 1;
    }
    if (ok < 0) return;
    Ptrs P; memset(&P, 0, sizeof(P)); for (int i = 0; i < 30; ++i) P.in[i] = (const float*)d_in[i]; P.out = (float*)d_out; P.ws = (unsigned char*)d_ws;
    (void)hipMemsetAsync((unsigned char*)d_ws + WS_CTL, 0, CTL_ZERO_BYTES, stream);
    hipLaunchKernelGGL(mega, dim3(grid), dim3(512), MEGA_LDS, stream, P);
}
```

```cpp
#include <hip/hip_runtime.h>
#include <cstdio>
#include <cstdint>
#include <cstring>

#define LAS __attribute__((address_space(3)))
#define GAS __attribute__((address_space(1)))
typedef unsigned short bf16;
typedef short bf16x8 __attribute__((ext_vector_type(8)));
typedef float f32x4 __attribute__((ext_vector_type(4)));
typedef float f32x2 __attribute__((ext_vector_type(2)));
typedef unsigned u32x4 __attribute__((ext_vector_type(4)));
typedef unsigned u32x2 __attribute__((ext_vector_type(2)));

constexpr int BATCH = 8, SEQ = 4096, DM = 1024, DEPTH = 4, M = BATCH * SEQ;
constexpr int NIN = 5632, C_Q = 0, C_K = 1024, C_V = 1280, C_LX = 1536, C_LG = 2560, C_GA = 3584, C_GB = 4608;
constexpr int DFF = 3584, NEXP = 8, PLE = 256;
constexpr int NSLOT = 67584;
constexpr bool INPROJ_GATES_FP8 = false;
constexpr int NIN_A = C_LG, NIN_B = NIN - C_LG;
constexpr int INPROJ_FP8_MASK = 12;
constexpr int OUT_FP8_MASK = 12, MERGE_FP8_MASK = 12;
constexpr float Y8_SCALE = 8.f, MB8_SCALE = 16.f;
constexpr int PLE_FP8_MASK = 8;
constexpr bool INPROJ_FP8 = false;
constexpr float WIN_SCALE = 64.f;
constexpr int DENSE_FP8_MASK = 2;
constexpr bool MOE_FP8 = true;
constexpr bool LRU_FUSED = true;
constexpr size_t CTL_LRUFLAG = 262144;
static_assert(MOE_FP8 || !(INPROJ_FP8 || INPROJ_GATES_FP8), "WS_HB8 lives in the free half of the fp8 expert-weight region");
constexpr float W13_SCALE = 64.f, W2_SCALE = 128.f, G8_SCALE = 8.f;
constexpr float EPS = 1e-6f, LOG2E = 1.4426950408889634f, QSCALE = 0.125f * LOG2E;

constexpr size_t MiB = 1u << 20;
constexpr size_t WS_CTL = 0;
constexpr size_t WS_WIN = 1 * MiB;
constexpr size_t WS_WPA = 45 * MiB, WS_WPB = 53 * MiB, WS_WOUT = 61 * MiB, WS_WPG = 69 * MiB;
constexpr size_t WS_WPP = 77 * MiB;
constexpr size_t WS_W13D = 79 * MiB;
constexpr size_t WS_W2D = 107 * MiB;
constexpr size_t WS_LRUW = 121 * MiB;
constexpr size_t WS_W13E = 122 * MiB;
constexpr size_t WS_HB8 = 178 * MiB;
constexpr size_t WS_W2E = 234 * MiB;
constexpr size_t WS_PB = 290 * MiB;
constexpr size_t WS_HB = 306 * MiB;
constexpr size_t WS_SSQ = 370 * MiB;
constexpr size_t WS_SEL = 374 * MiB;
constexpr size_t WS_SLOT = 375 * MiB;
constexpr size_t WS_PP = 376 * MiB;
constexpr size_t WS_HB2 = 440 * MiB;
constexpr size_t WS_R = 504 * MiB;
constexpr size_t R_U = 0, R_YA = 352 * MiB, R_YB = 416 * MiB, R_MB = 480 * MiB, R_NA = 544 * MiB, R_NU = 576 * MiB;
constexpr size_t R_HR = R_MB, R_PQ = R_NA;
constexpr size_t WS_AGG = WS_SEL;
constexpr size_t R_G = 0;
constexpr size_t R_XG = 0, R_XG8 = 0, R_GM = 132 * MiB;
constexpr size_t WS_END = WS_R + 608 * MiB;

__host__ __device__ __forceinline__ float bf2f(bf16 x) { return __builtin_bit_cast(float, (unsigned)x << 16); }
__host__ __device__ __forceinline__ bf16 f2bf(float f) { unsigned u = __builtin_bit_cast(unsigned, f); return (bf16)((u + 0x7fffu + ((u >> 16) & 1u)) >> 16); }
__device__ __forceinline__ unsigned pk2(float lo, float hi) { return (unsigned)f2bf(lo) | ((unsigned)f2bf(hi) << 16); }
__device__ __forceinline__ float fast_exp(float x) { return __builtin_amdgcn_exp2f(x * LOG2E); }
__device__ __forceinline__ float sigmoidf_(float x) { return 1.f / (1.f + fast_exp(-x)); }
__device__ __forceinline__ float gelu_tanh(float x) { const float z = 0.7978845608028654f * (x + 0.044715f * x * x * x); return x / (1.f + fast_exp(-2.f * z)); }
__device__ __forceinline__ int lane_id() { unsigned ones = ~0u; asm volatile("" : "+s"(ones)); return (int)__builtin_amdgcn_mbcnt_hi(ones, __builtin_amdgcn_mbcnt_lo(ones, 0u)); }
__device__ __forceinline__ int opaque_tid(int wbase) { int t = wbase + lane_id(); asm volatile("" : "+v"(t)); return t; }
__device__ __forceinline__ int opaque_s(int x) { asm volatile("" : "+s"(x)); return x; }
__device__ __forceinline__ float opaque_f(float x) { asm volatile("" : "+v"(x)); return x; }
__device__ __forceinline__ unsigned opaque_u(unsigned x) { asm volatile("" : "+v"(x)); return x; }
template <int MASK> __device__ __forceinline__ float swz_f(float v) { return __builtin_bit_cast(float, __builtin_amdgcn_ds_swizzle(__builtin_bit_cast(int, v), (MASK << 10) | 0x1f)); }
template <int MASK> __device__ __forceinline__ int swz_i(int v) { return __builtin_amdgcn_ds_swizzle(v, (MASK << 10) | 0x1f); }
__device__ __forceinline__ float sum_x32(float v) { const unsigned u = __builtin_bit_cast(unsigned, v); auto rr = __builtin_amdgcn_permlane32_swap(u, u, false, false); return __builtin_bit_cast(float, (unsigned)rr[0]) + __builtin_bit_cast(float, (unsigned)rr[1]); }
__device__ __forceinline__ float max_x32(float v) { const unsigned u = __builtin_bit_cast(unsigned, v); auto rr = __builtin_amdgcn_permlane32_swap(u, u, false, false); return fmaxf(__builtin_bit_cast(float, (unsigned)rr[0]), __builtin_bit_cast(float, (unsigned)rr[1])); }
__device__ __forceinline__ int sum_x32i(int v) { auto rr = __builtin_amdgcn_permlane32_swap((unsigned)v, (unsigned)v, false, false); return (int)rr[0] + (int)rr[1]; }
__device__ __forceinline__ float get_x32(float v, int hi) { const unsigned u = __builtin_bit_cast(unsigned, v); auto rr = __builtin_amdgcn_permlane32_swap(u, u, false, false); return __builtin_bit_cast(float, hi ? (unsigned)rr[0] : (unsigned)rr[1]); }
__device__ __forceinline__ float wave_sum(float v) {
    v += swz_f<1>(v); v += swz_f<2>(v); v += swz_f<4>(v); v += swz_f<8>(v); v += swz_f<16>(v);
    return sum_x32(v);
}
__device__ __forceinline__ float rstd_of(const float* ssq, int m) {
    const f32x4* p = (const f32x4*)(ssq + 16 * (size_t)m); const f32x4 a = p[0], b = p[1], c = p[2], d = p[3];
    const float s = (((a.x + a.y) + (a.z + a.w)) + ((b.x + b.y) + (b.z + b.w))) + (((c.x + c.y) + (c.z + c.w)) + ((d.x + d.y) + (d.z + d.w)));
    return __builtin_amdgcn_rsqf(s * (1.f / 1024.f) + EPS);
}
__device__ __forceinline__ unsigned cvt_pk_bf16(float lo, float hi) { unsigned r; asm volatile("v_cvt_pk_bf16_f32 %0, %1, %2" : "=v"(r) : "v"(lo), "v"(hi)); return r; }
__device__ __forceinline__ unsigned pk4_fp8(float a, float b, float c, float d) {
    a = __builtin_amdgcn_fmed3f(a, -448.f, 448.f); b = __builtin_amdgcn_fmed3f(b, -448.f, 448.f); c = __builtin_amdgcn_fmed3f(c, -448.f, 448.f); d = __builtin_amdgcn_fmed3f(d, -448.f, 448.f);
    int w = __builtin_bit_cast(int, a); w = __builtin_amdgcn_cvt_pk_fp8_f32(a, b, w, false);
    w = __builtin_amdgcn_cvt_pk_fp8_f32(c, d, w, true); return (unsigned)w; }
__device__ __forceinline__ float fast_sigmoid(float x) { return __builtin_amdgcn_rcpf(1.f + __builtin_amdgcn_exp2f(-LOG2E * x)); }
__device__ __forceinline__ float fast_gelu_tanh(float x) { const float z = (2.f * 0.7978845608028654f * LOG2E) * (x + 0.044715f * x * x * x); return x * __builtin_amdgcn_rcpf(1.f + __builtin_amdgcn_exp2f(-z)); }
__device__ __forceinline__ f32x4 unpack_lo(u32x2 w) { return (f32x4){__builtin_bit_cast(float, w.x << 16), __builtin_bit_cast(float, w.x & 0xffff0000u), __builtin_bit_cast(float, w.y << 16), __builtin_bit_cast(float, w.y & 0xffff0000u)}; }

namespace pg8 {
typedef unsigned short bf16_t;
constexpr int BM = 256, BK = 64, HALF = 128, HTB = HALF * BK * 2, STAGE_BYTES = 8 * HTB, NXCD = 8, WGM = 8;
__host__ __device__ __forceinline__ int lds_byte(int r, int c) { const int st = (r >> 4) * 2 + (c >> 5), rr = r & 15, cc = c & 31, ob = rr * 64 + cc * 2; return st * 1024 + (ob ^ (((ob >> 9) & 1) << 5)); }
__host__ __device__ __forceinline__ void stage_rc(int b, int& R, int& C) { const int st = b / 1024, sb = b % 1024, swz = sb ^ (((sb >> 9) & 1) << 5); R = (st >> 1) * 16 + swz / 64; C = (st & 1) * 32 + (swz % 64) / 2; }
__host__ __device__ __forceinline__ int perm32(int rho) { const int n = rho >> 4, i = rho & 15; return 8 * (i >> 2) + 4 * n + (i & 3); }

struct Unit { int pm, pn, part; };
struct Gemm { const bf16_t* A; const bf16_t* Bt; int K; int pad; };

struct StaticOrder {
    int nM, nN, nwg, G, c, pad;
    __host__ __device__ void init(int M_, int N_, int G_, int c_) { nM = M_ / BM; nN = N_ / BM; nwg = nM * nN; G = G_; c = c_; pad = 0; }
    __device__ __forceinline__ void setup(int G_, int c_) { G = G_; c = c_; }
    __host__ __device__ bool next(int i, Unit& u) const {
        const int L = i * G + c; if (L >= nwg) return false;
        int wgid = L; { const int q = nwg / NXCD, r = nwg % NXCD, xcd = wgid % NXCD, off = wgid / NXCD; wgid = (xcd < r ? xcd * (q + 1) : r * (q + 1) + (xcd - r) * q) + off; }
        const int nig = WGM * nN, gid = wgid / nig, fm = gid * WGM, gsz = (nM - fm) < WGM ? (nM - fm) : WGM;
        u.pm = fm + ((wgid % nig) % gsz); u.pn = (wgid % nig) / gsz; u.part = 0; return true;
    }
    static constexpr bool TWO = false;
    __device__ __forceinline__ unsigned a_off(const Unit& u, const Gemm& g) const { return (unsigned)u.pm * (unsigned)(BM * 2) * (unsigned)g.K; }
    __device__ __forceinline__ unsigned b_off(const Unit& u, const Gemm& g) const { return (unsigned)u.pn * (unsigned)(BM * 2) * (unsigned)g.K; }
    __device__ __forceinline__ void a_ready(const Unit&) const {}
    __device__ __forceinline__ void done(const Unit&) const {}
};
struct MoeOrder {
    const int* meta; size_t wstride; int N, pad0;
    StaticOrder so; int ts[10];
    __device__ __forceinline__ void setup(int G_, int c_) {
#pragma unroll
        for (int e = 0; e < 9; ++e) ts[e] = __builtin_amdgcn_readfirstlane(__hip_atomic_load(meta + e, __ATOMIC_RELAXED, __HIP_MEMORY_SCOPE_AGENT));
        so.init(ts[8] * BM, N, G_, c_);
    }
    __device__ __forceinline__ bool next(int i, Unit& u) const { return so.next(i, u); }
    static constexpr bool TWO = false;
    __device__ __forceinline__ unsigned a_off(const Unit& u, const Gemm& g) const { return (unsigned)u.pm * (unsigned)(BM * 2) * (unsigned)g.K; }
    __device__ __forceinline__ unsigned b_off(const Unit& u, const Gemm& g) const {
        int e = 0;
#pragma unroll
        for (int j = 1; j < 8; ++j) e += (u.pm >= ts[j]) ? 1 : 0;
        return (unsigned)e * (unsigned)(wstride * 2) + (unsigned)u.pn * (unsigned)(BM * 2) * (unsigned)g.K;
    }
    __device__ __forceinline__ void a_ready(const Unit&) const {}
    __device__ __forceinline__ void done(const Unit&) const {}
};

#define EPI_ROWS(ai, m) (u.pm * BM + (ai) * HALF + wr * 64 + (m) * 16 + fr)
__device__ __forceinline__ float rstd_q(const float* ssq, int row, int fq) {
    const f32x4 p = *(const f32x4*)(ssq + 16 * (size_t)row + 4 * fq); float s = (p.x + p.y) + (p.z + p.w); s += swz_f<16>(s); s = sum_x32(s);
    return __builtin_amdgcn_rsqf(s * (1.f / 1024.f) + EPS);
}
__device__ __forceinline__ u32x4 pack8(const f32x4 a, const f32x4 b) { u32x4 w; w.x = cvt_pk_bf16(a[0], a[1]); w.y = cvt_pk_bf16(a[2], a[3]); w.z = cvt_pk_bf16(b[0], b[1]); w.w = cvt_pk_bf16(b[2], b[3]); return w; }
__device__ __forceinline__ void unpack8(const u32x4 w, f32x4& a, f32x4& b) {
    a = (f32x4){__builtin_bit_cast(float, w.x << 16), __builtin_bit_cast(float, w.x & 0xffff0000u), __builtin_bit_cast(float, w.y << 16), __builtin_bit_cast(float, w.y & 0xffff0000u)};
    b = (f32x4){__builtin_bit_cast(float, w.z << 16), __builtin_bit_cast(float, w.z & 0xffff0000u), __builtin_bit_cast(float, w.w << 16), __builtin_bit_cast(float, w.w & 0xffff0000u)}; }
template <bool GATES> struct EpiInproj {
    static constexpr bool PERM = true, AFTER_DRAIN = false, HAS_PRE = false;
    bf16* U; const float* ssq; const float* qg; const float* kg; int pn_off; float ascale;
    __device__ __forceinline__ bool reset(const Unit&) const { return true; }
    __device__ __forceinline__ void operator()(const f32x4 (&acc)[2][2][4][2], const Unit& u, int wr, int wc, int fr, int fq) const {
        const int pn = u.pn + pn_off, type = GATES ? (pn < 14 ? 3 : 4) : (pn < 4 ? 0 : pn == 4 ? 1 : pn < 10 ? 2 : pn < 14 ? 3 : 4);
        const float* gp = (type == 0 ? qg : kg) + 8 * fq; const float gsc = type == 0 ? QSCALE : 1.f;
        float rs8[2][4];
#pragma unroll
        for (int ai = 0; ai < 2; ++ai)
#pragma unroll
            for (int m = 0; m < 4; ++m) rs8[ai][m] = rstd_q(ssq, EPI_ROWS(ai, m), fq) * ascale;
#pragma unroll
        for (int ai = 0; ai < 2; ++ai)
#pragma unroll
            for (int m = 0; m < 4; ++m) { const int row = EPI_ROWS(ai, m); const float rs = rs8[ai][m]; f32x4 v[2][2];
#pragma unroll
                for (int bj = 0; bj < 2; ++bj)
#pragma unroll
                    for (int n = 0; n < 2; ++n) v[bj][n] = acc[ai][bj][m][n] * rs;
                if (!GATES && type <= 1) { float ss = 0.f;
#pragma unroll
                    for (int bj = 0; bj < 2; ++bj)
#pragma unroll
                        for (int n = 0; n < 2; ++n) ss += (v[bj][n][0] * v[bj][n][0] + v[bj][n][1] * v[bj][n][1]) + (v[bj][n][2] * v[bj][n][2] + v[bj][n][3] * v[bj][n][3]);
                    ss += swz_f<16>(ss); ss = sum_x32(ss);
                    const float r = __builtin_amdgcn_rsqf(ss * (1.f / 64.f) + EPS) * gsc;
#pragma unroll
                    for (int bj = 0; bj < 2; ++bj)
#pragma unroll
                        for (int n = 0; n < 2; ++n) v[bj][n] = v[bj][n] * r * *(const f32x4*)(gp + 32 * bj + 4 * n);
                } else if (type == 3) {
#pragma unroll
                    for (int bj = 0; bj < 2; ++bj)
#pragma unroll
                        for (int n = 0; n < 2; ++n)
#pragma unroll
                            for (int e = 0; e < 4; ++e) v[bj][n][e] = fast_gelu_tanh(v[bj][n][e]);
                } else if (type == 4) {
#pragma unroll
                    for (int bj = 0; bj < 2; ++bj)
#pragma unroll
                        for (int n = 0; n < 2; ++n)
#pragma unroll
                            for (int e = 0; e < 4; ++e) v[bj][n][e] = fmaxf(fast_sigmoid(v[bj][n][e]), 5.9604645e-8f);
                }
                bf16* rowp = U + (size_t)row * NIN + pn * BM + 64 * wc + 8 * fq;
#pragma unroll
                for (int bj = 0; bj < 2; ++bj) *(u32x4*)(rowp + 32 * bj) = pack8(v[bj][0], v[bj][1]);
            }
    }
};
struct EpiStore16 {
    static constexpr bool PERM = true, AFTER_DRAIN = false, HAS_PRE = false;
    bf16* O; int ld; float scale;
    __device__ __forceinline__ bool reset(const Unit&) const { return true; }
    __device__ __forceinline__ void operator()(const f32x4 (&acc)[2][2][4][2], const Unit& u, int wr, int wc, int fr, int fq) const {
#pragma unroll
        for (int ai = 0; ai < 2; ++ai)
#pragma unroll
            for (int m = 0; m < 4; ++m) { bf16* rowp = O + (size_t)EPI_ROWS(ai, m) * ld + u.pn * BM + wc * 32 + 8 * fq;
#pragma unroll
                for (int bj = 0; bj < 2; ++bj) *(u32x4*)(rowp + bj * HALF) = pack8(acc[ai][bj][m][0] * scale, acc[ai][bj][m][1] * scale); }
    }
};
template <bool F8> struct EpiMerge {
    static constexpr bool PERM = true, AFTER_DRAIN = false, HAS_PRE = false;
    bf16* MB; const bf16* U; float oscale; int pad_;
    __device__ __forceinline__ bool reset(const Unit& u) const { return u.part != 0; }
    __device__ __forceinline__ void operator()(f32x4 (&acc)[2][2][4][2], const Unit& u, int wr, int wc, int fr, int fq) const {
#pragma unroll
        for (int ai = 0; ai < 2; ++ai)
#pragma unroll
        for (int mb = 0; mb < 4; mb += 2) {
            u32x4 gbv[4][2], gav[4][2];
#pragma unroll
            for (int m = mb; m < mb + 2; ++m) { const int row = EPI_ROWS(ai, m);
#pragma unroll
                for (int bj = 0; bj < 2; ++bj) { const int col = u.pn * BM + bj * HALF + wc * 32 + 8 * fq; gbv[m][bj] = *(const u32x4*)(U + (size_t)row * NIN + C_GB + col);
                    if (u.part == 0) gav[m][bj] = *(const u32x4*)(U + (size_t)row * NIN + C_GA + col); } }
#pragma unroll
            for (int m = mb; m < mb + 2; ++m) { const int row = EPI_ROWS(ai, m);
#pragma unroll
                for (int bj = 0; bj < 2; ++bj) { const int col = u.pn * BM + bj * HALF + wc * 32 + 8 * fq;
                    f32x4 b0, b1; unpack8(gbv[m][bj], b0, b1);
                    if (u.part == 0) { f32x4 a0, a1; unpack8(gav[m][bj], a0, a1);
#pragma unroll
                        for (int e = 0; e < 4; ++e) { acc[ai][bj][m][0][e] *= a0[e] * __builtin_amdgcn_rcpf(b0[e]); acc[ai][bj][m][1][e] *= a1[e] * __builtin_amdgcn_rcpf(b1[e]); }
                    } else if (!F8) *(u32x4*)(MB + (size_t)row * DM + col) = pack8(acc[ai][bj][m][0] * b0, acc[ai][bj][m][1] * b1);
                    else { const f32x4 o0 = acc[ai][bj][m][0] * b0 * oscale, o1 = acc[ai][bj][m][1] * b1 * oscale;
                        { u32x2 w8; w8.x = pk4_fp8(o0[0], o0[1], o0[2], o0[3]); w8.y = pk4_fp8(o1[0], o1[1], o1[2], o1[3]); *(u32x2*)((unsigned char*)MB + (size_t)row * DM + col) = w8; }
                    }
                } }
        }
    }
};
template <int MODE, int MBAT_ = (MODE == 1 ? 2 : 4)> struct EpiResid {
    static constexpr bool PERM = true, AFTER_DRAIN = false, HAS_PRE = false;
    const bf16* hin; bf16* hout; float* outf; float* ssq_out; const bf16* PP; const float* ssq_in; unsigned char* h8; float ascale; int pad_;
    __device__ __forceinline__ bool reset(const Unit&) const { return true; }
    __device__ __forceinline__ void operator()(const f32x4 (&acc)[2][2][4][2], const Unit& u, int wr, int wc, int fr, int fq) const {
        constexpr int MBAT = MBAT_;
#pragma unroll
        for (int ai = 0; ai < 2; ++ai)
#pragma unroll
        for (int mb = 0; mb < 4; mb += MBAT) {
            u32x4 hv[4][2], pv[4][2]; float rs4[4];
#pragma unroll
            for (int m = mb; m < mb + MBAT; ++m) { const int row = EPI_ROWS(ai, m); rs4[m] = 0.f; if (MODE == 1) rs4[m] = rstd_q(ssq_in, row, fq) * ascale;
#pragma unroll
                for (int bj = 0; bj < 2; ++bj) { const size_t off = (size_t)row * DM + u.pn * BM + bj * HALF + wc * 32 + 8 * fq; hv[m][bj] = *(const u32x4*)(hin + off); if (MODE == 1) pv[m][bj] = *(const u32x4*)(PP + off); } }
#pragma unroll
            for (int m = mb; m < mb + MBAT; ++m) { const int row = EPI_ROWS(ai, m); const float rs = rs4[m]; float ss = 0.f;
#pragma unroll
                for (int bj = 0; bj < 2; ++bj) { const size_t off = (size_t)row * DM + u.pn * BM + bj * HALF + wc * 32 + 8 * fq;
                    f32x4 v0, v1; unpack8(hv[m][bj], v0, v1); const f32x4 a0 = acc[ai][bj][m][0], a1 = acc[ai][bj][m][1];
                    if (MODE == 0) { v0 = v0 + a0 * ascale; v1 = v1 + a1 * ascale; }
                    else { f32x4 p0, p1; unpack8(pv[m][bj], p0, p1);
#pragma unroll
                        for (int e = 0; e < 4; ++e) { v0[e] += fast_sigmoid(a0[e] * rs) * p0[e]; v1[e] += fast_sigmoid(a1[e] * rs) * p1[e]; } }
                    if (outf) { *(f32x4*)(outf + off) = v0; *(f32x4*)(outf + off + 4) = v1; }
                    else *(u32x4*)(hout + off) = pack8(v0, v1);
                    if (h8) { u32x2 w8; w8.x = pk4_fp8(v0[0], v0[1], v0[2], v0[3]); w8.y = pk4_fp8(v1[0], v1[1], v1[2], v1[3]); *(u32x2*)(h8 + off) = w8; }
                    ss += ((v0[0] * v0[0] + v0[1] * v0[1]) + (v0[2] * v0[2] + v0[3] * v0[3])) + ((v1[0] * v1[0] + v1[1] * v1[1]) + (v1[2] * v1[2] + v1[3] * v1[3])); }
                ss += swz_f<16>(ss); ss = sum_x32(ss);
                if (fq == 0) ssq_out[(size_t)row * 16 + u.pn * 4 + wc] = ss; }
        }
    }
};
template <bool MOE> struct EpiSwiglu {
    static constexpr bool PERM = true, AFTER_DRAIN = false, HAS_PRE = MOE && MOE_FP8;
    __device__ __forceinline__ void pre_load(float (&pre)[8], const Unit& u, int wr) const { const int fr = lane_id() & 15;
#pragma unroll
        for (int ai = 0; ai < 2; ++ai)
#pragma unroll
            for (int m = 0; m < 4; ++m) { const unsigned o4 = (unsigned)EPI_ROWS(ai, m) * 4u; asm volatile("global_load_dword %0, %1, %2" : "=v"(pre[ai * 4 + m]) : "v"(o4), "s"(sgw) : "memory"); } }
    bf16* G; const float* ssq; const float* srs; const float* sgw; int f8; float ascale;
    __device__ __forceinline__ bool reset(const Unit&) const { return true; }
    __device__ __forceinline__ void operator()(const f32x4 (&acc)[2][2][4][2], const Unit& u, int wr, int wc, int fr, int fq, const float* pre = nullptr) const {
        float rs8[2][4], gw8[2][4];
#pragma unroll
        for (int ai = 0; ai < 2; ++ai)
#pragma unroll
            for (int m = 0; m < 4; ++m) { const int row = EPI_ROWS(ai, m); float rs, gw = 1.f;
                if (MOE) { rs = (MOE_FP8 ? opaque_f(1.f / W13_SCALE) : srs[row]); gw = (HAS_PRE ? pre[ai * 4 + m] : sgw[row]) * (MOE_FP8 ? G8_SCALE : 1.f); } else { rs = rstd_q(ssq, row, fq) * ascale; if (f8) gw = G8_SCALE; }
                rs8[ai][m] = rs; gw8[ai][m] = gw; }
#pragma unroll
        for (int ai = 0; ai < 2; ++ai)
#pragma unroll
            for (int m = 0; m < 4; ++m) { const int row = EPI_ROWS(ai, m); const float rs = rs8[ai][m], gw = gw8[ai][m];
                const float rs2 = rs * gw; f32x4 o[2];
#pragma unroll
                for (int bj = 0; bj < 2; ++bj)
#pragma unroll
                    for (int e = 0; e < 4; ++e) { const float a = acc[ai][bj][m][0][e] * rs, b = acc[ai][bj][m][1][e] * rs2; o[bj][e] = a * fast_sigmoid(a) * b; }
                if ((MOE && MOE_FP8) || (!MOE && f8)) { u32x2 w; w.x = pk4_fp8(o[0][0], o[0][1], o[0][2], o[0][3]); w.y = pk4_fp8(o[1][0], o[1][1], o[1][2], o[1][3]);
                    *(u32x2*)((unsigned char*)G + (size_t)row * DFF + u.pn * HALF + wc * 32 + 8 * fq) = w; }
                else *(u32x4*)(G + (size_t)row * DFF + u.pn * HALF + wc * 32 + 8 * fq) = pack8(o[0], o[1]); }
    }
};
struct MergeOrder {
    const bf16_t* A1; const bf16_t* Bt1; StaticOrder so;
    __device__ __forceinline__ void setup(int G_, int c_) { so.setup(G_, c_); }
    __device__ __forceinline__ bool next(int i, Unit& u) const { const bool ok = so.next(i >> 1, u); u.part = i & 1; return ok; }
    static constexpr bool TWO = true;
    __device__ __forceinline__ unsigned a_off(const Unit& u, const Gemm& g) const { return (unsigned)u.pm * (unsigned)(BM * 2) * (unsigned)g.K; }
    __device__ __forceinline__ unsigned b_off(const Unit& u, const Gemm& g) const { return (unsigned)u.pn * (unsigned)(BM * 2) * (unsigned)g.K; }
    __device__ __forceinline__ void a_ready(const Unit&) const {}
    __device__ __forceinline__ void done(const Unit&) const {}
};

typedef int v8i_t __attribute__((ext_vector_type(8)));
__device__ __forceinline__ v8i_t cat8(const bf16x8 a, const bf16x8 b) { const u32x4 x = __builtin_bit_cast(u32x4, a), y = __builtin_bit_cast(u32x4, b); return (v8i_t){(int)x.x, (int)x.y, (int)x.z, (int)x.w, (int)y.x, (int)y.y, (int)y.z, (int)y.w}; }
template <class Epi, class Sched, bool ALIGN_EPI = false, bool SP2 = false, bool FP8 = false>
__device__ __forceinline__ void gemm_phase(LAS unsigned char* lds, const Gemm g, const Sched& S, const Epi& E, int wbase) {
    const int tid = opaque_tid(wbase), wid = __builtin_amdgcn_readfirstlane(tid >> 6), lane = tid & 63, wr = wid >> 2, wc = wid & 3, fr = lane & 15, fq = lane >> 4;
    const int K = opaque_s(g.K), nt = K / BK;
    unsigned voffA[2], voffB[2];
#pragma unroll
    for (int i = 0; i < 2; ++i) { int R, C; stage_rc(tid * 16 + i * 8192, R, C); const int Rb = Epi::PERM ? ((R & ~31) + perm32(R & 31)) : R;
        voffA[i] = (unsigned)(R * K + C) * 2u; voffB[i] = (unsigned)(Rb * K + C) * 2u; }
    const unsigned kstep = (unsigned)(BK * 2);
    const unsigned hstep = (unsigned)HALF * (unsigned)K * 2u;
    typedef __amdgpu_buffer_rsrc_t rsrc_t;
    const rsrc_t rA0 = __builtin_amdgcn_make_buffer_rsrc((void*)g.A, 0, 0xffffffff, 0x00020000), rB0 = __builtin_amdgcn_make_buffer_rsrc((void*)g.Bt, 0, 0xffffffff, 0x00020000);
    rsrc_t rA1 = rA0, rB1 = rB0;
    if constexpr (Sched::TWO) { rA1 = __builtin_amdgcn_make_buffer_rsrc((void*)S.A1, 0, 0xffffffff, 0x00020000); rB1 = __builtin_amdgcn_make_buffer_rsrc((void*)S.Bt1, 0, 0xffffffff, 0x00020000); }
    const unsigned ldsw = (unsigned)wid * 1024u;
    const int aoff = lds_byte(wr * 64 + fr, fq * 8), boff = lds_byte(wc * 32 + fr, fq * 8);
#define PG8_SA(b, h) (((b) * 2 + (h)) * HTB)
#define PG8_SB(b, h) ((4 + (b) * 2 + (h)) * HTB)
#define PG8_STAGE(bufoff, rs_, soff_, voff) do { _Pragma("unroll") for (int _i = 0; _i < 2; ++_i) \
        __builtin_amdgcn_raw_ptr_buffer_load_lds(rs_, (LAS void*)(lds + (bufoff) + ldsw + _i * 8192), 16, (int)(voff)[_i], (int)(soff_), 0, 0); } while (0)
#define PG8_LD2(p_) cat8(*(const LAS bf16x8*)(p_), *(const LAS bf16x8*)((p_) + 1024))
#define PG8_LDA(dst, b, h) do { _Pragma("unroll") for (int m = 0; m < 4; ++m) dst[m] = PG8_LD2(lds + PG8_SA(b, h) + aoff + m * 2048); } while (0)
#define PG8_LDB(dst, b, h) do { _Pragma("unroll") for (int n = 0; n < 2; ++n) dst[n] = PG8_LD2(lds + PG8_SB(b, h) + boff + n * 2048); } while (0)
#define PG8_LO(v_) __builtin_bit_cast(bf16x8, __builtin_shufflevector(v_, v_, 0, 1, 2, 3))
#define PG8_HI(v_) __builtin_bit_cast(bf16x8, __builtin_shufflevector(v_, v_, 4, 5, 6, 7))
#define PG8_MMA(ai, bj, At, Bt) do { __builtin_amdgcn_s_setprio(1); \
        if constexpr (FP8) { _Pragma("unroll") for (int m = 0; m < 4; ++m) _Pragma("unroll") for (int n = 0; n < 2; ++n) \
            acc[ai][bj][m][n] = __builtin_amdgcn_mfma_scale_f32_16x16x128_f8f6f4(Bt[n], At[m], acc[ai][bj][m][n], 0, 0, 0, 0x7f7f7f7f, 0, 0x7f7f7f7f); } \
        else { _Pragma("unroll") for (int m = 0; m < 4; ++m) _Pragma("unroll") for (int n = 0; n < 2; ++n) { \
            acc[ai][bj][m][n] = __builtin_amdgcn_mfma_f32_16x16x32_bf16(PG8_LO(Bt[n]), PG8_LO(At[m]), acc[ai][bj][m][n], 0, 0, 0); \
            acc[ai][bj][m][n] = __builtin_amdgcn_mfma_f32_16x16x32_bf16(PG8_HI(Bt[n]), PG8_HI(At[m]), acc[ai][bj][m][n], 0, 0, 0); } } \
        __builtin_amdgcn_s_setprio(0); } while (0)
#define PG8_WAIT_V(n) asm volatile("s_waitcnt vmcnt(" #n ")" ::: "memory")
#define PG8_WAIT_L(n) asm volatile("s_waitcnt lgkmcnt(" #n ")" ::: "memory")
#define PG8_BAR __builtin_amdgcn_s_barrier()
#define PG8_SCHED __builtin_amdgcn_sched_barrier(0)
    Unit cur, nxt; int ui = 0;
    if (!S.next(0, cur)) return;
    f32x4 acc[2][2][4][2];
#define PG8_ZERO_ACC() do { float z_; asm volatile("v_mov_b32 %0, 0" : "=v"(z_)); _Pragma("unroll") for (int a = 0; a < 2; ++a) _Pragma("unroll") for (int b = 0; b < 2; ++b) _Pragma("unroll") for (int m = 0; m < 4; ++m) \
        _Pragma("unroll") for (int n = 0; n < 2; ++n) acc[a][b][m][n] = (f32x4){z_, z_, z_, z_}; } while (0)
    PG8_ZERO_ACC();
    v8i_t At[4], B0[2], B1[2];
    unsigned cA = S.a_off(cur, g), cB = S.b_off(cur, g); rsrc_t rAc = (Sched::TWO && cur.part) ? rA1 : rA0, rBc = (Sched::TWO && cur.part) ? rB1 : rB0;
    S.a_ready(cur);
    if constexpr (SP2) {
        PG8_STAGE(PG8_SB(0, 0), rBc, cB, voffB); PG8_STAGE(PG8_SB(0, 1), rBc, cB + hstep, voffB); PG8_STAGE(PG8_SA(0, 0), rAc, cA, voffA); PG8_STAGE(PG8_SA(0, 1), rAc, cA + hstep, voffA);
        if (wr == 1) PG8_BAR;
        PG8_WAIT_V(2); PG8_BAR;
        PG8_STAGE(PG8_SB(1, 0), rBc, cB + kstep, voffB); PG8_STAGE(PG8_SA(1, 0), rAc, cA + kstep, voffA); PG8_STAGE(PG8_SB(1, 1), rBc, cB + hstep + kstep, voffB);
        PG8_WAIT_V(6); PG8_BAR;
    } else {
        PG8_STAGE(PG8_SB(0, 0), rBc, cB, voffB); PG8_STAGE(PG8_SA(0, 0), rAc, cA, voffA); PG8_STAGE(PG8_SB(0, 1), rBc, cB + hstep, voffB); PG8_STAGE(PG8_SA(0, 1), rAc, cA + hstep, voffA);
        if (wr == 1) PG8_BAR;
        PG8_WAIT_V(4); PG8_BAR;
        PG8_STAGE(PG8_SB(1, 0), rBc, cB + kstep, voffB); PG8_STAGE(PG8_SA(1, 0), rAc, cA + kstep, voffA); PG8_STAGE(PG8_SB(1, 1), rBc, cB + hstep + kstep, voffB);
        PG8_WAIT_V(6); PG8_BAR;
    }
    for (;;) {
        const bool has_next = S.next(ui + 1, nxt);
        const unsigned nA = has_next ? S.a_off(nxt, g) : cA, nB = has_next ? S.b_off(nxt, g) : cB;
        const rsrc_t rAn = (Sched::TWO && has_next) ? (nxt.part ? rA1 : rA0) : rAc, rBn = (Sched::TWO && has_next) ? (nxt.part ? rB1 : rB0) : rBc;
        float pre_[8] = {0.f, 0.f, 0.f, 0.f, 0.f, 0.f, 0.f, 0.f};
        if constexpr (Epi::HAS_PRE) E.pre_load(pre_, cur, wr);
        for (int t = 0; t < nt; t += 2) {
            const bool last = (t == nt - 2);
            const unsigned a1 = cA + (unsigned)(t + 1) * kstep;
            const unsigned a2 = last ? nA : cA + (unsigned)(t + 2) * kstep, b2 = last ? nB : cB + (unsigned)(t + 2) * kstep; const rsrc_t rA2 = (Sched::TWO && last) ? rAn : rAc, rB2 = (Sched::TWO && last) ? rBn : rBc;
            const unsigned a3 = a2 + kstep, b3 = b2 + kstep;
            if (last && has_next) S.a_ready(nxt);
            if constexpr (SP2) {
            PG8_LDB(B0, 0, 0); PG8_LDB(B1, 0, 1); PG8_SCHED; PG8_LDA(At, 0, 0); PG8_STAGE(PG8_SA(1, 1), rAc, a1 + hstep, voffA);
            PG8_WAIT_V(8); PG8_WAIT_L(0); PG8_BAR; PG8_MMA(0, 0, At, B0); PG8_MMA(0, 1, At, B1); PG8_BAR; PG8_SCHED;
            PG8_LDA(At, 0, 1); PG8_STAGE(PG8_SB(0, 0), rB2, b2, voffB); PG8_STAGE(PG8_SB(0, 1), rB2, b2 + hstep, voffB); PG8_STAGE(PG8_SA(0, 0), rA2, a2, voffA);
            PG8_WAIT_V(8); PG8_WAIT_L(0); PG8_BAR; PG8_MMA(1, 0, At, B0); PG8_MMA(1, 1, At, B1); PG8_BAR; PG8_SCHED;
            PG8_LDB(B0, 1, 0); PG8_LDB(B1, 1, 1); PG8_SCHED; PG8_LDA(At, 1, 0); PG8_STAGE(PG8_SA(0, 1), rA2, a2 + hstep, voffA);
            PG8_WAIT_V(8); PG8_WAIT_L(0); PG8_BAR; PG8_MMA(0, 0, At, B0); PG8_MMA(0, 1, At, B1); PG8_BAR; PG8_SCHED;
            PG8_LDA(At, 1, 1); PG8_STAGE(PG8_SB(1, 0), rB2, b3, voffB); PG8_STAGE(PG8_SB(1, 1), rB2, b3 + hstep, voffB); PG8_STAGE(PG8_SA(1, 0), rA2, a3, voffA);
            PG8_WAIT_V(8); PG8_WAIT_L(0); PG8_BAR; PG8_MMA(1, 0, At, B0); PG8_MMA(1, 1, At, B1); PG8_BAR; PG8_SCHED;
            } else {
            PG8_LDB(B0, 0, 0); PG8_SCHED; PG8_LDA(At, 0, 0); PG8_STAGE(PG8_SA(1, 1), rAc, a1 + hstep, voffA);
            PG8_WAIT_L(8); PG8_BAR; PG8_WAIT_L(0); PG8_MMA(0, 0, At, B0); PG8_BAR; PG8_SCHED;
            PG8_LDB(B1, 0, 1); PG8_STAGE(PG8_SB(0, 0), rB2, b2, voffB);
            PG8_BAR; PG8_WAIT_L(0); PG8_MMA(0, 1, At, B1); PG8_BAR;
            PG8_LDA(At, 0, 1); PG8_STAGE(PG8_SA(0, 0), rA2, a2, voffA);
            PG8_BAR; PG8_WAIT_L(0); PG8_MMA(1, 0, At, B0); PG8_BAR; PG8_SCHED;
            PG8_STAGE(PG8_SB(0, 1), rB2, b2 + hstep, voffB);
            PG8_WAIT_V(6); PG8_BAR; PG8_MMA(1, 1, At, B1); PG8_BAR;
            PG8_LDB(B0, 1, 0); PG8_SCHED; PG8_LDA(At, 1, 0); PG8_STAGE(PG8_SA(0, 1), rA2, a2 + hstep, voffA);
            PG8_WAIT_L(8); PG8_BAR; PG8_WAIT_L(0); PG8_MMA(0, 0, At, B0); PG8_BAR; PG8_SCHED;
            PG8_LDB(B1, 1, 1); PG8_STAGE(PG8_SB(1, 0), rB2, b3, voffB);
            PG8_BAR; PG8_WAIT_L(0); PG8_MMA(0, 1, At, B1); PG8_BAR;
            PG8_LDA(At, 1, 1); PG8_STAGE(PG8_SA(1, 0), rA2, a3, voffA);
            PG8_BAR; PG8_WAIT_L(0); PG8_MMA(1, 0, At, B0); PG8_BAR; PG8_SCHED;
            PG8_STAGE(PG8_SB(1, 1), rB2, b3 + hstep, voffB);
            PG8_WAIT_V(6); PG8_BAR; PG8_MMA(1, 1, At, B1); PG8_BAR;
            }
        }
        if constexpr (ALIGN_EPI) { if (wr == 0) PG8_BAR; }
        { int fr_ = fr, fq_ = fq; asm volatile("" : "+v"(fr_), "+v"(fq_));
          if constexpr (Epi::HAS_PRE) E(acc, cur, wr, wc, fr_, fq_, pre_); else E(acc, cur, wr, wc, fr_, fq_); } S.done(cur);
        if (!has_next) break;
        if (E.reset(cur)) PG8_ZERO_ACC();
        cur = nxt; cA = nA; cB = nB; rAc = rAn; rBc = rBn; ++ui;
        if constexpr (ALIGN_EPI) { if (wr == 1) PG8_BAR; }
    }
    PG8_WAIT_V(0);
    if constexpr (!ALIGN_EPI) { if (wr == 0) PG8_BAR; }
    PG8_BAR;
#undef PG8_SA
#undef PG8_SB
#undef PG8_STAGE
#undef PG8_LDA
#undef PG8_ZERO_ACC
#undef PG8_LD2
#undef PG8_LO
#undef PG8_HI
#undef PG8_LDB
#undef PG8_MMA
#undef PG8_WAIT_V
#undef PG8_WAIT_L
#undef PG8_BAR
#undef PG8_SCHED
}
}

struct CJob { const float* W; const float* gain; bf16* dst; int K, N, mode, fp8; float wscale; int ldw, col0, pad; };
struct Ptrs { const float* in[30]; float* out; unsigned char* ws; };
typedef const __attribute__((address_space(4))) Ptrs* KP;

__device__ __forceinline__ void conv_load(const CJob& jb, int item, int lane, f32x4 (&v)[8]) {
    const int nblk = jb.N / 32, kb = item / nblk, nb = item % nblk, k0 = 64 * kb, n0 = 32 * nb;
    const float* src = jb.W + (size_t)(k0 + (lane >> 3)) * jb.ldw + jb.col0 + n0 + 4 * (lane & 7);
#pragma unroll
    for (int i = 0; i < 8; ++i) v[i] = __builtin_nontemporal_load((const f32x4*)(src + (size_t)(8 * i) * jb.ldw));
}
__device__ __forceinline__ void conv_finish(const CJob& jb, LAS float* scr, int item, int lane, const f32x4 (&v)[8]) {
    const int nblk = jb.N / 32, kb = item / nblk, nb = item % nblk, k0 = 64 * kb, n0 = 32 * nb;
    const int c = lane & 7;
    f32x4 g0 = (f32x4){1.f, 1.f, 1.f, 1.f}, g1 = g0;
    if (jb.gain) { g0 = *(const f32x4*)(jb.gain + k0 + 8 * c); g1 = *(const f32x4*)(jb.gain + k0 + 8 * c + 4); }
#pragma unroll
    for (int i = 0; i < 8; ++i) { LAS float* d = scr + ((lane >> 3) + 8 * i) * 33 + 4 * (lane & 7); d[0] = v[i].x; d[1] = v[i].y; d[2] = v[i].z; d[3] = v[i].w; }
    asm volatile("s_waitcnt lgkmcnt(0)" ::: "memory");
#pragma unroll
    for (int j = 0; j < 4; ++j) { const int n = (lane >> 3) + 8 * j; const LAS float* s = scr + (8 * c) * 33 + n;
        u32x4 o; o.x = cvt_pk_bf16(s[0 * 33] * g0.x, s[1 * 33] * g0.y); o.y = cvt_pk_bf16(s[2 * 33] * g0.z, s[3 * 33] * g0.w); o.z = cvt_pk_bf16(s[4 * 33] * g1.x, s[5 * 33] * g1.y); o.w = cvt_pk_bf16(s[6 * 33] * g1.z, s[7 * 33] * g1.w);
        const int nn = n0 + n; int row = nn;
        if (jb.mode == 3) { const int w = nn & 255; row = (nn & ~255) + ((w >> 5) & 1) * 128 + (w >> 6) * 32 + (w & 31); }
        else if (jb.mode >= 4) { const int r = nn & 127; row = (nn >> 7) * 256 + ((r >> 2) & 1) * 128 + (r >> 5) * 32 + ((r >> 3) & 3) * 8 + (jb.mode == 5 ? 4 : 0) + (r & 3); }
        if (jb.fp8) { const float ws_ = jb.wscale; u32x2 o8; o8.x = pk4_fp8(s[0 * 33] * g0.x * ws_, s[1 * 33] * g0.y * ws_, s[2 * 33] * g0.z * ws_, s[3 * 33] * g0.w * ws_);
            o8.y = pk4_fp8(s[4 * 33] * g1.x * ws_, s[5 * 33] * g1.y * ws_, s[6 * 33] * g1.z * ws_, s[7 * 33] * g1.w * ws_); *(u32x2*)((unsigned char*)jb.dst + (size_t)row * jb.K + k0 + 8 * c) = o8; }
        else *(u32x4*)(jb.dst + (size_t)row * jb.K + k0 + 8 * c) = o; }
    asm volatile("s_waitcnt lgkmcnt(0)" ::: "memory");
}
__device__ __forceinline__ void conv_item(const CJob& jb, LAS float* scr, int item, int lane) { f32x4 v[8]; conv_load(jb, item, lane, v); conv_finish(jb, scr, item, lane, v); }
__device__ __forceinline__ void conv_job(const CJob& jb, LAS float* scr, int gw, int ngw, int lane, int& base) {
    const int nit = (jb.K / 64) * (jb.N / 32);
    int first = gw - base; if (first < 0) first += ngw;
    for (int it = first; it < nit; it += ngw) conv_item(jb, scr, it, lane);
    base = (base + nit) % ngw;
}
__device__ __forceinline__ CJob static_job(KP P, int j) {
    CJob jb; jb.pad = 0; jb.gain = nullptr; jb.mode = 0; jb.fp8 = 0; jb.wscale = 1.f; jb.ldw = 0; jb.col0 = 0;
    if (j >= 30 + 128) { const int l = j - (30 + 128);
        jb.W = P->in[3] + (size_t)l * DM * NIN; jb.gain = P->in[2] + l * DM; jb.dst = (bf16*)(P->ws + WS_WIN + (size_t)l * NIN * DM * 2 + (size_t)NIN_A * DM * 2); jb.K = DM; jb.N = NIN_B; jb.mode = 3; jb.fp8 = 1; jb.wscale = WIN_SCALE; jb.ldw = NIN; jb.col0 = C_LG; return jb; }
    if (j < 24) { const int l = j / 6, k = j % 6;
        if (k == 0) { jb.W = P->in[3] + (size_t)l * DM * NIN; jb.gain = P->in[2] + l * DM; jb.dst = (bf16*)(P->ws + WS_WIN + (size_t)l * NIN * DM * (INPROJ_FP8 ? 1 : 2)); jb.K = DM; jb.N = INPROJ_GATES_FP8 ? NIN_A : NIN; jb.ldw = NIN; jb.mode = 3; jb.fp8 = (INPROJ_FP8 || ((INPROJ_FP8_MASK >> l) & 1)) ? 1 : 0; jb.wscale = jb.fp8 ? WIN_SCALE : 1.f; }
        else if (k == 1) { jb.W = P->in[15] + (size_t)l * DM * DM; jb.dst = (bf16*)(P->ws + WS_WPA) + (size_t)l * DM * DM; jb.K = DM; jb.N = DM; jb.fp8 = (MERGE_FP8_MASK >> l) & 1; jb.wscale = jb.fp8 ? WIN_SCALE : 1.f; }
        else if (k == 2) { jb.W = P->in[16] + (size_t)l * DM * DM; jb.dst = (bf16*)(P->ws + WS_WPB) + (size_t)l * DM * DM; jb.K = DM; jb.N = DM; jb.fp8 = (MERGE_FP8_MASK >> l) & 1; jb.wscale = jb.fp8 ? WIN_SCALE : 1.f; }
        else if (k == 3) { jb.W = P->in[17] + (size_t)l * DM * DM; jb.dst = (bf16*)(P->ws + WS_WOUT) + (size_t)l * DM * DM; jb.K = DM; jb.N = DM; jb.fp8 = (OUT_FP8_MASK >> l) & 1; jb.wscale = jb.fp8 ? WIN_SCALE : 1.f; }
        else if (k == 4) { jb.W = P->in[28] + (size_t)l * DM * DM; jb.gain = P->in[27] + l * DM; jb.dst = (bf16*)(P->ws + WS_WPG) + (size_t)l * DM * DM; jb.K = DM; jb.N = DM; jb.fp8 = (PLE_FP8_MASK >> l) & 1; jb.wscale = jb.fp8 ? WIN_SCALE : 1.f; }
        else { jb.W = P->in[29] + (size_t)l * PLE * DM; jb.dst = (bf16*)(P->ws + WS_WPP) + (size_t)l * DM * PLE; jb.K = PLE; jb.N = DM; }
    } else if (j >= 30) { const int idx = j - 30, l = idx >> 5, mat = (idx >> 4) & 1, n = idx & 15;
        jb.W = P->in[mat ? 12 : 10] + (size_t)(l * 16 + n) * 64 * 64; jb.dst = (bf16*)(P->ws + WS_LRUW) + (size_t)((l * 2 + mat) * 16 + n) * 64 * 64; jb.K = 64; jb.N = 64;
    } else { const int j2 = (j - 24) / 3, k = (j - 24) % 3;
        const bool f8 = (DENSE_FP8_MASK >> j2) & 1;
        if (k < 2) { jb.W = P->in[19 + k] + (size_t)j2 * DM * DFF; jb.gain = P->in[18] + (2 * j2) * DM; jb.dst = (bf16*)(P->ws + WS_W13D) + (size_t)j2 * 2 * DFF * DM; jb.K = DM; jb.N = DFF; jb.mode = 4 + k; jb.fp8 = f8; jb.wscale = f8 ? W13_SCALE : 1.f; }
        else { jb.W = P->in[21] + (size_t)j2 * DFF * DM; jb.dst = (bf16*)(P->ws + WS_W2D) + (size_t)j2 * DM * DFF; jb.K = DFF; jb.N = DM; jb.fp8 = f8; jb.wscale = f8 ? W2_SCALE : 1.f; }
    }
    if (jb.ldw == 0) jb.ldw = jb.N;
    return jb;
}
__device__ __forceinline__ CJob moe_job(KP P, int j2, int j) {
    CJob jb; jb.pad = 0; jb.gain = nullptr; jb.mode = 0; jb.fp8 = MOE_FP8 ? 1 : 0; jb.wscale = 1.f; jb.col0 = 0; const int e = j / 3, k = j % 3;
    if (k < 2) { jb.W = P->in[24 + k] + ((size_t)j2 * NEXP + e) * DM * DFF; jb.gain = P->in[18] + (2 * j2 + 1) * DM; jb.dst = (bf16*)(P->ws + WS_W13E + (size_t)e * 2 * DFF * DM * (MOE_FP8 ? 1 : 2)); jb.K = DM; jb.N = DFF; jb.mode = 4 + k; jb.wscale = MOE_FP8 ? W13_SCALE : 1.f; }
    else { jb.W = P->in[26] + ((size_t)j2 * NEXP + e) * DFF * DM; jb.dst = (bf16*)(P->ws + WS_W2E + (size_t)e * DM * DFF * (MOE_FP8 ? 1 : 2)); jb.K = DFF; jb.N = DM; jb.wscale = MOE_FP8 ? W2_SCALE : 1.f; }
    jb.ldw = jb.N;
    return jb;
}
__device__ __forceinline__ void conv_static_all(KP P, const LAS int* pref, int njobs, LAS float* scr, int gw, int ngw, int lane) {
#define PREF_U(j_) __builtin_amdgcn_readfirstlane(pref[j_])
    const int NT = PREF_U(njobs); int fl = gw; if (fl >= NT) return;
    int job = 0; while (fl >= PREF_U(job + 1)) ++job;
    CJob jb = static_job(P, job); f32x4 v[8]; conv_load(jb, fl - PREF_U(job), lane, v);
    for (;;) { const int nx = fl + ngw; const bool has = nx < NT; CJob jn = jb; int jobn = job; f32x4 w[8];
        if (has) { while (nx >= PREF_U(jobn + 1)) ++jobn; jn = static_job(P, jobn); conv_load(jn, nx - PREF_U(jobn), lane, w); }
        conv_finish(jb, scr, fl - PREF_U(job), lane, v);
        if (!has) break;
        jb = jn; job = jobn; fl = nx;
#pragma unroll
        for (int i = 0; i < 8; ++i) v[i] = w[i]; }
#undef PREF_U
}
__device__ __forceinline__ void conv_moe_layer(KP P, int j2, LAS float* scr, int gw, int ngw, int lane) {
    constexpr int IT = (DM / 64) * (DFF / 32), NT = 24 * IT;
    int fl = gw; if (fl >= NT) return;
    CJob jb = moe_job(P, j2, fl / IT); f32x4 v[8]; conv_load(jb, fl % IT, lane, v);
    for (;;) { const int nx = fl + ngw; const bool has = nx < NT; CJob jn = jb; f32x4 w[8];
        if (has) { jn = moe_job(P, j2, nx / IT); conv_load(jn, nx % IT, lane, w); }
        conv_finish(jb, scr, fl % IT, lane, v);
        if (!has) break;
        jb = jn; fl = nx;
#pragma unroll
        for (int i = 0; i < 8; ++i) v[i] = w[i]; }
}
template <bool COMBINE> __device__ __forceinline__ void rowstats_row(const float* xrow, bf16* hbrow, float* ssq, const bf16* o1, const bf16* o2, int lane, unsigned char* h8row = nullptr) {
    float s[4];
#pragma unroll
    for (int j = 0; j < 4; ++j) { f32x4 v;
        if (COMBINE) v = unpack_lo(*((const u32x2*)hbrow + lane + 64 * j)) + unpack_lo(*((const u32x2*)o1 + lane + 64 * j)) + unpack_lo(*((const u32x2*)o2 + lane + 64 * j));
        else v = *((const f32x4*)xrow + lane + 64 * j);
        s[j] = (v.x * v.x + v.y * v.y) + (v.z * v.z + v.w * v.w);
        u32x2 o; o.x = cvt_pk_bf16(v.x, v.y); o.y = cvt_pk_bf16(v.z, v.w); *((u32x2*)hbrow + lane + 64 * j) = o;
        if (h8row) *((unsigned*)h8row + lane + 64 * j) = pk4_fp8(v.x, v.y, v.z, v.w); }
#pragma unroll
    for (int j = 0; j < 4; ++j) s[j] = wave_sum(s[j]);
    const float v = lane == 0 ? s[0] : lane == 1 ? s[1] : lane == 2 ? s[2] : lane == 3 ? s[3] : 0.f;
    if (lane < 16) ssq[lane] = v;
}

__device__ __forceinline__ void rowstats_x2(const float* xA, bf16* hA, float* ssqA, const float* xB, bf16* hB, float* ssqB, int lane) {
    f32x4 va[4], vb[4];
#pragma unroll
    for (int j = 0; j < 4; ++j) { va[j] = __builtin_nontemporal_load((const f32x4*)xA + lane + 64 * j); vb[j] = __builtin_nontemporal_load((const f32x4*)xB + lane + 64 * j); }
    float sa[4], sb[4];
#pragma unroll
    for (int j = 0; j < 4; ++j) { const f32x4 v = va[j], w = vb[j]; sa[j] = (v.x * v.x + v.y * v.y) + (v.z * v.z + v.w * v.w); sb[j] = (w.x * w.x + w.y * w.y) + (w.z * w.z + w.w * w.w);
        u32x2 o; o.x = cvt_pk_bf16(v.x, v.y); o.y = cvt_pk_bf16(v.z, v.w); *((u32x2*)hA + lane + 64 * j) = o; o.x = cvt_pk_bf16(w.x, w.y); o.y = cvt_pk_bf16(w.z, w.w); *((u32x2*)hB + lane + 64 * j) = o; }
#pragma unroll
    for (int j = 0; j < 4; ++j) { sa[j] = wave_sum(sa[j]); sb[j] = wave_sum(sb[j]); }
    const float ua = lane == 0 ? sa[0] : lane == 1 ? sa[1] : lane == 2 ? sa[2] : lane == 3 ? sa[3] : 0.f, ub = lane == 0 ? sb[0] : lane == 1 ? sb[1] : lane == 2 ? sb[2] : lane == 3 ? sb[3] : 0.f;
    if (lane < 16) { ssqA[lane] = ua; ssqB[lane] = ub; }
}
__device__ __forceinline__ void combine_rows2(bf16* hA, float* ssqA, const bf16* a1, const bf16* a2, bf16* hB, float* ssqB, const bf16* b1, const bf16* b2, int lane, unsigned char* h8A = nullptr, unsigned char* h8B = nullptr) {
    u32x2 ra[3][4], rb[3][4];
#pragma unroll
    for (int j = 0; j < 4; ++j) { ra[0][j] = *((const u32x2*)hA + lane + 64 * j); ra[1][j] = *((const u32x2*)a1 + lane + 64 * j); ra[2][j] = *((const u32x2*)a2 + lane + 64 * j);
                                  rb[0][j] = *((const u32x2*)hB + lane + 64 * j); rb[1][j] = *((const u32x2*)b1 + lane + 64 * j); rb[2][j] = *((const u32x2*)b2 + lane + 64 * j); }
    float sa[4], sb[4];
#pragma unroll
    for (int j = 0; j < 4; ++j) { const f32x4 v = unpack_lo(ra[0][j]) + unpack_lo(ra[1][j]) + unpack_lo(ra[2][j]), w = unpack_lo(rb[0][j]) + unpack_lo(rb[1][j]) + unpack_lo(rb[2][j]);
        sa[j] = (v.x * v.x + v.y * v.y) + (v.z * v.z + v.w * v.w); sb[j] = (w.x * w.x + w.y * w.y) + (w.z * w.z + w.w * w.w);
        u32x2 o; o.x = cvt_pk_bf16(v.x, v.y); o.y = cvt_pk_bf16(v.z, v.w); *((u32x2*)hA + lane + 64 * j) = o; o.x = cvt_pk_bf16(w.x, w.y); o.y = cvt_pk_bf16(w.z, w.w); *((u32x2*)hB + lane + 64 * j) = o;
        if (h8A) { *((unsigned*)h8A + lane + 64 * j) = pk4_fp8(v.x, v.y, v.z, v.w); *((unsigned*)h8B + lane + 64 * j) = pk4_fp8(w.x, w.y, w.z, w.w); } }
#pragma unroll
    for (int j = 0; j < 4; ++j) { sa[j] = wave_sum(sa[j]); sb[j] = wave_sum(sb[j]); }
    const float va = lane == 0 ? sa[0] : lane == 1 ? sa[1] : lane == 2 ? sa[2] : lane == 3 ? sa[3] : 0.f, vb = lane == 0 ? sb[0] : lane == 1 ? sb[1] : lane == 2 ? sb[2] : lane == 3 ? sb[3] : 0.f;
    if (lane < 16) { ssqA[lane] = va; ssqB[lane] = vb; }
}

__device__ __forceinline__ void cvt_p_bf16(const f32x4* src, u32x2* dst, int i0, int stride) {
    constexpr int N4 = M * PLE / 4; int i = i0;
    for (; i + 3 * stride < N4; i += 4 * stride) { f32x4 v[4];
#pragma unroll
        for (int k = 0; k < 4; ++k) v[k] = __builtin_nontemporal_load(src + i + k * stride);
#pragma unroll
        for (int k = 0; k < 4; ++k) { u32x2 o; o.x = cvt_pk_bf16(v[k].x, v[k].y); o.y = cvt_pk_bf16(v[k].z, v[k].w); dst[i + k * stride] = o; } }
    for (; i < N4; i += stride) { const f32x4 v = __builtin_nontemporal_load(src + i); u32x2 o; o.x = cvt_pk_bf16(v.x, v.y); o.y = cvt_pk_bf16(v.z, v.w); dst[i] = o; }
}

__device__ __forceinline__ int t5_bucket(int d) {
    if (d < 16) return d;
    return 16 + (d >= 19) + (d >= 21) + (d >= 24) + (d >= 27) + (d >= 31) + (d >= 35) + (d >= 40) + (d >= 46) + (d >= 52) + (d >= 59) + (d >= 67) + (d >= 77) + (d >= 87) + (d >= 99) + (d >= 113);
}
namespace attn {
typedef float f32x16 __attribute__((ext_vector_type(16)));
typedef short s16x4 __attribute__((ext_vector_type(4)));
constexpr int KIMG = 0, VIMG = 32768, RBT = 65536, LSCR = RBT + 3072, OST = RBT + 4096, LDS_BYTES = OST + 8 * 4096;
__device__ __forceinline__ int crow(int r, int hi) { return (r & 3) + 8 * (r >> 2) + 4 * hi; }
__device__ __forceinline__ s16x4 vtr(const LAS unsigned char* p) { return __builtin_bit_cast(s16x4, __builtin_amdgcn_ds_read_tr16_b64_v4i16((LAS s16x4*)p)); }
__device__ __forceinline__ void attn_phase(LAS unsigned char* lds, const bf16* U, bf16* YA, const float* sinks, const float* rel_bias, int G, int c, int wbase, int y8) {
    const int tid = opaque_tid(wbase), lane = tid & 63, wid = __builtin_amdgcn_readfirstlane(tid >> 6), r32 = lane & 31, hi = lane >> 5;
    const int g = wid >> 1, qh = wid & 1; G = opaque_s(G); c = opaque_s(c);
    LAS float* rbt = (LAS float*)(lds + RBT); LAS float* lscr = (LAS float*)(lds + LSCR) + wid * 32; LAS bf16* stg = (LAS bf16*)(lds + OST + wid * 4096);
    int kvh_tab = -1;
    for (int L = c; L < BATCH * 32 * 4; L += G) {
        const int kvh = L & 3, n = (L >> 2) & 31, b = L >> 7;
        const int tok0 = b * SEQ + (n - 1) * 128;
        if (kvh != kvh_tab) { kvh_tab = kvh;
            for (int e = tid; e < 4 * 192; e += 512) { const int gg = e / 192, jj = e % 192, dist = 159 - jj;
                rbt[e] = (dist >= 0 && dist < 128) ? rel_bias[t5_bucket(dist) * 16 + kvh * 4 + gg] * LOG2E : -1.0e30f; } }
#pragma unroll
        for (int kg = 0; kg < 4; ++kg) { const int key = 64 * kg + lane; int t = tok0 + key; if (t < b * SEQ) t = b * SEQ;
            __builtin_amdgcn_global_load_lds((const unsigned*)(U + (size_t)t * NIN + C_K + kvh * 64 + 8 * wid), (LAS unsigned*)(lds + KIMG + wid * 4096 + kg * 1024), 16, 0, 0); }
#pragma unroll
        for (int j = 0; j < 4; ++j) { const int kg16 = 4 * (wid & 3) + j, key = 16 * kg16 + (lane >> 2); int t = tok0 + key; if (t < b * SEQ) t = b * SEQ;
            __builtin_amdgcn_global_load_lds((const unsigned*)(U + (size_t)t * NIN + C_V + kvh * 64 + 32 * (wid >> 2) + 8 * (lane & 3)), (LAS unsigned*)(lds + VIMG + (wid >> 2) * 16384 + kg16 * 1024), 16, 0, 0); }
        const size_t mq0 = (size_t)b * SEQ + n * 128 + 64 * qh;
        bf16x8 qf[2][4];
#pragma unroll
        for (int qt = 0; qt < 2; ++qt)
#pragma unroll
            for (int d0 = 0; d0 < 4; ++d0) qf[qt][d0] = *(const bf16x8*)(U + (mq0 + 32 * qt + r32) * NIN + (kvh * 4 + g) * 64 + 16 * d0 + 8 * hi);
        asm volatile("s_waitcnt vmcnt(0)" ::: "memory"); __syncthreads();
        const float sink2 = sinks[kvh * 4 + g] * LOG2E; const LAS float* bt = rbt + g * 192 + 31 - r32 + 4 * hi;
#pragma unroll
        for (int qt = 0; qt < 2; ++qt) {
            const int iq0 = 64 * qh + 32 * qt, kt0 = iq0 >> 5; const size_t mq = mq0 + 32 * qt;
            f32x16 p[5];
#pragma unroll
            for (int jt = 0; jt < 5; ++jt) { f32x16 a = {};
#pragma unroll
                for (int d0 = 0; d0 < 4; ++d0) { const bf16x8 kf = *(const LAS bf16x8*)(lds + KIMG + (2 * d0 + hi) * 4096 + (32 * (kt0 + jt) + r32) * 16); a = __builtin_amdgcn_mfma_f32_32x32x16_bf16(kf, qf[qt][d0], a, 0, 0, 0); }
                p[jt] = a; }
            float mx = sink2;
#pragma unroll
            for (int jt = 0; jt < 5; ++jt)
#pragma unroll
                for (int r = 0; r < 16; ++r) { float s = p[jt][r] + bt[32 * jt + (r & 3) + 8 * (r >> 2)];
                    if (n == 0) { if (32 * (kt0 + jt) + crow(r, hi) < 128) s = -1.0e30f; }
                    p[jt][r] = s; mx = fmaxf(mx, s); }
            mx = max_x32(mx);
            float l = 0.f;
#pragma unroll
            for (int jt = 0; jt < 5; ++jt)
#pragma unroll
                for (int r = 0; r < 16; ++r) { const float e = __builtin_amdgcn_exp2f(p[jt][r] - mx); p[jt][r] = e; l += e; }
            l = sum_x32(l); l += __builtin_amdgcn_exp2f(sink2 - mx);
            f32x16 o[2]; o[0] = (f32x16){}; o[1] = (f32x16){};
            const LAS unsigned char* vb = lds + VIMG + ((lane >> 4) & 1) * 32 + (lane & 3) * 8 + (4 * hi + ((lane & 15) >> 2)) * 64;
#pragma unroll
            for (int jt = 0; jt < 5; ++jt)
#pragma unroll
                for (int s = 0; s < 2; ++s) { u32x4 w; w.x = cvt_pk_bf16(p[jt][8 * s], p[jt][8 * s + 1]); w.y = cvt_pk_bf16(p[jt][8 * s + 2], p[jt][8 * s + 3]); w.z = cvt_pk_bf16(p[jt][8 * s + 4], p[jt][8 * s + 5]); w.w = cvt_pk_bf16(p[jt][8 * s + 6], p[jt][8 * s + 7]);
                    const bf16x8 pa = __builtin_bit_cast(bf16x8, w);
#pragma unroll
                    for (int d0 = 0; d0 < 2; ++d0) { const LAS unsigned char* vp = vb + d0 * 16384 + (32 * (kt0 + jt) + 16 * s) * 64; const s16x4 lo = vtr(vp), hv = vtr(vp + 8 * 64);
                        const bf16x8 vf = (bf16x8){lo[0], lo[1], lo[2], lo[3], hv[0], hv[1], hv[2], hv[3]};
                        o[d0] = __builtin_amdgcn_mfma_f32_32x32x16_bf16(pa, vf, o[d0], 0, 0, 0); } }
            if (hi == 0) lscr[r32] = l;
            asm volatile("s_waitcnt lgkmcnt(0)" ::: "memory");
#pragma unroll
            for (int r = 0; r < 16; r += 2) { const int qi = crow(r, hi); const float rl0 = __builtin_amdgcn_rcpf(lscr[qi]), rl1 = __builtin_amdgcn_rcpf(lscr[qi + 1]);
                const unsigned w0 = cvt_pk_bf16(o[0][r] * rl0, o[0][r + 1] * rl1), w1 = cvt_pk_bf16(o[1][r] * rl0, o[1][r + 1] * rl1);
                stg[qi * 64 + r32] = (bf16)(w0 & 0xffffu); stg[(qi + 1) * 64 + r32] = (bf16)(w0 >> 16); stg[qi * 64 + 32 + r32] = (bf16)(w1 & 0xffffu); stg[(qi + 1) * 64 + 32 + r32] = (bf16)(w1 >> 16); }
            asm volatile("s_waitcnt lgkmcnt(0)" ::: "memory");
#pragma unroll
            for (int i = 0; i < 4; ++i) { const int row = 8 * i + (lane >> 3), chn = lane & 7;
                const u32x4 sv = *(const LAS u32x4*)(stg + row * 64 + 8 * chn);
                if (y8) { f32x4 a0, a1; pg8::unpack8(sv, a0, a1); a0 = a0 * Y8_SCALE; a1 = a1 * Y8_SCALE; u32x2 w8; w8.x = pk4_fp8(a0[0], a0[1], a0[2], a0[3]); w8.y = pk4_fp8(a1[0], a1[1], a1[2], a1[3]);
                    *(u32x2*)((unsigned char*)YA + (mq + row) * DM + (kvh * 4 + g) * 64 + 8 * chn) = w8; }
                else *(u32x4*)(YA + (mq + row) * DM + (kvh * 4 + g) * 64 + 8 * chn) = sv; }
            asm volatile("s_waitcnt lgkmcnt(0)" ::: "memory");
        }
        __syncthreads();
    }
}
}

namespace lru {
typedef float f32x16 __attribute__((ext_vector_type(16)));
constexpr int TC = 128, NCK = SEQ / TC, NUNIT = BATCH * 16 * NCK, CW_BYTES = 5 * 64 * 4, ST_BYTES = 2 * 32 * 128, WAVE_LDS = ST_BYTES + CW_BYTES + 256, WL_OFF = 8 * WAVE_LDS, WL_ROW = 144, LA_OFF = 98304;
__device__ __forceinline__ int crow(int r, int hi) { return (r & 3) + 8 * (r >> 2) + 4 * hi; }
__device__ __forceinline__ void lru_scan(LAS unsigned char* lds, const bf16* U, bf16* HR, bf16* PQ, float* AGG, const bf16* Wt, const float* conv_w, const float* conv_b,
                                         const float* b_rg, const float* b_ig, const float* lam, int G, int c, int wbase, bf16* YB, unsigned* flags, unsigned epoch, unsigned* tmo, int y8) {
    const int tid = opaque_tid(wbase), lane = tid & 63, wid = __builtin_amdgcn_readfirstlane(tid >> 6), r32 = lane & 31, hi = lane >> 5; G = opaque_s(G); c = opaque_s(c);
    LAS unsigned char* wl = lds + wid * WAVE_LDS; LAS bf16* stH = (LAS bf16*)wl; LAS bf16* stP = (LAS bf16*)(wl + 32 * 128);
    LAS float* cw = (LAS float*)(wl + ST_BYTES);
    int nb_l = -1;
    for (int un = c * 8 + wid; un < NUNIT; un += G * 8) {
        const int ck = un & (NCK - 1), nb = (un >> 5) & 15, b = un >> 9, ch0 = nb * 64;
        if (nb != nb_l) {
            __syncthreads();
#pragma unroll
            for (int j = 0; j < 2; ++j) { const int p = tid + 512 * j, row = p >> 3, seg = p & 7;
                *(LAS u32x4*)(lds + WL_OFF + row * WL_ROW + seg * 16) = *(const u32x4*)(Wt + (size_t)(row >> 6) * 16 * 64 * 64 + (size_t)(nb * 64 + (row & 63)) * 64 + seg * 8); }
            __syncthreads(); nb_l = nb; }
#pragma unroll
        for (int j = 0; j < 4; ++j) cw[j * 64 + lane] = conv_w[j * DM + ch0 + lane];
        cw[4 * 64 + lane] = conv_b[ch0 + lane];
        float brg[2], big[2], sp8[2], carry[2], prodA[2];
#pragma unroll
        for (int ct = 0; ct < 2; ++ct) { const int ch = ch0 + 32 * ct + r32; brg[ct] = b_rg[ch] * -LOG2E; big[ct] = b_ig[ch] * -LOG2E; { const float x = fast_exp(-lam[ch]); sp8[ct] = (-8.f * LOG2E) * (x < 0.25f ? x * (1.f - x * (0.5f - x * ((1.f / 3.f) - x * (0.25f - x * (0.2f - x * (1.f / 6.f)))))) : (__builtin_amdgcn_logf(1.f + x) * 0.6931471805599453f)); } carry[ct] = 0.f; prodA[ct] = 1.f; }
        asm volatile("s_waitcnt lgkmcnt(0)" ::: "memory");
        u32x4 raw[4][4];
#define LRU_LOAD_RAW(st_) do { const int t_ = ck * TC + (st_) * 32 + r32; const size_t m_ = (size_t)b * SEQ + t_; _Pragma("unroll") for (int ks = 0; ks < 4; ++ks) _Pragma("unroll") for (int j = 0; j < 4; ++j) { \
            const int back_ = 3 - j; const size_t mm_ = (t_ >= back_) ? m_ - back_ : m_; raw[ks][j] = *(const u32x4*)(U + mm_ * NIN + C_LX + ch0 + 16 * ks + 8 * hi); } } while (0)
        LRU_LOAD_RAW(0);
        for (int st = 0; st < 4; ++st) {
            const int t0 = ck * TC + st * 32, t = t0 + r32;
            bf16x8 af[4];
#pragma unroll
            for (int ks = 0; ks < 4; ++ks) { const int cl = 16 * ks + 8 * hi; f32x4 x0 = *(const LAS f32x4*)(cw + 256 + cl), x1 = *(const LAS f32x4*)(cw + 256 + cl + 4);
#pragma unroll
                for (int j = 0; j < 4; ++j) { const int back = 3 - j; const bool ok = t >= back;
                    f32x4 v0, v1; pg8::unpack8(raw[ks][j], v0, v1);
                    const f32x4 w0 = *(const LAS f32x4*)(cw + j * 64 + cl), w1 = *(const LAS f32x4*)(cw + j * 64 + cl + 4);
                    if (ok) { x0 = x0 + w0 * v0; x1 = x1 + w1 * v1; } }
                af[ks] = __builtin_bit_cast(bf16x8, pg8::pack8(x0, x1)); }
            if (st < 3) LRU_LOAD_RAW(st + 1);
#pragma unroll
            for (int ct = 0; ct < 2; ++ct) {
                f32x16 R = {}, I = {}, X = {};
                int zoff; asm volatile("v_mov_b32 %0, 0" : "=v"(zoff)); const LAS unsigned char* Wp = lds + WL_OFF + zoff;
                bf16x8 wr[4], wi[4];
#pragma unroll
                for (int ks = 0; ks < 4; ++ks) { const int o = (32 * ct + r32) * WL_ROW + (16 * ks + 8 * hi) * 2; wr[ks] = *(const LAS bf16x8*)(Wp + o); wi[ks] = *(const LAS bf16x8*)(Wp + 64 * WL_ROW + o); }
#pragma unroll
                for (int ks = 0; ks < 4; ++ks) { bf16x8 idf;
#pragma unroll
                    for (int j = 0; j < 8; ++j) idf[j] = (16 * ks + 8 * hi + j == 32 * ct + r32) ? (short)0x3F80 : (short)0;
                    R = __builtin_amdgcn_mfma_f32_32x32x16_bf16(af[ks], wr[ks], R, 0, 0, 0); I = __builtin_amdgcn_mfma_f32_32x32x16_bf16(af[ks], wi[ks], I, 0, 0, 0);
                    X = __builtin_amdgcn_mfma_f32_32x32x16_bf16(af[ks], idf, X, 0, 0, 0); }
                float P[16], H[16];
#pragma unroll
                for (int r = 0; r < 16; ++r) { const float er = __builtin_amdgcn_exp2f(R[r] * -LOG2E + brg[ct]), ei = __builtin_amdgcn_exp2f(I[r] * -LOG2E + big[ct]);
                    const float e1 = 1.f + er, e2 = 1.f + ei, qq = __builtin_amdgcn_rcpf(e1 * e2), rr = qq * e2, ii = qq * e1;
                    const float a = __builtin_amdgcn_exp2f(rr * sp8[ct]);
                    P[r] = a; H[r] = __builtin_amdgcn_sqrtf(fmaxf(1.f - a * a, 0.f)) * (ii * X[r]); }
                float Ag[4], Hg[4], Ao[4], Ho[4];
#pragma unroll
                for (int g4 = 0; g4 < 4; ++g4) {
#pragma unroll
                    for (int j = 1; j < 4; ++j) { H[4 * g4 + j] = P[4 * g4 + j] * H[4 * g4 + j - 1] + H[4 * g4 + j]; P[4 * g4 + j] = P[4 * g4 + j] * P[4 * g4 + j - 1]; }
                    Ag[g4] = P[4 * g4 + 3]; Hg[g4] = H[4 * g4 + 3]; Ao[g4] = get_x32(Ag[g4], hi); Ho[g4] = get_x32(Hg[g4], hi); }
                float C = carry[ct], PC = prodA[ct], Cm[4], Pm[4];
#pragma unroll
                for (int g4 = 0; g4 < 4; ++g4) { const float A0 = hi ? Ao[g4] : Ag[g4], H0 = hi ? Ho[g4] : Hg[g4], A1 = hi ? Ag[g4] : Ao[g4], H1 = hi ? Hg[g4] : Ho[g4];
                    const float C1 = A0 * C + H0, P1 = PC * A0; Cm[g4] = hi ? C1 : C; Pm[g4] = hi ? P1 : PC; C = A1 * C1 + H1; PC = P1 * A1; }
                carry[ct] = C; prodA[ct] = PC;
#pragma unroll
                for (int r = 0; r < 16; r += 2) { const int o = crow(r, hi) * 64 + 32 * ct + r32;
                    const unsigned wh = cvt_pk_bf16(H[r] + P[r] * Cm[r >> 2], H[r + 1] + P[r + 1] * Cm[r >> 2]), wp = cvt_pk_bf16(P[r] * Pm[r >> 2], P[r + 1] * Pm[r >> 2]);
                    stH[o] = (bf16)(wh & 0xffffu); stH[o + 64] = (bf16)(wh >> 16); stP[o] = (bf16)(wp & 0xffffu); stP[o + 64] = (bf16)(wp >> 16); }
            }
            asm volatile("s_waitcnt lgkmcnt(0)" ::: "memory");
#pragma unroll
            for (int i = 0; i < 4; ++i) { const int row = (lane >> 3) + 8 * i, chn = lane & 7; const size_t go = ((size_t)b * SEQ + t0 + row) * DM + ch0 + 8 * chn;
                *(u32x4*)(HR + go) = *(const LAS u32x4*)(stH + row * 64 + 8 * chn); *(u32x4*)(PQ + go) = *(const LAS u32x4*)(stP + row * 64 + 8 * chn); }
            asm volatile("s_waitcnt lgkmcnt(0)" ::: "memory");
        }
        if (!LRU_FUSED) { if (hi == 0) {
#pragma unroll
            for (int ct = 0; ct < 2; ++ct) *(f32x2*)(AGG + ((size_t)(b * NCK + ck) * DM + ch0 + 32 * ct + r32) * 2) = (f32x2){prodA[ct], carry[ct]};
        } } else {
        if (hi == 0) {
#pragma unroll
            for (int ct = 0; ct < 2; ++ct) { const unsigned long long pk_ = (unsigned long long)__builtin_bit_cast(unsigned, prodA[ct]) | ((unsigned long long)__builtin_bit_cast(unsigned, carry[ct]) << 32);
                __hip_atomic_store((unsigned long long*)(AGG + ((size_t)(b * NCK + ck) * DM + ch0 + 32 * ct + r32) * 2), pk_, __ATOMIC_RELAXED, __HIP_MEMORY_SCOPE_AGENT); } }
        asm volatile("s_waitcnt vmcnt(0)" ::: "memory");
        if (lane == 0) __hip_atomic_store(flags + (size_t)un * 16, epoch, __ATOMIC_RELAXED, __HIP_MEMORY_SCOPE_AGENT);
        if (ck > 0) { unsigned sp_ = 0;
            for (;;) { unsigned v_ = epoch; if (lane < ck) v_ = __hip_atomic_load(flags + (size_t)(un - ck + lane) * 16, __ATOMIC_RELAXED, __HIP_MEMORY_SCOPE_AGENT);
                if (__all(v_ == epoch)) break;
                __builtin_amdgcn_s_sleep(1);
                if ((++sp_ & 255u) == 0u) { if (__hip_atomic_load(tmo, __ATOMIC_RELAXED, __HIP_MEMORY_SCOPE_AGENT)) break; if (sp_ > (1u << 18)) { atomicAdd(tmo, 1u); break; } } } }
        { const int c8 = 8 * (lane & 7), rg = lane >> 3;
          float cc = 0.f;
          { const unsigned long long* ag = (const unsigned long long*)(AGG + ((size_t)(b * NCK) * DM + ch0 + lane) * 2); int j = 0;
            for (; j + 8 <= ck; j += 8) { unsigned long long p[8];
#pragma unroll
                for (int k = 0; k < 8; ++k) p[k] = __hip_atomic_load(ag + (size_t)(j + k) * DM, __ATOMIC_RELAXED, __HIP_MEMORY_SCOPE_AGENT);
#pragma unroll
                for (int k = 0; k < 8; ++k) cc = __builtin_bit_cast(float, (unsigned)p[k]) * cc + __builtin_bit_cast(float, (unsigned)(p[k] >> 32)); }
            for (; j < ck; ++j) { const unsigned long long p = __hip_atomic_load(ag + (size_t)j * DM, __ATOMIC_RELAXED, __HIP_MEMORY_SCOPE_AGENT); cc = __builtin_bit_cast(float, (unsigned)p) * cc + __builtin_bit_cast(float, (unsigned)(p >> 32)); } }
          LAS float* const carl = (LAS float*)(lds + LA_OFF) + wid * 64; carl[lane] = cc;
          asm volatile("s_waitcnt lgkmcnt(0)" ::: "memory");
          const f32x4 c0 = *(const LAS f32x4*)(carl + c8), c1 = *(const LAS f32x4*)(carl + c8 + 4);
          for (int i = 0; i < 16; i += 4) { u32x4 hv[4], qv[4], gv[4];
#pragma unroll
              for (int k = 0; k < 4; ++k) { const size_t m = (size_t)b * SEQ + ck * TC + 8 * (i + k) + rg; hv[k] = *(const u32x4*)(HR + m * DM + ch0 + c8); qv[k] = *(const u32x4*)(PQ + m * DM + ch0 + c8); gv[k] = *(const u32x4*)(U + m * NIN + C_LG + ch0 + c8); }
#pragma unroll
              for (int k = 0; k < 4; ++k) { const size_t m = (size_t)b * SEQ + ck * TC + 8 * (i + k) + rg; f32x4 h0, h1, q0, q1, g0, g1; pg8::unpack8(hv[k], h0, h1); pg8::unpack8(qv[k], q0, q1); pg8::unpack8(gv[k], g0, g1);
                  if (y8) { const f32x4 y0 = (h0 + q0 * c0) * g0 * Y8_SCALE, y1 = (h1 + q1 * c1) * g1 * Y8_SCALE; u32x2 w8; w8.x = pk4_fp8(y0[0], y0[1], y0[2], y0[3]); w8.y = pk4_fp8(y1[0], y1[1], y1[2], y1[3]);
                      *(u32x2*)((unsigned char*)YB + m * DM + ch0 + c8) = w8; }
                  else *(u32x4*)(YB + m * DM + ch0 + c8) = pg8::pack8((h0 + q0 * c0) * g0, (h1 + q1 * c1) * g1); } } }
        }
    }
}
#undef LRU_LOAD_RAW
template <bool F8> __device__ __forceinline__ void lru_apply(const bf16* U, const bf16* HR, const bf16* PQ, const float* AGG, bf16* YB, int G, int c, int wbase) {
    const int tid = opaque_tid(wbase); G = opaque_s(G); c = opaque_s(c); const int ch = 8 * (tid & 127), tq = tid >> 7;
    for (int cu = c; cu < BATCH * NCK; cu += G) { const int b = cu / NCK, ck = cu % NCK;
        f32x4 c0 = {}, c1 = {};
        int j = 0;
        for (; j + 8 <= ck; j += 8) { f32x4 p[8][4];
#pragma unroll
            for (int k = 0; k < 8; ++k) { const f32x4* ap = (const f32x4*)(AGG + ((size_t)(b * NCK + j + k) * DM + ch) * 2); p[k][0] = ap[0]; p[k][1] = ap[1]; p[k][2] = ap[2]; p[k][3] = ap[3]; }
#pragma unroll
            for (int k = 0; k < 8; ++k) { c0 = (f32x4){p[k][0].x * c0.x + p[k][0].y, p[k][0].z * c0.y + p[k][0].w, p[k][1].x * c0.z + p[k][1].y, p[k][1].z * c0.w + p[k][1].w};
                                          c1 = (f32x4){p[k][2].x * c1.x + p[k][2].y, p[k][2].z * c1.y + p[k][2].w, p[k][3].x * c1.z + p[k][3].y, p[k][3].z * c1.w + p[k][3].w}; } }
        for (; j < ck; ++j) { const f32x4* ap = (const f32x4*)(AGG + ((size_t)(b * NCK + j) * DM + ch) * 2); const f32x4 p0 = ap[0], p1 = ap[1], p2 = ap[2], p3 = ap[3];
            c0 = (f32x4){p0.x * c0.x + p0.y, p0.z * c0.y + p0.w, p1.x * c0.z + p1.y, p1.z * c0.w + p1.w}; c1 = (f32x4){p2.x * c1.x + p2.y, p2.z * c1.y + p2.w, p3.x * c1.z + p3.y, p3.z * c1.w + p3.w}; }
        for (int i = 0; i < 32; i += 4) { u32x4 hv[4], qv[4], gv[4];
#pragma unroll
            for (int k = 0; k < 4; ++k) { const size_t m = (size_t)b * SEQ + ck * TC + tq + 4 * (i + k); hv[k] = *(const u32x4*)(HR + m * DM + ch); qv[k] = *(const u32x4*)(PQ + m * DM + ch); gv[k] = *(const u32x4*)(U + m * NIN + C_LG + ch); }
#pragma unroll
            for (int k = 0; k < 4; ++k) { const size_t m = (size_t)b * SEQ + ck * TC + tq + 4 * (i + k); f32x4 h0, h1, q0, q1, g0, g1; pg8::unpack8(hv[k], h0, h1); pg8::unpack8(qv[k], q0, q1); pg8::unpack8(gv[k], g0, g1);
                if (F8) { const f32x4 y0 = (h0 + q0 * c0) * g0 * Y8_SCALE, y1 = (h1 + q1 * c1) * g1 * Y8_SCALE; u32x2 w8; w8.x = pk4_fp8(y0[0], y0[1], y0[2], y0[3]); w8.y = pk4_fp8(y1[0], y1[1], y1[2], y1[3]);
                    *(u32x2*)((unsigned char*)YB + m * DM + ch) = w8; }
                else *(u32x4*)(YB + m * DM + ch) = pg8::pack8((h0 + q0 * c0) * g0, (h1 + q1 * c1) * g1); } }
    }
}
}

namespace moe {
constexpr int NCHUNK = M / 128;
__device__ __forceinline__ void route_a(LAS unsigned char* lds, const bf16* h, const float* ssq, const float* gain, const float* rw, const float* rb, int* sel, float* selw, int* CNT, int G, int c, int wbase) {
    const int tid = opaque_tid(wbase), lane = tid & 63, wid = __builtin_amdgcn_readfirstlane(tid >> 6); LAS int* lc = (LAS int*)lds; G = opaque_s(G); c = opaque_s(c);
    f32x4 wg[4][4][2];
#pragma unroll
    for (int j = 0; j < 4; ++j) { const f32x4 gk = *(const f32x4*)(gain + 4 * lane + 256 * j);
#pragma unroll
        for (int q = 0; q < 4; ++q) { const float* wp = rw + (size_t)(4 * lane + 256 * j + q) * 8; wg[j][q][0] = *(const f32x4*)wp * gk[q]; wg[j][q][1] = *(const f32x4*)(wp + 4) * gk[q]; } }
    float rbv[8];
#pragma unroll
    for (int e = 0; e < 8; ++e) rbv[e] = rb[e];
    for (int chunk = c; chunk < NCHUNK; chunk += G) {
        if (tid < 8) lc[tid] = 0;
        __syncthreads();
        for (int i0 = 0; i0 < 16; i0 += 2) {
            u32x2 hx[2][4]; f32x4 sq[2];
#pragma unroll
            for (int u = 0; u < 2; ++u) { const int m = chunk * 128 + wid * 16 + i0 + u; const u32x2* hp = (const u32x2*)(h + (size_t)m * DM) + lane;
#pragma unroll
                for (int j = 0; j < 4; ++j) hx[u][j] = hp[64 * j];
                sq[u] = *(const f32x4*)(ssq + 16 * (size_t)m + 4 * (lane & 3)); }
#pragma unroll
            for (int u = 0; u < 2; ++u) { const int m = chunk * 128 + wid * 16 + i0 + u; f32x4 a0 = {}, a1 = {};
#pragma unroll
                for (int j = 0; j < 4; ++j) { const f32x4 x = unpack_lo(hx[u][j]);
#pragma unroll
                    for (int q = 0; q < 4; ++q) { a0 = a0 + wg[j][q][0] * x[q]; a1 = a1 + wg[j][q][1] * x[q]; } }
                float s = (sq[u].x + sq[u].y) + (sq[u].z + sq[u].w); s += swz_f<1>(s); s += swz_f<2>(s);
                const float rs = __builtin_amdgcn_rsqf(s * (1.f / 1024.f) + EPS); float acc[8] = {a0.x, a0.y, a0.z, a0.w, a1.x, a1.y, a1.z, a1.w};
#pragma unroll
                for (int e = 0; e < 8; ++e) acc[e] = wave_sum(acc[e]) * rs + rbv[e];
                int i1 = 0; float v1 = acc[0];
#pragma unroll
                for (int e = 1; e < 8; ++e) if (acc[e] > v1) { v1 = acc[e]; i1 = e; }
                int i2 = -1; float v2 = -3.0e38f;
#pragma unroll
                for (int e = 0; e < 8; ++e) if (e != i1 && acc[e] > v2) { v2 = acc[e]; i2 = e; }
                const float ex = fast_exp(v2 - v1), w1 = 1.f / (1.f + ex), w2 = ex / (1.f + ex);
                if (lane == 0) { sel[2 * m] = i1; sel[2 * m + 1] = i2; selw[2 * m] = w1; selw[2 * m + 1] = w2; atomicAdd((int*)(lc + i1), 1); atomicAdd((int*)(lc + i2), 1); }
            }
        }
        __syncthreads();
        if (tid < 8) CNT[chunk * 8 + tid] = lc[tid];
        __syncthreads();
    }
}
__device__ __forceinline__ void route_b(LAS unsigned char* lds, const int* sel, const float* selw, const float* ssq, const int* CNT, const bf16* hb, int* tok, float* srs, float* sgw, int* tslot, int* meta, bf16* XG, int G, int c, int wbase) {
    const int tid = opaque_tid(wbase), lane = tid & 63, wid = __builtin_amdgcn_readfirstlane(tid >> 6); G = opaque_s(G); c = opaque_s(c);
    LAS int* tot = (LAS int*)lds; LAS int* pre = tot + 8; LAS int* start = tot + 16; LAS int* pos = tot + 32; LAS float* rsl = (LAS float*)(tot + 32 + 256);
    for (int chunk = c; chunk < NCHUNK; chunk += G) {
        { int t = 0, p = 0;
#pragma unroll
          for (int j = 0; j < NCHUNK / 64; ++j) { const int ch = lane + 64 * j; const int v = CNT[ch * 8 + wid]; t += v; p += (ch < chunk) ? v : 0; }
          t += swz_i<1>(t); t += swz_i<2>(t); t += swz_i<4>(t); t += swz_i<8>(t); t += swz_i<16>(t); t = sum_x32i(t);
          p += swz_i<1>(p); p += swz_i<2>(p); p += swz_i<4>(p); p += swz_i<8>(p); p += swz_i<16>(p); p = sum_x32i(p);
          if (lane == 0) { tot[wid] = t; pre[wid] = p; } }
        __syncthreads();
        if (tid == 0) { int s = 0; for (int e = 0; e < 8; ++e) { start[e] = s; s += ((tot[e] + 255) >> 8) << 8; } start[8] = s; }
        __syncthreads();
        if (chunk == 0 && tid < 9) meta[tid] = start[tid] >> 8;
        if (wid == 0) {
            int run[8];
#pragma unroll
            for (int e = 0; e < 8; ++e) run[e] = start[e] + pre[e];
#pragma unroll
            for (int hf = 0; hf < 2; ++hf)
#pragma unroll
                for (int k = 0; k < 2; ++k) { const int m = chunk * 128 + hf * 64 + lane; const int e = sel[2 * m + k]; int p = 0;
#pragma unroll
                    for (int ee = 0; ee < 8; ++ee) { const unsigned long long mask = __ballot(e == ee); if (e == ee) p = run[ee] + __popcll(mask & ((1ull << lane) - 1ull)); run[ee] += __popcll(mask); }
                    const float rsm = rstd_of(ssq, m); tok[p] = m; srs[p] = rsm; sgw[p] = selw[2 * m + k]; tslot[2 * m + k] = p; pos[(hf * 2 + k) * 64 + lane] = p; rsl[(hf * 2 + k) * 64 + lane] = rsm; }
        }
        __syncthreads();
        for (int q0 = wid * 32; q0 < wid * 32 + 32; q0 += 4) {
            u32x4 r0[4], r1[4]; int pp[4]; float rr[4];
#pragma unroll
            for (int u = 0; u < 4; ++u) { const int q = q0 + u, m = chunk * 128 + (q >> 7) * 64 + (q & 63); pp[u] = pos[q]; rr[u] = rsl[q];
                if (MOE_FP8) { const u32x4* src = (const u32x4*)(hb + (size_t)m * DM) + 2 * lane; r0[u] = src[0]; r1[u] = src[1]; }
                else { const u32x4* src = (const u32x4*)(hb + (size_t)m * DM); r0[u] = src[lane]; r1[u] = src[lane + 64]; } }
#pragma unroll
            for (int u = 0; u < 4; ++u) {
                if (MOE_FP8) { const float rs = rr[u]; f32x4 a0, a1, b0, b1; pg8::unpack8(r0[u], a0, a1); pg8::unpack8(r1[u], b0, b1);
                    u32x4 o; o.x = pk4_fp8(a0.x * rs, a0.y * rs, a0.z * rs, a0.w * rs); o.y = pk4_fp8(a1.x * rs, a1.y * rs, a1.z * rs, a1.w * rs); o.z = pk4_fp8(b0.x * rs, b0.y * rs, b0.z * rs, b0.w * rs); o.w = pk4_fp8(b1.x * rs, b1.y * rs, b1.z * rs, b1.w * rs);
                    *((u32x4*)((unsigned char*)XG + (size_t)pp[u] * DM) + lane) = o; }
                else { u32x4* dst = (u32x4*)(XG + (size_t)pp[u] * DM); dst[lane] = r0[u]; dst[lane + 64] = r1[u]; } } }
        if (chunk == 0) {
            for (int e = 0; e < 8; ++e) { const int s0 = start[e] + tot[e], s1 = start[e + 1];
                for (int s = s0 + tid; s < s1; s += 512) { tok[s] = 0; srs[s] = 0.f; sgw[s] = 0.f; }
                unsigned z0; asm volatile("v_mov_b32 %0, 0" : "=v"(z0)); const u32x4 zz = (u32x4){z0, z0, z0, z0};
                for (int s = s0 + wid; s < s1; s += 8) { if (MOE_FP8) *((u32x4*)((unsigned char*)XG + (size_t)s * DM) + lane) = zz;
                    else { u32x4* dst = (u32x4*)(XG + (size_t)s * DM); dst[lane] = zz; dst[lane + 64] = zz; } } }
        }
        __syncthreads();
    }
}
}

#define XB_TMO      128
#define XB_XCNT(j)  (256  + 64 * (j))
#define XB_XSUB(j)  (1280 + 64 * (j))
#define XB_XGEN(j)  (2304 + 64 * (j))
#define XB_TOP      3328
#define XB_TOPGEN   3392
#define XCD_BAR_WORDS 3456
#define XB_SPIN_CAP (1u << 18)
__device__ __forceinline__ unsigned xb_ld(unsigned* p)              { return __hip_atomic_load(p, __ATOMIC_RELAXED, __HIP_MEMORY_SCOPE_AGENT); }
__device__ __forceinline__ unsigned xb_add(unsigned* p, unsigned v) { return __hip_atomic_fetch_add(p, v, __ATOMIC_RELAXED, __HIP_MEMORY_SCOPE_AGENT); }
__device__ __forceinline__ unsigned xb_xcc_id() { return (unsigned)__builtin_amdgcn_s_getreg((3 << 11) | 20) & 0xFu; }
#define XB_SPIN(cond, bar) do { unsigned _sp = 0; while (cond) { __builtin_amdgcn_s_sleep(1); \
    if ((++_sp & 255u) == 0u) { if (xb_ld(&(bar)[XB_TMO])) break; if (_sp > XB_SPIN_CAP) { atomicAdd(&(bar)[XB_TMO], 1u); break; } } } } while (0)
struct XcdBarrier { unsigned* bar; unsigned x; volatile LAS unsigned* st; };
__device__ __forceinline__ XcdBarrier xcd_barrier_post(unsigned* bar, volatile LAS unsigned* st) {
    XcdBarrier b; b.bar = bar; b.x = xb_xcc_id(); b.st = st;
    if (threadIdx.x == 0) (void)xb_add(&bar[XB_XCNT(b.x)], 1u);
    return b;
}
__device__ __forceinline__ void xcd_barrier_complete(unsigned* bar, unsigned x, unsigned& nloc, unsigned& nx) {
    const unsigned G = gridDim.x * gridDim.y * gridDim.z;
    unsigned sum, cnt, mine, sp = 0u;
    for (;;) {
        sum = 0u; cnt = 0u; mine = 0u;
#pragma unroll
        for (unsigned j = 0; j < 16; ++j) { const unsigned c = xb_ld(&bar[XB_XCNT(j)]); sum += c; cnt += (c > 0u) ? 1u : 0u; mine = (j == x) ? c : mine; }
        if (sum == G) break;
        __builtin_amdgcn_s_sleep(1);
        if ((++sp & 255u) == 0u) { if (xb_ld(&bar[XB_TMO])) break; if (sp > XB_SPIN_CAP) { atomicAdd(&bar[XB_TMO], 1u); break; } }
    }
    nloc = mine > 0u ? mine : 1u; nx = cnt > 0u ? cnt : 1u;
}
__device__ __forceinline__ void xcd_barrier(const XcdBarrier& b, bool leader) {
    asm volatile("s_waitcnt vmcnt(0)" ::: "memory");
    __syncthreads();
    if (leader) {
        unsigned zo_; asm volatile("v_mov_b32 %0, 0" : "=v"(zo_)); unsigned* bar = b.bar + zo_;
        __builtin_amdgcn_s_waitcnt(0);
        unsigned nloc = b.st[0], nx = b.st[1];
        if (nloc == 0u) { xcd_barrier_complete(bar, b.x, nloc, nx); b.st[0] = nloc; b.st[1] = nx; }
        const unsigned old = xb_add(&bar[XB_XSUB(b.x)], 1u);
        const unsigned gen = old / nloc;
        if (old + 1u == (gen + 1u) * nloc) {
            __builtin_amdgcn_fence(__ATOMIC_RELEASE, "agent");
            asm volatile("s_waitcnt vmcnt(0)" ::: "memory");
            const unsigned og = xb_add(&bar[XB_TOP], 1u);
            const unsigned tg = og / nx;
            if (og + 1u == (tg + 1u) * nx) xb_add(&bar[XB_TOPGEN], 1u);
            else XB_SPIN(xb_ld(&bar[XB_TOPGEN]) == tg, bar);
            __builtin_amdgcn_fence(__ATOMIC_ACQUIRE, "agent");
            xb_add(&bar[XB_XGEN(b.x)], 1u);
            asm volatile("s_waitcnt vmcnt(0)" ::: "memory");
        } else {
            XB_SPIN(xb_ld(&bar[XB_XGEN(b.x)]) == gen, bar);
            __builtin_amdgcn_fence(__ATOMIC_ACQUIRE, "agent");
            asm volatile("s_waitcnt vmcnt(0)" ::: "memory");
        }
    }
    __syncthreads();
}

constexpr int MEGA_LDS = 147456, LDSCTL_OFF = 131072;
constexpr int CW_BAR = 4096;
constexpr size_t CTL_ZERO_BYTES = 524288;

__device__ __forceinline__ KP kargs() { KP pp = (KP)__builtin_amdgcn_kernarg_segment_ptr(); asm volatile("" : "+s"(pp)); return pp; }
#define KIN(i) (kargs()->in[i])
#define KWS (kargs()->ws)
#define KOUT (kargs()->out)
#ifndef DUP_ID
#define DUP_ID 0
#define DUP_N 1
#endif
#define REP(id) for (int rep_ = 0; rep_ < ((DUP_ID == (id)) ? DUP_N : 1); ++rep_)
__global__ void __launch_bounds__(512, 2) mega(Ptrs Pdummy) {
    extern __shared__ __attribute__((aligned(16))) unsigned char lds_raw[];
    LAS unsigned char* lds = (LAS unsigned char*)lds_raw;
    const int G = (int)gridDim.x, c = (int)blockIdx.x, wbase = __builtin_amdgcn_readfirstlane((int)threadIdx.x) & ~63;
    { volatile LAS unsigned* MISC0 = (volatile LAS unsigned*)(lds + LDSCTL_OFF); if (threadIdx.x < 64) MISC0[threadIdx.x] = 0u; }
    __syncthreads();
    (void)xcd_barrier_post((unsigned*)(KWS + WS_CTL) + CW_BAR, (volatile LAS unsigned*)(lds + LDSCTL_OFF) + 8);
#define GRID_BAR() do { XcdBarrier b_; b_.bar = (unsigned*)(KWS + WS_CTL) + CW_BAR; b_.x = xb_xcc_id(); b_.st = (volatile LAS unsigned*)(lds + LDSCTL_OFF) + 8; xcd_barrier(b_, opaque_tid(wbase) == 0); } while (0)
#define HBUF(k) ((bf16*)(ws + ((k) ? WS_HB2 : WS_HB)))
#define SBUF(k) ((float*)(ws + WS_SSQ) + ((k) ? (size_t)16 * M : (size_t)0))
#define WAVE_IDS() const int tid = opaque_tid(wbase), lane = tid & 63, wid = __builtin_amdgcn_readfirstlane(tid >> 6), gw = c * 8 + wid, ngw = G * 8; (void)tid; (void)lane; (void)gw; (void)ngw

    REP(1) { WAVE_IDS(); const KP P = kargs(); unsigned char* ws = P->ws; LAS float* scr = (LAS float*)(lds + wid * 16384);
      { constexpr int NJ = 30 + 128 + (INPROJ_GATES_FP8 ? DEPTH : 0); LAS int* pref = (LAS int*)(lds + 9216);
        if (tid < NJ) { const CJob jb = static_job(P, tid); pref[512 + tid] = (jb.K / 64) * (jb.N / 32); }
        __syncthreads();
        if (tid == 0) { int s = 0; for (int j = 0; j < NJ; ++j) { pref[j] = s; s += pref[512 + j]; } pref[NJ] = s; }
        __syncthreads();
        conv_static_all(P, pref, NJ, scr, gw, ngw, lane); }
      if ((INPROJ_FP8 || INPROJ_GATES_FP8)) { for (int m = gw; m < M; m += ngw) rowstats_row<false>(P->in[0] + (size_t)m * DM, HBUF(0) + (size_t)m * DM, SBUF(0) + 16 * (size_t)m, nullptr, nullptr, lane, ws + WS_HB8 + (size_t)m * DM); }
      else for (int m = gw; m < M; m += 2 * ngw) { const int m2 = m + ngw;
          if (m2 >= M) { rowstats_row<false>(P->in[0] + (size_t)m * DM, HBUF(0) + (size_t)m * DM, SBUF(0) + 16 * (size_t)m, nullptr, nullptr, lane); break; }
          rowstats_x2(P->in[0] + (size_t)m * DM, HBUF(0) + (size_t)m * DM, SBUF(0) + 16 * (size_t)m, P->in[0] + (size_t)m2 * DM, HBUF(0) + (size_t)m2 * DM, SBUF(0) + 16 * (size_t)m2, lane); }
      bf16* PB = (bf16*)(ws + WS_PB);
      cvt_p_bf16((const f32x4*)P->in[1], (u32x2*)PB, c * 512 + tid, G * 512); }
    GRID_BAR();

    if (DUP_ID == 20) for (int rep_ = 0; rep_ < DUP_N; ++rep_) GRID_BAR();
    int hc = 0, sc = 0;
    for (int l = 0; l < DEPTH; ++l) {
        if ((INPROJ_FP8_MASK >> l) & 1) {
          REP(2) { unsigned char* ws = KWS; pg8::Gemm g{(const bf16*)(ws + WS_HB8), (const bf16*)(ws + WS_WIN + (size_t)l * NIN * DM * 2), DM / 2, 0}; pg8::StaticOrder S; S.init(M, NIN, opaque_s(G), opaque_s(c));
            pg8::EpiInproj<false> E{(bf16*)(ws + WS_R + R_U), SBUF(sc), KIN(4) + l * 64, KIN(5) + l * 64, 0, 1.f / WIN_SCALE}; pg8::gemm_phase<pg8::EpiInproj<false>, pg8::StaticOrder, true, true, true>(lds, g, S, E, wbase); }
        } else
        REP(2) { unsigned char* ws = KWS; pg8::Gemm g{HBUF(hc), (const bf16*)(ws + WS_WIN + (size_t)l * NIN * DM * 2), DM, 0}; pg8::StaticOrder S; S.init(M, INPROJ_GATES_FP8 ? NIN_A : NIN, opaque_s(G), opaque_s(c));
          pg8::EpiInproj<false> E{(bf16*)(ws + WS_R + R_U), SBUF(sc), KIN(4) + l * 64, KIN(5) + l * 64, 0, 1.f}; pg8::gemm_phase<pg8::EpiInproj<false>, pg8::StaticOrder, true, true>(lds, g, S, E, wbase); }
        if (INPROJ_GATES_FP8) REP(2) { unsigned char* ws = KWS; pg8::Gemm g{(const bf16*)(ws + WS_HB8), (const bf16*)(ws + WS_WIN + (size_t)l * NIN * DM * 2 + (size_t)NIN_A * DM * 2), DM / 2, 0}; pg8::StaticOrder S; S.init(M, NIN_B, opaque_s(G), opaque_s(c));
          pg8::EpiInproj<true> E{(bf16*)(ws + WS_R + R_U), SBUF(sc), nullptr, nullptr, NIN_A / 256, 1.f / WIN_SCALE}; pg8::gemm_phase<pg8::EpiInproj<true>, pg8::StaticOrder, true, true, true>(lds, g, S, E, wbase); }
        REP(3) { unsigned char* ws = KWS; pg8::Gemm g{(const bf16*)(ws + WS_PB), (const bf16*)(ws + WS_WPP) + (size_t)l * DM * PLE, PLE, 0}; pg8::StaticOrder S; S.init(M, DM, opaque_s(G), opaque_s(c));
          pg8::EpiStore16 E{(bf16*)(ws + WS_PP), DM, 1.f}; pg8::gemm_phase<pg8::EpiStore16, pg8::StaticOrder, true, true>(lds, g, S, E, wbase); }
        GRID_BAR();
        const bool cf_ = (l & 1) && ((opaque_s(c) >> 3) & 1);
        if (cf_) { __syncthreads(); WAVE_IDS(); const KP P = kargs(); LAS float* scr = (LAS float*)(lds + wid * 16384); conv_moe_layer(P, l >> 1, scr, gw, ngw, lane); __syncthreads(); }
        REP(4) { unsigned char* ws = KWS; attn::attn_phase(lds, (const bf16*)(ws + WS_R + R_U), (bf16*)(ws + WS_R + R_YA), KIN(6) + l * 16, KIN(7), G, c, wbase, (MERGE_FP8_MASK >> opaque_s(l)) & 1); }
        REP(5) { unsigned char* ws = KWS; const bf16* Wt = (const bf16*)(ws + WS_LRUW) + (size_t)l * 2 * 16 * 64 * 64; __syncthreads();
          lru::lru_scan(lds, (const bf16*)(ws + WS_R + R_U), (bf16*)(ws + WS_R + R_HR), (bf16*)(ws + WS_R + R_PQ), (float*)(ws + WS_AGG), Wt, KIN(8) + l * 4 * DM, KIN(9) + l * DM, KIN(11) + l * DM, KIN(13) + l * DM, KIN(14) + l * DM, G, c, wbase,
                        (bf16*)(ws + WS_R + R_YB), (unsigned*)(ws + WS_CTL + CTL_LRUFLAG), (unsigned)(l + 1), (unsigned*)(ws + WS_CTL) + CW_BAR + XB_TMO, (MERGE_FP8_MASK >> opaque_s(l)) & 1); }
        if (l + 1 < DEPTH) REP(6) { unsigned char* ws = KWS; const f32x4* src = (const f32x4*)(KIN(1) + (size_t)(l + 1) * M * PLE); bf16* PB = (bf16*)(ws + WS_PB);
            cvt_p_bf16(src, (u32x2*)PB, opaque_s(c) * 512 + opaque_tid(wbase), G * 512); }
        if ((l & 1) && !cf_) REP(7) { __syncthreads(); WAVE_IDS(); const KP P = kargs(); LAS float* scr = (LAS float*)(lds + wid * 16384);
            conv_moe_layer(P, l >> 1, scr, gw, ngw, lane); }
        GRID_BAR();
        if (!LRU_FUSED) {
        if ((MERGE_FP8_MASK >> opaque_s(l)) & 1) { unsigned char* ws = KWS; lru::lru_apply<true>((const bf16*)(ws + WS_R + R_U), (const bf16*)(ws + WS_R + R_HR), (const bf16*)(ws + WS_R + R_PQ), (const float*)(ws + WS_AGG), (bf16*)(ws + WS_R + R_YB), G, c, wbase); }
        else REP(8) { unsigned char* ws = KWS; lru::lru_apply<false>((const bf16*)(ws + WS_R + R_U), (const bf16*)(ws + WS_R + R_HR), (const bf16*)(ws + WS_R + R_PQ), (const float*)(ws + WS_AGG), (bf16*)(ws + WS_R + R_YB), G, c, wbase); }
        GRID_BAR();
        }
        {
        if ((MERGE_FP8_MASK >> opaque_s(l)) & 1) {
          REP(9) { unsigned char* ws = KWS; pg8::Gemm g{(const bf16*)(ws + WS_R + R_YA), (const bf16*)(ws + WS_WPA) + (size_t)l * DM * DM, DM / 2, 0};
            pg8::MergeOrder S; S.A1 = (const bf16*)(ws + WS_R + R_YB); S.Bt1 = (const bf16*)(ws + WS_WPB) + (size_t)l * DM * DM; S.so.init(M, DM, opaque_s(G), opaque_s(c));
            pg8::EpiMerge<true> E{(bf16*)(ws + WS_R + R_MB), (const bf16*)(ws + WS_R + R_U), MB8_SCALE / (WIN_SCALE * Y8_SCALE), 0}; pg8::gemm_phase<pg8::EpiMerge<true>, pg8::MergeOrder, true, true, true>(lds, g, S, E, wbase); }
        } else if ((OUT_FP8_MASK & ~MERGE_FP8_MASK) != 0 && ((OUT_FP8_MASK >> opaque_s(l)) & 1)) { unsigned char* ws = KWS; pg8::Gemm g{(const bf16*)(ws + WS_R + R_YA), (const bf16*)(ws + WS_WPA) + (size_t)l * DM * DM, DM, 0};
          pg8::MergeOrder S; S.A1 = (const bf16*)(ws + WS_R + R_YB); S.Bt1 = (const bf16*)(ws + WS_WPB) + (size_t)l * DM * DM; S.so.init(M, DM, opaque_s(G), opaque_s(c));
          pg8::EpiMerge<true> E{(bf16*)(ws + WS_R + R_MB), (const bf16*)(ws + WS_R + R_U), MB8_SCALE, 0}; pg8::gemm_phase<pg8::EpiMerge<true>, pg8::MergeOrder, true, true>(lds, g, S, E, wbase); }
        else
        REP(9) { unsigned char* ws = KWS; pg8::Gemm g{(const bf16*)(ws + WS_R + R_YA), (const bf16*)(ws + WS_WPA) + (size_t)l * DM * DM, DM, 0};
          pg8::MergeOrder S; S.A1 = (const bf16*)(ws + WS_R + R_YB); S.Bt1 = (const bf16*)(ws + WS_WPB) + (size_t)l * DM * DM; S.so.init(M, DM, opaque_s(G), opaque_s(c));
          pg8::EpiMerge<false> E{(bf16*)(ws + WS_R + R_MB), (const bf16*)(ws + WS_R + R_U), 1.f, 0}; pg8::gemm_phase<pg8::EpiMerge<false>, pg8::MergeOrder, true, true>(lds, g, S, E, wbase); }
        GRID_BAR();
        if ((OUT_FP8_MASK >> opaque_s(l)) & 1) { unsigned char* ws = KWS; pg8::Gemm g{(const bf16*)(ws + WS_R + R_MB), (const bf16*)(ws + WS_WOUT) + (size_t)l * DM * DM, DM / 2, 0}; pg8::StaticOrder S; S.init(M, DM, opaque_s(G), opaque_s(c));
          pg8::EpiResid<0, 2> E{HBUF(hc), HBUF(hc), nullptr, SBUF(sc ^ 1), nullptr, nullptr, (l & 1) ? nullptr : ws + WS_HB8, 1.f / (WIN_SCALE * MB8_SCALE), 0}; pg8::gemm_phase<pg8::EpiResid<0, 2>, pg8::StaticOrder, true, true, true>(lds, g, S, E, wbase); }
        else
        for (int rep_ = 0; rep_ < ((DUP_ID == 10 && l == 0) ? DUP_N : 1); ++rep_) { unsigned char* ws = KWS; pg8::Gemm g{(const bf16*)(ws + WS_R + R_MB), (const bf16*)(ws + WS_WOUT) + (size_t)l * DM * DM, DM, 0}; pg8::StaticOrder S; S.init(M, DM, opaque_s(G), opaque_s(c));
          pg8::EpiResid<0> E{HBUF(hc), HBUF(hc), nullptr, SBUF(sc ^ 1), nullptr, nullptr, (!(l & 1) && ((DENSE_FP8_MASK >> (l >> 1)) & 1)) ? ws + WS_HB8 : nullptr, 1.f, 0}; pg8::gemm_phase<pg8::EpiResid<0>, pg8::StaticOrder, true, true>(lds, g, S, E, wbase); }
        }
        sc ^= 1;
        GRID_BAR();
        if (!(l & 1)) {
            if ((DENSE_FP8_MASK >> (l >> 1)) & 1) {
                REP(11) { unsigned char* ws = KWS; pg8::Gemm g{(const bf16*)(ws + WS_HB8), (const bf16*)(ws + WS_W13D) + (size_t)(l >> 1) * 2 * DFF * DM, DM / 2, 0}; pg8::StaticOrder S; S.init(M, 2 * DFF, opaque_s(G), opaque_s(c));
                  pg8::EpiSwiglu<false> E{(bf16*)(ws + WS_R + R_G), SBUF(sc), nullptr, nullptr, 1, 1.f / W13_SCALE}; pg8::gemm_phase<pg8::EpiSwiglu<false>, pg8::StaticOrder, true, true, true>(lds, g, S, E, wbase); }
                GRID_BAR();
                { unsigned char* ws = KWS; pg8::Gemm g{(const bf16*)(ws + WS_R + R_G), (const bf16*)(ws + WS_W2D) + (size_t)(l >> 1) * DM * DFF, DFF / 2, 0}; pg8::StaticOrder S; S.init(M, DM, opaque_s(G), opaque_s(c));
                  pg8::EpiResid<0> E{HBUF(hc), HBUF(hc), nullptr, SBUF(sc ^ 1), nullptr, nullptr, nullptr, 1.f / (W2_SCALE * G8_SCALE), 0}; pg8::gemm_phase<pg8::EpiResid<0>, pg8::StaticOrder, true, true, true>(lds, g, S, E, wbase); sc ^= 1; }
                GRID_BAR();
            } else {
                REP(11) { unsigned char* ws = KWS; pg8::Gemm g{HBUF(hc), (const bf16*)(ws + WS_W13D) + (size_t)(l >> 1) * 2 * DFF * DM, DM, 0}; pg8::StaticOrder S; S.init(M, 2 * DFF, opaque_s(G), opaque_s(c));
                  pg8::EpiSwiglu<false> E{(bf16*)(ws + WS_R + R_G), SBUF(sc), nullptr, nullptr, 0, 1.f}; pg8::gemm_phase<pg8::EpiSwiglu<false>, pg8::StaticOrder, true, true>(lds, g, S, E, wbase); }
                GRID_BAR();
                { unsigned char* ws = KWS; pg8::Gemm g{(const bf16*)(ws + WS_R + R_G), (const bf16*)(ws + WS_W2D) + (size_t)(l >> 1) * DM * DFF, DFF, 0}; pg8::StaticOrder S; S.init(M, DM, opaque_s(G), opaque_s(c));
                  pg8::EpiResid<0> E{HBUF(hc), HBUF(hc), nullptr, SBUF(sc ^ 1), nullptr, nullptr, nullptr, 1.f, 0}; pg8::gemm_phase<pg8::EpiResid<0>, pg8::StaticOrder, true, true>(lds, g, S, E, wbase); sc ^= 1; }
                GRID_BAR();
            }
        } else {
            REP(12) { unsigned char* ws = KWS; moe::route_a(lds, HBUF(hc), SBUF(sc), KIN(18) + l * DM, KIN(22) + (size_t)(l >> 1) * DM * NEXP, KIN(23) + (l >> 1) * NEXP, (int*)(ws + WS_SEL), (float*)(ws + WS_SEL + 256 * 1024), (int*)(ws + WS_SLOT + 964 * 1024), G, c, wbase); }
            GRID_BAR();
            REP(13) { unsigned char* ws = KWS; moe::route_b(lds, (const int*)(ws + WS_SEL), (const float*)(ws + WS_SEL + 256 * 1024), SBUF(sc), (const int*)(ws + WS_SLOT + 964 * 1024), HBUF(hc), (int*)(ws + WS_SLOT), (float*)(ws + WS_SLOT + 320 * 1024),
                                             (float*)(ws + WS_SLOT + 640 * 1024), (int*)(ws + WS_SEL + 512 * 1024), (int*)(ws + WS_SLOT + 960 * 1024), (bf16*)(ws + WS_R + R_XG), G, c, wbase); }
            GRID_BAR();
            REP(14) { unsigned char* ws = KWS; pg8::Gemm g{(const bf16*)(ws + WS_R + R_XG8), (const bf16*)(ws + WS_W13E), MOE_FP8 ? DM / 2 : DM, 0}; pg8::MoeOrder S; S.meta = (const int*)(ws + WS_SLOT + 960 * 1024); S.wstride = (size_t)2 * DFF * DM / (MOE_FP8 ? 2 : 1); S.N = 2 * DFF; S.pad0 = 0; S.setup(opaque_s(G), opaque_s(c));
              pg8::EpiSwiglu<true> E{(bf16*)(ws + WS_R + R_GM), nullptr, (const float*)(ws + WS_SLOT + 320 * 1024), (const float*)(ws + WS_SLOT + 640 * 1024), 0, 1.f}; pg8::gemm_phase<pg8::EpiSwiglu<true>, pg8::MoeOrder, true, true, MOE_FP8>(lds, g, S, E, wbase); }
            GRID_BAR();
            REP(15) { unsigned char* ws = KWS; pg8::Gemm g{(const bf16*)(ws + WS_R + R_GM), (const bf16*)(ws + WS_W2E), MOE_FP8 ? DFF / 2 : DFF, 0}; pg8::MoeOrder S; S.meta = (const int*)(ws + WS_SLOT + 960 * 1024); S.wstride = (size_t)DM * DFF / (MOE_FP8 ? 2 : 1); S.N = DM; S.pad0 = 0; S.setup(opaque_s(G), opaque_s(c));
              pg8::EpiStore16 E{(bf16*)(ws + WS_R + R_XG), DM, MOE_FP8 ? 1.f / (W2_SCALE * G8_SCALE) : 1.f}; pg8::gemm_phase<pg8::EpiStore16, pg8::MoeOrder, true, true, MOE_FP8>(lds, g, S, E, wbase); }
            GRID_BAR();
            { WAVE_IDS(); unsigned char* ws = KWS; const int* TSLOT = (const int*)(ws + WS_SEL + 512 * 1024); const bf16* XG = (const bf16*)(ws + WS_R + R_XG);
              for (int m = gw; m < M; m += 2 * ngw) { const int m2 = m + ngw;
                  if (m2 >= M) { rowstats_row<true>(nullptr, HBUF(hc) + (size_t)m * DM, SBUF(sc ^ 1) + 16 * (size_t)m, XG + (size_t)TSLOT[2 * m] * DM, XG + (size_t)TSLOT[2 * m + 1] * DM, lane); break; }
                  const int s1 = TSLOT[2 * m], s2 = TSLOT[2 * m + 1], s3 = TSLOT[2 * m2], s4 = TSLOT[2 * m2 + 1];
                  const bool p8 = (PLE_FP8_MASK >> l) & 1;
                  combine_rows2(HBUF(hc) + (size_t)m * DM, SBUF(sc ^ 1) + 16 * (size_t)m, XG + (size_t)s1 * DM, XG + (size_t)s2 * DM,
                                HBUF(hc) + (size_t)m2 * DM, SBUF(sc ^ 1) + 16 * (size_t)m2, XG + (size_t)s3 * DM, XG + (size_t)s4 * DM, lane,
                                p8 ? ws + WS_HB8 + (size_t)m * DM : nullptr, p8 ? ws + WS_HB8 + (size_t)m2 * DM : nullptr); } }
            sc ^= 1;
            GRID_BAR();
        }
        if ((PLE_FP8_MASK >> l) & 1) {
          unsigned char* ws = KWS; pg8::Gemm g{(const bf16*)(ws + WS_HB8), (const bf16*)(ws + WS_WPG) + (size_t)l * DM * DM, DM / 2, 0}; pg8::StaticOrder S; S.init(M, DM, opaque_s(G), opaque_s(c));
          pg8::EpiResid<1> E{HBUF(hc), HBUF(hc ^ 1), l + 1 < DEPTH ? nullptr : KOUT, SBUF(sc ^ 1), (const bf16*)(ws + WS_PP), SBUF(sc), nullptr, 1.f / WIN_SCALE, 0}; pg8::gemm_phase<pg8::EpiResid<1>, pg8::StaticOrder, true, true, true>(lds, g, S, E, wbase); sc ^= 1; hc ^= 1; }
        else
        { unsigned char* ws = KWS; pg8::Gemm g{HBUF(hc), (const bf16*)(ws + WS_WPG) + (size_t)l * DM * DM, DM, 0}; pg8::StaticOrder S; S.init(M, DM, opaque_s(G), opaque_s(c));
          pg8::EpiResid<1> E{HBUF(hc), HBUF(hc ^ 1), l + 1 < DEPTH ? nullptr : KOUT, SBUF(sc ^ 1), (const bf16*)(ws + WS_PP), SBUF(sc), ((INPROJ_FP8 || INPROJ_GATES_FP8 || ((INPROJ_FP8_MASK >> (l + 1)) & 1)) && l + 1 < DEPTH) ? ws + WS_HB8 : nullptr, 1.f, 0}; pg8::gemm_phase<pg8::EpiResid<1>, pg8::StaticOrder, true, true>(lds, g, S, E, wbase); sc ^= 1; hc ^= 1; }
        if (l + 1 < DEPTH) GRID_BAR();
    }
    { WAVE_IDS(); if (xb_ld((unsigned*)(KWS + WS_CTL) + CW_BAR + XB_TMO) != 0u) { const float q = __builtin_nanf(""); float* out = KOUT;
        for (int m = gw; m < M; m += ngw) { f32x4* o = (f32x4*)(out + (size_t)m * DM) + lane;
#pragma unroll
            for (int j = 0; j < 4; ++j) o[64 * j] = (f32x4){q, q, q, q}; } } }
#undef GRID_BAR
}

extern "C" void kernel_launch(void* const* d_in, const int* in_sizes, int n_in, void* d_out, int out_size, void* d_ws, size_t ws_size, hipStream_t stream) {
    static int ok = 0, grid = 256;
    if (ok == 0) {
        if (n_in != 30 || in_sizes[0] != M * DM || out_size != M * DM || ws_size < WS_END) { fprintf(stderr, "kernel_launch: unexpected shapes (n_in %d, ws %zu < %zu)\n", n_in, ws_size, (size_t)WS_END); ok = -1; return; }
        if (hipFuncSetAttribute((const void*)mega, hipFuncAttributeMaxDynamicSharedMemorySize, MEGA_LDS) != hipSuccess) { fprintf(stderr, "kernel_launch: hipFuncSetAttribute failed\n"); ok = -1; return; }
        int dev = 0, cus = 0;
        if (hipGetDevice(&dev) == hipSuccess && hipDeviceGetAttribute(&cus, hipDeviceAttributeMultiprocessorCount, dev) == hipSuccess && cus > 0 && cus < 256) grid = cus;
        (void)hipGetLastError();
        ok = 1;
    }
    if (ok < 0) return;
    Ptrs P; memset(&P, 0, sizeof(P)); for (int i = 0; i < 30; ++i) P.in[i] = (const float*)d_in[i]; P.out = (float*)d_out; P.ws = (unsigned char*)d_ws;
    (void)hipMemsetAsync((unsigned char*)d_ws + WS_CTL, 0, CTL_ZERO_BYTES, stream);
    hipLaunchKernelGGL(mega, dim3(grid), dim3(512), MEGA_LDS, stream, P);
}
```

```cpp
#include <hip/hip_runtime.h>
#include <cstdio>
#include <cstdint>
#include <cstring>

#define LAS __attribute__((address_space(3)))
#define GAS __attribute__((address_space(1)))
typedef unsigned short bf16;
typedef short bf16x8 __attribute__((ext_vector_type(8)));
typedef float f32x4 __attribute__((ext_vector_type(4)));
typedef float f32x2 __attribute__((ext_vector_type(2)));
typedef unsigned u32x4 __attribute__((ext_vector_type(4)));
typedef unsigned u32x2 __attribute__((ext_vector_type(2)));

constexpr int BATCH = 8, SEQ = 4096, DM = 1024, DEPTH = 4, M = BATCH * SEQ;
constexpr int NIN = 5632, C_Q = 0, C_K = 1024, C_V = 1280, C_LX = 1536, C_LG = 2560, C_GA = 3584, C_GB = 4608;
constexpr int DFF = 3584, NEXP = 8, PLE = 256;
constexpr int NSLOT = 67584;
constexpr bool INPROJ_GATES_FP8 = false;
constexpr int NIN_A = C_LG, NIN_B = NIN - C_LG;
constexpr int INPROJ_FP8_MASK = 14;
constexpr int OUT_FP8_MASK = 12, MERGE_FP8_MASK = 12;
constexpr float Y8_SCALE = 8.f, MB8_SCALE = 16.f;
constexpr int PLE_FP8_MASK = 8;
constexpr bool INPROJ_FP8 = false;
constexpr float WIN_SCALE = 64.f;
constexpr int DENSE_FP8_MASK = 2;
constexpr bool MOE_FP8 = true;
static_assert(MOE_FP8 || !(INPROJ_FP8 || INPROJ_GATES_FP8), "WS_HB8 lives in the free half of the fp8 expert-weight region");
constexpr float W13_SCALE = 64.f, W2_SCALE = 128.f, G8_SCALE = 8.f;
constexpr float EPS = 1e-6f, LOG2E = 1.4426950408889634f, QSCALE = 0.125f * LOG2E;

constexpr size_t MiB = 1u << 20;
constexpr size_t WS_CTL = 0;
constexpr size_t WS_WIN = 1 * MiB;
constexpr size_t WS_WPA = 45 * MiB, WS_WPB = 53 * MiB, WS_WOUT = 61 * MiB, WS_WPG = 69 * MiB;
constexpr size_t WS_WPP = 77 * MiB;
constexpr size_t WS_W13D = 79 * MiB;
constexpr size_t WS_W2D = 107 * MiB;
constexpr size_t WS_LRUW = 121 * MiB;
constexpr size_t WS_W13E = 122 * MiB;
constexpr size_t WS_HB8 = 178 * MiB;
constexpr size_t WS_W2E = 234 * MiB;
constexpr size_t WS_PB = 290 * MiB;
constexpr size_t WS_HB = 306 * MiB;
constexpr size_t WS_SSQ = 370 * MiB;
constexpr size_t WS_SEL = 374 * MiB;
constexpr size_t WS_SLOT = 375 * MiB;
constexpr size_t WS_PP = 376 * MiB;
constexpr size_t WS_HB2 = 440 * MiB;
constexpr size_t WS_R = 504 * MiB;
constexpr size_t R_U = 0, R_YA = 352 * MiB, R_YB = 416 * MiB, R_MB = 480 * MiB, R_NA = 544 * MiB, R_NU = 576 * MiB;
constexpr size_t R_HR = R_MB, R_PQ = R_NA;
constexpr size_t WS_AGG = WS_SEL;
constexpr size_t R_G = 0;
constexpr size_t R_XG = 0, R_XG8 = 0, R_GM = 132 * MiB;
constexpr size_t WS_END = WS_R + 608 * MiB;

__host__ __device__ __forceinline__ float bf2f(bf16 x) { return __builtin_bit_cast(float, (unsigned)x << 16); }
__host__ __device__ __forceinline__ bf16 f2bf(float f) { unsigned u = __builtin_bit_cast(unsigned, f); return (bf16)((u + 0x7fffu + ((u >> 16) & 1u)) >> 16); }
__device__ __forceinline__ unsigned pk2(float lo, float hi) { return (unsigned)f2bf(lo) | ((unsigned)f2bf(hi) << 16); }
__device__ __forceinline__ float fast_exp(float x) { return __builtin_amdgcn_exp2f(x * LOG2E); }
__device__ __forceinline__ float sigmoidf_(float x) { return 1.f / (1.f + fast_exp(-x)); }
__device__ __forceinline__ float gelu_tanh(float x) { const float z = 0.7978845608028654f * (x + 0.044715f * x * x * x); return x / (1.f + fast_exp(-2.f * z)); }
__device__ __forceinline__ int lane_id() { unsigned ones = ~0u; asm volatile("" : "+s"(ones)); return (int)__builtin_amdgcn_mbcnt_hi(ones, __builtin_amdgcn_mbcnt_lo(ones, 0u)); }
__device__ __forceinline__ int opaque_tid(int wbase) { int t = wbase + lane_id(); asm volatile("" : "+v"(t)); return t; }
__device__ __forceinline__ int opaque_s(int x) { asm volatile("" : "+s"(x)); return x; }
__device__ __forceinline__ float opaque_f(float x) { asm volatile("" : "+v"(x)); return x; }
__device__ __forceinline__ unsigned opaque_u(unsigned x) { asm volatile("" : "+v"(x)); return x; }
template <int MASK> __device__ __forceinline__ float swz_f(float v) { return __builtin_bit_cast(float, __builtin_amdgcn_ds_swizzle(__builtin_bit_cast(int, v), (MASK << 10) | 0x1f)); }
template <int MASK> __device__ __forceinline__ int swz_i(int v) { return __builtin_amdgcn_ds_swizzle(v, (MASK << 10) | 0x1f); }
__device__ __forceinline__ float sum_x32(float v) { const unsigned u = __builtin_bit_cast(unsigned, v); auto rr = __builtin_amdgcn_permlane32_swap(u, u, false, false); return __builtin_bit_cast(float, (unsigned)rr[0]) + __builtin_bit_cast(float, (unsigned)rr[1]); }
__device__ __forceinline__ float max_x32(float v) { const unsigned u = __builtin_bit_cast(unsigned, v); auto rr = __builtin_amdgcn_permlane32_swap(u, u, false, false); return fmaxf(__builtin_bit_cast(float, (unsigned)rr[0]), __builtin_bit_cast(float, (unsigned)rr[1])); }
__device__ __forceinline__ int sum_x32i(int v) { auto rr = __builtin_amdgcn_permlane32_swap((unsigned)v, (unsigned)v, false, false); return (int)rr[0] + (int)rr[1]; }
__device__ __forceinline__ float get_x32(float v, int hi) { const unsigned u = __builtin_bit_cast(unsigned, v); auto rr = __builtin_amdgcn_permlane32_swap(u, u, false, false); return __builtin_bit_cast(float, hi ? (unsigned)rr[0] : (unsigned)rr[1]); }
__device__ __forceinline__ float wave_sum(float v) {
    v += swz_f<1>(v); v += swz_f<2>(v); v += swz_f<4>(v); v += swz_f<8>(v); v += swz_f<16>(v);
    return sum_x32(v);
}
__device__ __forceinline__ float rstd_of(const float* ssq, int m) {
    const f32x4* p = (const f32x4*)(ssq + 16 * (size_t)m); const f32x4 a = p[0], b = p[1], c = p[2], d = p[3];
    const float s = (((a.x + a.y) + (a.z + a.w)) + ((b.x + b.y) + (b.z + b.w))) + (((c.x + c.y) + (c.z + c.w)) + ((d.x + d.y) + (d.z + d.w)));
    return __builtin_amdgcn_rsqf(s * (1.f / 1024.f) + EPS);
}
__device__ __forceinline__ unsigned cvt_pk_bf16(float lo, float hi) { unsigned r; asm volatile("v_cvt_pk_bf16_f32 %0, %1, %2" : "=v"(r) : "v"(lo), "v"(hi)); return r; }
__device__ __forceinline__ unsigned pk4_fp8(float a, float b, float c, float d) {
    a = __builtin_amdgcn_fmed3f(a, -448.f, 448.f); b = __builtin_amdgcn_fmed3f(b, -448.f, 448.f); c = __builtin_amdgcn_fmed3f(c, -448.f, 448.f); d = __builtin_amdgcn_fmed3f(d, -448.f, 448.f);
    int w = __builtin_bit_cast(int, a); w = __builtin_amdgcn_cvt_pk_fp8_f32(a, b, w, false);
    w = __builtin_amdgcn_cvt_pk_fp8_f32(c, d, w, true); return (unsigned)w; }
__device__ __forceinline__ float fast_sigmoid(float x) { return __builtin_amdgcn_rcpf(1.f + __builtin_amdgcn_exp2f(-LOG2E * x)); }
__device__ __forceinline__ float fast_gelu_tanh(float x) { const float z = (2.f * 0.7978845608028654f * LOG2E) * (x + 0.044715f * x * x * x); return x * __builtin_amdgcn_rcpf(1.f + __builtin_amdgcn_exp2f(-z)); }
__device__ __forceinline__ f32x4 unpack_lo(u32x2 w) { return (f32x4){__builtin_bit_cast(float, w.x << 16), __builtin_bit_cast(float, w.x & 0xffff0000u), __builtin_bit_cast(float, w.y << 16), __builtin_bit_cast(float, w.y & 0xffff0000u)}; }

namespace pg8 {
typedef unsigned short bf16_t;
constexpr int BM = 256, BK = 64, HALF = 128, HTB = HALF * BK * 2, STAGE_BYTES = 8 * HTB, NXCD = 8, WGM = 8;
__host__ __device__ __forceinline__ int lds_byte(int r, int c) { const int st = (r >> 4) * 2 + (c >> 5), rr = r & 15, cc = c & 31, ob = rr * 64 + cc * 2; return st * 1024 + (ob ^ (((ob >> 9) & 1) << 5)); }
__host__ __device__ __forceinline__ void stage_rc(int b, int& R, int& C) { const int st = b / 1024, sb = b % 1024, swz = sb ^ (((sb >> 9) & 1) << 5); R = (st >> 1) * 16 + swz / 64; C = (st & 1) * 32 + (swz % 64) / 2; }
__host__ __device__ __forceinline__ int perm32(int rho) { const int n = rho >> 4, i = rho & 15; return 8 * (i >> 2) + 4 * n + (i & 3); }

struct Unit { int pm, pn, part; };
struct Gemm { const bf16_t* A; const bf16_t* Bt; int K; int pad; };

struct StaticOrder {
    int nM, nN, nwg, G, c, pad;
    __host__ __device__ void init(int M_, int N_, int G_, int c_) { nM = M_ / BM; nN = N_ / BM; nwg = nM * nN; G = G_; c = c_; pad = 0; }
    __device__ __forceinline__ void setup(int G_, int c_) { G = G_; c = c_; }
    __host__ __device__ bool next(int i, Unit& u) const {
        const int L = i * G + c; if (L >= nwg) return false;
        int wgid = L; { const int q = nwg / NXCD, r = nwg % NXCD, xcd = wgid % NXCD, off = wgid / NXCD; wgid = (xcd < r ? xcd * (q + 1) : r * (q + 1) + (xcd - r) * q) + off; }
        const int nig = WGM * nN, gid = wgid / nig, fm = gid * WGM, gsz = (nM - fm) < WGM ? (nM - fm) : WGM;
        u.pm = fm + ((wgid % nig) % gsz); u.pn = (wgid % nig) / gsz; u.part = 0; return true;
    }
    static constexpr bool TWO = false;
    __device__ __forceinline__ unsigned a_off(const Unit& u, const Gemm& g) const { return (unsigned)u.pm * (unsigned)(BM * 2) * (unsigned)g.K; }
    __device__ __forceinline__ unsigned b_off(const Unit& u, const Gemm& g) const { return (unsigned)u.pn * (unsigned)(BM * 2) * (unsigned)g.K; }
    __device__ __forceinline__ void a_ready(const Unit&) const {}
    __device__ __forceinline__ void done(const Unit&) const {}
};
struct MoeOrder {
    const int* meta; size_t wstride; int N, pad0;
    StaticOrder so; int ts[10];
    __device__ __forceinline__ void setup(int G_, int c_) {
#pragma unroll
        for (int e = 0; e < 9; ++e) ts[e] = __builtin_amdgcn_readfirstlane(__hip_atomic_load(meta + e, __ATOMIC_RELAXED, __HIP_MEMORY_SCOPE_AGENT));
        so.init(ts[8] * BM, N, G_, c_);
    }
    __device__ __forceinline__ bool next(int i, Unit& u) const { return so.next(i, u); }
    static constexpr bool TWO = false;
    __device__ __forceinline__ unsigned a_off(const Unit& u, const Gemm& g) const { return (unsigned)u.pm * (unsigned)(BM * 2) * (unsigned)g.K; }
    __device__ __forceinline__ unsigned b_off(const Unit& u, const Gemm& g) const {
        int e = 0;
#pragma unroll
        for (int j = 1; j < 8; ++j) e += (u.pm >= ts[j]) ? 1 : 0;
        return (unsigned)e * (unsigned)(wstride * 2) + (unsigned)u.pn * (unsigned)(BM * 2) * (unsigned)g.K;
    }
    __device__ __forceinline__ void a_ready(const Unit&) const {}
    __device__ __forceinline__ void done(const Unit&) const {}
};

#define EPI_ROWS(ai, m) (u.pm * BM + (ai) * HALF + wr * 64 + (m) * 16 + fr)
__device__ __forceinline__ float rstd_q(const float* ssq, int row, int fq) {
    const f32x4 p = *(const f32x4*)(ssq + 16 * (size_t)row + 4 * fq); float s = (p.x + p.y) + (p.z + p.w); s += swz_f<16>(s); s = sum_x32(s);
    return __builtin_amdgcn_rsqf(s * (1.f / 1024.f) + EPS);
}
__device__ __forceinline__ u32x4 pack8(const f32x4 a, const f32x4 b) { u32x4 w; w.x = cvt_pk_bf16(a[0], a[1]); w.y = cvt_pk_bf16(a[2], a[3]); w.z = cvt_pk_bf16(b[0], b[1]); w.w = cvt_pk_bf16(b[2], b[3]); return w; }
__device__ __forceinline__ void unpack8(const u32x4 w, f32x4& a, f32x4& b) {
    a = (f32x4){__builtin_bit_cast(float, w.x << 16), __builtin_bit_cast(float, w.x & 0xffff0000u), __builtin_bit_cast(float, w.y << 16), __builtin_bit_cast(float, w.y & 0xffff0000u)};
    b = (f32x4){__builtin_bit_cast(float, w.z << 16), __builtin_bit_cast(float, w.z & 0xffff0000u), __builtin_bit_cast(float, w.w << 16), __builtin_bit_cast(float, w.w & 0xffff0000u)}; }
template <bool GATES> struct EpiInproj {
    static constexpr bool PERM = true, AFTER_DRAIN = false, HAS_PRE = false;
    bf16* U; const float* ssq; const float* qg; const float* kg; int pn_off; float ascale;
    __device__ __forceinline__ bool reset(const Unit&) const { return true; }
    __device__ __forceinline__ void operator()(const f32x4 (&acc)[2][2][4][2], const Unit& u, int wr, int wc, int fr, int fq) const {
        const int pn = u.pn + pn_off, type = GATES ? (pn < 14 ? 3 : 4) : (pn < 4 ? 0 : pn == 4 ? 1 : pn < 10 ? 2 : pn < 14 ? 3 : 4);
        const float* gp = (type == 0 ? qg : kg) + 8 * fq; const float gsc = type == 0 ? QSCALE : 1.f;
        float rs8[2][4];
#pragma unroll
        for (int ai = 0; ai < 2; ++ai)
#pragma unroll
            for (int m = 0; m < 4; ++m) rs8[ai][m] = rstd_q(ssq, EPI_ROWS(ai, m), fq) * ascale;
#pragma unroll
        for (int ai = 0; ai < 2; ++ai)
#pragma unroll
            for (int m = 0; m < 4; ++m) { const int row = EPI_ROWS(ai, m); const float rs = rs8[ai][m]; f32x4 v[2][2];
#pragma unroll
                for (int bj = 0; bj < 2; ++bj)
#pragma unroll
                    for (int n = 0; n < 2; ++n) v[bj][n] = acc[ai][bj][m][n] * rs;
                if (!GATES && type <= 1) { float ss = 0.f;
#pragma unroll
                    for (int bj = 0; bj < 2; ++bj)
#pragma unroll
                        for (int n = 0; n < 2; ++n) ss += (v[bj][n][0] * v[bj][n][0] + v[bj][n][1] * v[bj][n][1]) + (v[bj][n][2] * v[bj][n][2] + v[bj][n][3] * v[bj][n][3]);
                    ss += swz_f<16>(ss); ss = sum_x32(ss);
                    const float r = __builtin_amdgcn_rsqf(ss * (1.f / 64.f) + EPS) * gsc;
#pragma unroll
                    for (int bj = 0; bj < 2; ++bj)
#pragma unroll
                        for (int n = 0; n < 2; ++n) v[bj][n] = v[bj][n] * r * *(const f32x4*)(gp + 32 * bj + 4 * n);
                } else if (type == 3) {
#pragma unroll
                    for (int bj = 0; bj < 2; ++bj)
#pragma unroll
                        for (int n = 0; n < 2; ++n)
#pragma unroll
                            for (int e = 0; e < 4; ++e) v[bj][n][e] = fast_gelu_tanh(v[bj][n][e]);
                } else if (type == 4) {
#pragma unroll
                    for (int bj = 0; bj < 2; ++bj)
#pragma unroll
                        for (int n = 0; n < 2; ++n)
#pragma unroll
                            for (int e = 0; e < 4; ++e) v[bj][n][e] = fmaxf(fast_sigmoid(v[bj][n][e]), 5.9604645e-8f);
                }
                bf16* rowp = U + (size_t)row * NIN + pn * BM + 64 * wc + 8 * fq;
#pragma unroll
                for (int bj = 0; bj < 2; ++bj) *(u32x4*)(rowp + 32 * bj) = pack8(v[bj][0], v[bj][1]);
            }
    }
};
struct EpiStore16 {
    static constexpr bool PERM = true, AFTER_DRAIN = false, HAS_PRE = false;
    bf16* O; int ld; float scale;
    __device__ __forceinline__ bool reset(const Unit&) const { return true; }
    __device__ __forceinline__ void operator()(const f32x4 (&acc)[2][2][4][2], const Unit& u, int wr, int wc, int fr, int fq) const {
#pragma unroll
        for (int ai = 0; ai < 2; ++ai)
#pragma unroll
            for (int m = 0; m < 4; ++m) { bf16* rowp = O + (size_t)EPI_ROWS(ai, m) * ld + u.pn * BM + wc * 32 + 8 * fq;
#pragma unroll
                for (int bj = 0; bj < 2; ++bj) *(u32x4*)(rowp + bj * HALF) = pack8(acc[ai][bj][m][0] * scale, acc[ai][bj][m][1] * scale); }
    }
};
template <bool F8> struct EpiMerge {
    static constexpr bool PERM = true, AFTER_DRAIN = false, HAS_PRE = false;
    bf16* MB; const bf16* U; float oscale; int pad_;
    __device__ __forceinline__ bool reset(const Unit& u) const { return u.part != 0; }
    __device__ __forceinline__ void operator()(f32x4 (&acc)[2][2][4][2], const Unit& u, int wr, int wc, int fr, int fq) const {
#pragma unroll
        for (int ai = 0; ai < 2; ++ai)
#pragma unroll
        for (int mb = 0; mb < 4; mb += 2) {
            u32x4 gbv[4][2], gav[4][2];
#pragma unroll
            for (int m = mb; m < mb + 2; ++m) { const int row = EPI_ROWS(ai, m);
#pragma unroll
                for (int bj = 0; bj < 2; ++bj) { const int col = u.pn * BM + bj * HALF + wc * 32 + 8 * fq; gbv[m][bj] = *(const u32x4*)(U + (size_t)row * NIN + C_GB + col);
                    if (u.part == 0) gav[m][bj] = *(const u32x4*)(U + (size_t)row * NIN + C_GA + col); } }
#pragma unroll
            for (int m = mb; m < mb + 2; ++m) { const int row = EPI_ROWS(ai, m);
#pragma unroll
                for (int bj = 0; bj < 2; ++bj) { const int col = u.pn * BM + bj * HALF + wc * 32 + 8 * fq;
                    f32x4 b0, b1; unpack8(gbv[m][bj], b0, b1);
                    if (u.part == 0) { f32x4 a0, a1; unpack8(gav[m][bj], a0, a1);
#pragma unroll
                        for (int e = 0; e < 4; ++e) { acc[ai][bj][m][0][e] *= a0[e] * __builtin_amdgcn_rcpf(b0[e]); acc[ai][bj][m][1][e] *= a1[e] * __builtin_amdgcn_rcpf(b1[e]); }
                    } else if (!F8) *(u32x4*)(MB + (size_t)row * DM + col) = pack8(acc[ai][bj][m][0] * b0, acc[ai][bj][m][1] * b1);
                    else { const f32x4 o0 = acc[ai][bj][m][0] * b0 * oscale, o1 = acc[ai][bj][m][1] * b1 * oscale;
                        { u32x2 w8; w8.x = pk4_fp8(o0[0], o0[1], o0[2], o0[3]); w8.y = pk4_fp8(o1[0], o1[1], o1[2], o1[3]); *(u32x2*)((unsigned char*)MB + (size_t)row * DM + col) = w8; }
                    }
                } }
        }
    }
};
template <int MODE, int MBAT_ = (MODE == 1 ? 2 : 4)> struct EpiResid {
    static constexpr bool PERM = true, AFTER_DRAIN = false, HAS_PRE = false;
    const bf16* hin; bf16* hout; float* outf; float* ssq_out; const bf16* PP; const float* ssq_in; unsigned char* h8; float ascale; int pad_;
    __device__ __forceinline__ bool reset(const Unit&) const { return true; }
    __device__ __forceinline__ void operator()(const f32x4 (&acc)[2][2][4][2], const Unit& u, int wr, int wc, int fr, int fq) const {
        constexpr int MBAT = MBAT_;
#pragma unroll
        for (int ai = 0; ai < 2; ++ai)
#pragma unroll
        for (int mb = 0; mb < 4; mb += MBAT) {
            u32x4 hv[4][2], pv[4][2]; float rs4[4];
#pragma unroll
            for (int m = mb; m < mb + MBAT; ++m) { const int row = EPI_ROWS(ai, m); rs4[m] = 0.f; if (MODE == 1) rs4[m] = rstd_q(ssq_in, row, fq) * ascale;
#pragma unroll
                for (int bj = 0; bj < 2; ++bj) { const size_t off = (size_t)row * DM + u.pn * BM + bj * HALF + wc * 32 + 8 * fq; hv[m][bj] = *(const u32x4*)(hin + off); if (MODE == 1) pv[m][bj] = *(const u32x4*)(PP + off); } }
#pragma unroll
            for (int m = mb; m < mb + MBAT; ++m) { const int row = EPI_ROWS(ai, m); const float rs = rs4[m]; float ss = 0.f;
#pragma unroll
                for (int bj = 0; bj < 2; ++bj) { const size_t off = (size_t)row * DM + u.pn * BM + bj * HALF + wc * 32 + 8 * fq;
                    f32x4 v0, v1; unpack8(hv[m][bj], v0, v1); const f32x4 a0 = acc[ai][bj][m][0], a1 = acc[ai][bj][m][1];
                    if (MODE == 0) { v0 = v0 + a0 * ascale; v1 = v1 + a1 * ascale; }
                    else { f32x4 p0, p1; unpack8(pv[m][bj], p0, p1);
#pragma unroll
                        for (int e = 0; e < 4; ++e) { v0[e] += fast_sigmoid(a0[e] * rs) * p0[e]; v1[e] += fast_sigmoid(a1[e] * rs) * p1[e]; } }
                    if (outf) { *(f32x4*)(outf + off) = v0; *(f32x4*)(outf + off + 4) = v1; }
                    else *(u32x4*)(hout + off) = pack8(v0, v1);
                    if (h8) { u32x2 w8; w8.x = pk4_fp8(v0[0], v0[1], v0[2], v0[3]); w8.y = pk4_fp8(v1[0], v1[1], v1[2], v1[3]); *(u32x2*)(h8 + off) = w8; }
                    ss += ((v0[0] * v0[0] + v0[1] * v0[1]) + (v0[2] * v0[2] + v0[3] * v0[3])) + ((v1[0] * v1[0] + v1[1] * v1[1]) + (v1[2] * v1[2] + v1[3] * v1[3])); }
                ss += swz_f<16>(ss); ss = sum_x32(ss);
                if (fq == 0) ssq_out[(size_t)row * 16 + u.pn * 4 + wc] = ss; }
        }
    }
};
template <bool MOE> struct EpiSwiglu {
    static constexpr bool PERM = true, AFTER_DRAIN = false, HAS_PRE = MOE && MOE_FP8;
    __device__ __forceinline__ void pre_load(float (&pre)[8], const Unit& u, int wr) const { const int fr = lane_id() & 15;
#pragma unroll
        for (int ai = 0; ai < 2; ++ai)
#pragma unroll
            for (int m = 0; m < 4; ++m) { const unsigned o4 = (unsigned)EPI_ROWS(ai, m) * 4u; asm volatile("global_load_dword %0, %1, %2" : "=v"(pre[ai * 4 + m]) : "v"(o4), "s"(sgw) : "memory"); } }
    bf16* G; const float* ssq; const float* srs; const float* sgw; int f8; float ascale;
    __device__ __forceinline__ bool reset(const Unit&) const { return true; }
    __device__ __forceinline__ void operator()(const f32x4 (&acc)[2][2][4][2], const Unit& u, int wr, int wc, int fr, int fq, const float* pre = nullptr) const {
        float rs8[2][4], gw8[2][4];
#pragma unroll
        for (int ai = 0; ai < 2; ++ai)
#pragma unroll
            for (int m = 0; m < 4; ++m) { const int row = EPI_ROWS(ai, m); float rs, gw = 1.f;
                if (MOE) { rs = (MOE_FP8 ? opaque_f(1.f / W13_SCALE) : srs[row]); gw = (HAS_PRE ? pre[ai * 4 + m] : sgw[row]) * (MOE_FP8 ? G8_SCALE : 1.f); } else { rs = rstd_q(ssq, row, fq) * ascale; if (f8) gw = G8_SCALE; }
                rs8[ai][m] = rs; gw8[ai][m] = gw; }
#pragma unroll
        for (int ai = 0; ai < 2; ++ai)
#pragma unroll
            for (int m = 0; m < 4; ++m) { const int row = EPI_ROWS(ai, m); const float rs = rs8[ai][m], gw = gw8[ai][m];
                const float rs2 = rs * gw; f32x4 o[2];
#pragma unroll
                for (int bj = 0; bj < 2; ++bj)
#pragma unroll
                    for (int e = 0; e < 4; ++e) { const float a = acc[ai][bj][m][0][e] * rs, b = acc[ai][bj][m][1][e] * rs2; o[bj][e] = a * fast_sigmoid(a) * b; }
                if ((MOE && MOE_FP8) || (!MOE && f8)) { u32x2 w; w.x = pk4_fp8(o[0][0], o[0][1], o[0][2], o[0][3]); w.y = pk4_fp8(o[1][0], o[1][1], o[1][2], o[1][3]);
                    *(u32x2*)((unsigned char*)G + (size_t)row * DFF + u.pn * HALF + wc * 32 + 8 * fq) = w; }
                else *(u32x4*)(G + (size_t)row * DFF + u.pn * HALF + wc * 32 + 8 * fq) = pack8(o[0], o[1]); }
    }
};
struct MergeOrder {
    const bf16_t* A1; const bf16_t* Bt1; StaticOrder so;
    __device__ __forceinline__ void setup(int G_, int c_) { so.setup(G_, c_); }
    __device__ __forceinline__ bool next(int i, Unit& u) const { const bool ok = so.next(i >> 1, u); u.part = i & 1; return ok; }
    static constexpr bool TWO = true;
    __device__ __forceinline__ unsigned a_off(const Unit& u, const Gemm& g) const { return (unsigned)u.pm * (unsigned)(BM * 2) * (unsigned)g.K; }
    __device__ __forceinline__ unsigned b_off(const Unit& u, const Gemm& g) const { return (unsigned)u.pn * (unsigned)(BM * 2) * (unsigned)g.K; }
    __device__ __forceinline__ void a_ready(const Unit&) const {}
    __device__ __forceinline__ void done(const Unit&) const {}
};

typedef int v8i_t __attribute__((ext_vector_type(8)));
__device__ __forceinline__ v8i_t cat8(const bf16x8 a, const bf16x8 b) { const u32x4 x = __builtin_bit_cast(u32x4, a), y = __builtin_bit_cast(u32x4, b); return (v8i_t){(int)x.x, (int)x.y, (int)x.z, (int)x.w, (int)y.x, (int)y.y, (int)y.z, (int)y.w}; }
template <class Epi, class Sched, bool ALIGN_EPI = false, bool SP2 = false, bool FP8 = false>
__device__ __forceinline__ void gemm_phase(LAS unsigned char* lds, const Gemm g, const Sched& S, const Epi& E, int wbase) {
    const int tid = opaque_tid(wbase), wid = __builtin_amdgcn_readfirstlane(tid >> 6), lane = tid & 63, wr = wid >> 2, wc = wid & 3, fr = lane & 15, fq = lane >> 4;
    const int K = opaque_s(g.K), nt = K / BK;
    unsigned voffA[2], voffB[2];
#pragma unroll
    for (int i = 0; i < 2; ++i) { int R, C; stage_rc(tid * 16 + i * 8192, R, C); const int Rb = Epi::PERM ? ((R & ~31) + perm32(R & 31)) : R;
        voffA[i] = (unsigned)(R * K + C) * 2u; voffB[i] = (unsigned)(Rb * K + C) * 2u; }
    const unsigned kstep = (unsigned)(BK * 2);
    const unsigned hstep = (unsigned)HALF * (unsigned)K * 2u;
    typedef __amdgpu_buffer_rsrc_t rsrc_t;
    const rsrc_t rA0 = __builtin_amdgcn_make_buffer_rsrc((void*)g.A, 0, 0xffffffff, 0x00020000), rB0 = __builtin_amdgcn_make_buffer_rsrc((void*)g.Bt, 0, 0xffffffff, 0x00020000);
    rsrc_t rA1 = rA0, rB1 = rB0;
    if constexpr (Sched::TWO) { rA1 = __builtin_amdgcn_make_buffer_rsrc((void*)S.A1, 0, 0xffffffff, 0x00020000); rB1 = __builtin_amdgcn_make_buffer_rsrc((void*)S.Bt1, 0, 0xffffffff, 0x00020000); }
    const unsigned ldsw = (unsigned)wid * 1024u;
    const int aoff = lds_byte(wr * 64 + fr, fq * 8), boff = lds_byte(wc * 32 + fr, fq * 8);
#define PG8_SA(b, h) (((b) * 2 + (h)) * HTB)
#define PG8_SB(b, h) ((4 + (b) * 2 + (h)) * HTB)
#define PG8_STAGE(bufoff, rs_, soff_, voff) do { _Pragma("unroll") for (int _i = 0; _i < 2; ++_i) \
        __builtin_amdgcn_raw_ptr_buffer_load_lds(rs_, (LAS void*)(lds + (bufoff) + ldsw + _i * 8192), 16, (int)(voff)[_i], (int)(soff_), 0, 0); } while (0)
#define PG8_LD2(p_) cat8(*(const LAS bf16x8*)(p_), *(const LAS bf16x8*)((p_) + 1024))
#define PG8_LDA(dst, b, h) do { _Pragma("unroll") for (int m = 0; m < 4; ++m) dst[m] = PG8_LD2(lds + PG8_SA(b, h) + aoff + m * 2048); } while (0)
#define PG8_LDB(dst, b, h) do { _Pragma("unroll") for (int n = 0; n < 2; ++n) dst[n] = PG8_LD2(lds + PG8_SB(b, h) + boff + n * 2048); } while (0)
#define PG8_LO(v_) __builtin_bit_cast(bf16x8, __builtin_shufflevector(v_, v_, 0, 1, 2, 3))
#define PG8_HI(v_) __builtin_bit_cast(bf16x8, __builtin_shufflevector(v_, v_, 4, 5, 6, 7))
#define PG8_MMA(ai, bj, At, Bt) do { __builtin_amdgcn_s_setprio(1); \
        if constexpr (FP8) { _Pragma("unroll") for (int m = 0; m < 4; ++m) _Pragma("unroll") for (int n = 0; n < 2; ++n) \
            acc[ai][bj][m][n] = __builtin_amdgcn_mfma_scale_f32_16x16x128_f8f6f4(Bt[n], At[m], acc[ai][bj][m][n], 0, 0, 0, 0x7f7f7f7f, 0, 0x7f7f7f7f); } \
        else { _Pragma("unroll") for (int m = 0; m < 4; ++m) _Pragma("unroll") for (int n = 0; n < 2; ++n) { \
            acc[ai][bj][m][n] = __builtin_amdgcn_mfma_f32_16x16x32_bf16(PG8_LO(Bt[n]), PG8_LO(At[m]), acc[ai][bj][m][n], 0, 0, 0); \
            acc[ai][bj][m][n] = __builtin_amdgcn_mfma_f32_16x16x32_bf16(PG8_HI(Bt[n]), PG8_HI(At[m]), acc[ai][bj][m][n], 0, 0, 0); } } \
        __builtin_amdgcn_s_setprio(0); } while (0)
#define PG8_WAIT_V(n) asm volatile("s_waitcnt vmcnt(" #n ")" ::: "memory")
#define PG8_WAIT_L(n) asm volatile("s_waitcnt lgkmcnt(" #n ")" ::: "memory")
#define PG8_BAR __builtin_amdgcn_s_barrier()
#define PG8_SCHED __builtin_amdgcn_sched_barrier(0)
    Unit cur, nxt; int ui = 0;
    if (!S.next(0, cur)) return;
    f32x4 acc[2][2][4][2];
#define PG8_ZERO_ACC() do { float z_; asm volatile("v_mov_b32 %0, 0" : "=v"(z_)); _Pragma("unroll") for (int a = 0; a < 2; ++a) _Pragma("unroll") for (int b = 0; b < 2; ++b) _Pragma("unroll") for (int m = 0; m < 4; ++m) \
        _Pragma("unroll") for (int n = 0; n < 2; ++n) acc[a][b][m][n] = (f32x4){z_, z_, z_, z_}; } while (0)
    PG8_ZERO_ACC();
    v8i_t At[4], B0[2], B1[2];
    unsigned cA = S.a_off(cur, g), cB = S.b_off(cur, g); rsrc_t rAc = (Sched::TWO && cur.part) ? rA1 : rA0, rBc = (Sched::TWO && cur.part) ? rB1 : rB0;
    S.a_ready(cur);
    if constexpr (SP2) {
        PG8_STAGE(PG8_SB(0, 0), rBc, cB, voffB); PG8_STAGE(PG8_SB(0, 1), rBc, cB + hstep, voffB); PG8_STAGE(PG8_SA(0, 0), rAc, cA, voffA); PG8_STAGE(PG8_SA(0, 1), rAc, cA + hstep, voffA);
        if (wr == 1) PG8_BAR;
        PG8_WAIT_V(2); PG8_BAR;
        PG8_STAGE(PG8_SB(1, 0), rBc, cB + kstep, voffB); PG8_STAGE(PG8_SA(1, 0), rAc, cA + kstep, voffA); PG8_STAGE(PG8_SB(1, 1), rBc, cB + hstep + kstep, voffB);
        PG8_WAIT_V(6); PG8_BAR;
    } else {
        PG8_STAGE(PG8_SB(0, 0), rBc, cB, voffB); PG8_STAGE(PG8_SA(0, 0), rAc, cA, voffA); PG8_STAGE(PG8_SB(0, 1), rBc, cB + hstep, voffB); PG8_STAGE(PG8_SA(0, 1), rAc, cA + hstep, voffA);
        if (wr == 1) PG8_BAR;
        PG8_WAIT_V(4); PG8_BAR;
        PG8_STAGE(PG8_SB(1, 0), rBc, cB + kstep, voffB); PG8_STAGE(PG8_SA(1, 0), rAc, cA + kstep, voffA); PG8_STAGE(PG8_SB(1, 1), rBc, cB + hstep + kstep, voffB);
        PG8_WAIT_V(6); PG8_BAR;
    }
    for (;;) {
        const bool has_next = S.next(ui + 1, nxt);
        const unsigned nA = has_next ? S.a_off(nxt, g) : cA, nB = has_next ? S.b_off(nxt, g) : cB;
        const rsrc_t rAn = (Sched::TWO && has_next) ? (nxt.part ? rA1 : rA0) : rAc, rBn = (Sched::TWO && has_next) ? (nxt.part ? rB1 : rB0) : rBc;
        float pre_[8] = {0.f, 0.f, 0.f, 0.f, 0.f, 0.f, 0.f, 0.f};
        if constexpr (Epi::HAS_PRE) E.pre_load(pre_, cur, wr);
        for (int t = 0; t < nt; t += 2) {
            const bool last = (t == nt - 2);
            const unsigned a1 = cA + (unsigned)(t + 1) * kstep;
            const unsigned a2 = last ? nA : cA + (unsigned)(t + 2) * kstep, b2 = last ? nB : cB + (unsigned)(t + 2) * kstep; const rsrc_t rA2 = (Sched::TWO && last) ? rAn : rAc, rB2 = (Sched::TWO && last) ? rBn : rBc;
            const unsigned a3 = a2 + kstep, b3 = b2 + kstep;
            if (last && has_next) S.a_ready(nxt);
            if constexpr (SP2) {
            PG8_LDB(B0, 0, 0); PG8_LDB(B1, 0, 1); PG8_SCHED; PG8_LDA(At, 0, 0); PG8_STAGE(PG8_SA(1, 1), rAc, a1 + hstep, voffA);
            PG8_WAIT_V(8); PG8_WAIT_L(0); PG8_BAR; PG8_MMA(0, 0, At, B0); PG8_MMA(0, 1, At, B1); PG8_BAR; PG8_SCHED;
            PG8_LDA(At, 0, 1); PG8_STAGE(PG8_SB(0, 0), rB2, b2, voffB); PG8_STAGE(PG8_SB(0, 1), rB2, b2 + hstep, voffB); PG8_STAGE(PG8_SA(0, 0), rA2, a2, voffA);
            PG8_WAIT_V(8); PG8_WAIT_L(0); PG8_BAR; PG8_MMA(1, 0, At, B0); PG8_MMA(1, 1, At, B1); PG8_BAR; PG8_SCHED;
            PG8_LDB(B0, 1, 0); PG8_LDB(B1, 1, 1); PG8_SCHED; PG8_LDA(At, 1, 0); PG8_STAGE(PG8_SA(0, 1), rA2, a2 + hstep, voffA);
            PG8_WAIT_V(8); PG8_WAIT_L(0); PG8_BAR; PG8_MMA(0, 0, At, B0); PG8_MMA(0, 1, At, B1); PG8_BAR; PG8_SCHED;
            PG8_LDA(At, 1, 1); PG8_STAGE(PG8_SB(1, 0), rB2, b3, voffB); PG8_STAGE(PG8_SB(1, 1), rB2, b3 + hstep, voffB); PG8_STAGE(PG8_SA(1, 0), rA2, a3, voffA);
            PG8_WAIT_V(8); PG8_WAIT_L(0); PG8_BAR; PG8_MMA(1, 0, At, B0); PG8_MMA(1, 1, At, B1); PG8_BAR; PG8_SCHED;
            } else {
            PG8_LDB(B0, 0, 0); PG8_SCHED; PG8_LDA(At, 0, 0); PG8_STAGE(PG8_SA(1, 1), rAc, a1 + hstep, voffA);
            PG8_WAIT_L(8); PG8_BAR; PG8_WAIT_L(0); PG8_MMA(0, 0, At, B0); PG8_BAR; PG8_SCHED;
            PG8_LDB(B1, 0, 1); PG8_STAGE(PG8_SB(0, 0), rB2, b2, voffB);
            PG8_BAR; PG8_WAIT_L(0); PG8_MMA(0, 1, At, B1); PG8_BAR;
            PG8_LDA(At, 0, 1); PG8_STAGE(PG8_SA(0, 0), rA2, a2, voffA);
            PG8_BAR; PG8_WAIT_L(0); PG8_MMA(1, 0, At, B0); PG8_BAR; PG8_SCHED;
            PG8_STAGE(PG8_SB(0, 1), rB2, b2 + hstep, voffB);
            PG8_WAIT_V(6); PG8_BAR; PG8_MMA(1, 1, At, B1); PG8_BAR;
            PG8_LDB(B0, 1, 0); PG8_SCHED; PG8_LDA(At, 1, 0); PG8_STAGE(PG8_SA(0, 1), rA2, a2 + hstep, voffA);
            PG8_WAIT_L(8); PG8_BAR; PG8_WAIT_L(0); PG8_MMA(0, 0, At, B0); PG8_BAR; PG8_SCHED;
            PG8_LDB(B1, 1, 1); PG8_STAGE(PG8_SB(1, 0), rB2, b3, voffB);
            PG8_BAR; PG8_WAIT_L(0); PG8_MMA(0, 1, At, B1); PG8_BAR;
            PG8_LDA(At, 1, 1); PG8_STAGE(PG8_SA(1, 0), rA2, a3, voffA);
            PG8_BAR; PG8_WAIT_L(0); PG8_MMA(1, 0, At, B0); PG8_BAR; PG8_SCHED;
            PG8_STAGE(PG8_SB(1, 1), rB2, b3 + hstep, voffB);
            PG8_WAIT_V(6); PG8_BAR; PG8_MMA(1, 1, At, B1); PG8_BAR;
            }
        }
        if constexpr (ALIGN_EPI) { if (wr == 0) PG8_BAR; }
        { int fr_ = fr, fq_ = fq; asm volatile("" : "+v"(fr_), "+v"(fq_));
          if constexpr (Epi::HAS_PRE) E(acc, cur, wr, wc, fr_, fq_, pre_); else E(acc, cur, wr, wc, fr_, fq_); } S.done(cur);
        if (!has_next) break;
        if (E.reset(cur)) PG8_ZERO_ACC();
        cur = nxt; cA = nA; cB = nB; rAc = rAn; rBc = rBn; ++ui;
        if constexpr (ALIGN_EPI) { if (wr == 1) PG8_BAR; }
    }
    PG8_WAIT_V(0);
    if constexpr (!ALIGN_EPI) { if (wr == 0) PG8_BAR; }
    PG8_BAR;
#undef PG8_SA
#undef PG8_SB
#undef PG8_STAGE
#undef PG8_LDA
#undef PG8_ZERO_ACC
#undef PG8_LD2
#undef PG8_LO
#undef PG8_HI
#undef PG8_LDB
#undef PG8_MMA
#undef PG8_WAIT_V
#undef PG8_WAIT_L
#undef PG8_BAR
#undef PG8_SCHED
}
}

struct CJob { const float* W; const float* gain; bf16* dst; int K, N, mode, fp8; float wscale; int ldw, col0, pad; };
struct Ptrs { const float* in[30]; float* out; unsigned char* ws; };
typedef const __attribute__((address_space(4))) Ptrs* KP;

__device__ __forceinline__ void conv_load(const CJob& jb, int item, int lane, f32x4 (&v)[8]) {
    const int nblk = jb.N / 32, kb = item / nblk, nb = item % nblk, k0 = 64 * kb, n0 = 32 * nb;
    const float* src = jb.W + (size_t)(k0 + (lane >> 3)) * jb.ldw + jb.col0 + n0 + 4 * (lane & 7);
#pragma unroll
    for (int i = 0; i < 8; ++i) v[i] = __builtin_nontemporal_load((const f32x4*)(src + (size_t)(8 * i) * jb.ldw));
}
__device__ __forceinline__ void conv_finish(const CJob& jb, LAS float* scr, int item, int lane, const f32x4 (&v)[8]) {
    const int nblk = jb.N / 32, kb = item / nblk, nb = item % nblk, k0 = 64 * kb, n0 = 32 * nb;
    const int c = lane & 7;
    f32x4 g0 = (f32x4){1.f, 1.f, 1.f, 1.f}, g1 = g0;
    if (jb.gain) { g0 = *(const f32x4*)(jb.gain + k0 + 8 * c); g1 = *(const f32x4*)(jb.gain + k0 + 8 * c + 4); }
#pragma unroll
    for (int i = 0; i < 8; ++i) { LAS float* d = scr + ((lane >> 3) + 8 * i) * 33 + 4 * (lane & 7); d[0] = v[i].x; d[1] = v[i].y; d[2] = v[i].z; d[3] = v[i].w; }
    asm volatile("s_waitcnt lgkmcnt(0)" ::: "memory");
#pragma unroll
    for (int j = 0; j < 4; ++j) { const int n = (lane >> 3) + 8 * j; const LAS float* s = scr + (8 * c) * 33 + n;
        u32x4 o; o.x = cvt_pk_bf16(s[0 * 33] * g0.x, s[1 * 33] * g0.y); o.y = cvt_pk_bf16(s[2 * 33] * g0.z, s[3 * 33] * g0.w); o.z = cvt_pk_bf16(s[4 * 33] * g1.x, s[5 * 33] * g1.y); o.w = cvt_pk_bf16(s[6 * 33] * g1.z, s[7 * 33] * g1.w);
        const int nn = n0 + n; int row = nn;
        if (jb.mode == 3) { const int w = nn & 255; row = (nn & ~255) + ((w >> 5) & 1) * 128 + (w >> 6) * 32 + (w & 31); }
        else if (jb.mode >= 4) { const int r = nn & 127; row = (nn >> 7) * 256 + ((r >> 2) & 1) * 128 + (r >> 5) * 32 + ((r >> 3) & 3) * 8 + (jb.mode == 5 ? 4 : 0) + (r & 3); }
        if (jb.fp8) { const float ws_ = jb.wscale; u32x2 o8; o8.x = pk4_fp8(s[0 * 33] * g0.x * ws_, s[1 * 33] * g0.y * ws_, s[2 * 33] * g0.z * ws_, s[3 * 33] * g0.w * ws_);
            o8.y = pk4_fp8(s[4 * 33] * g1.x * ws_, s[5 * 33] * g1.y * ws_, s[6 * 33] * g1.z * ws_, s[7 * 33] * g1.w * ws_); *(u32x2*)((unsigned char*)jb.dst + (size_t)row * jb.K + k0 + 8 * c) = o8; }
        else *(u32x4*)(jb.dst + (size_t)row * jb.K + k0 + 8 * c) = o; }
    asm volatile("s_waitcnt lgkmcnt(0)" ::: "memory");
}
__device__ __forceinline__ void conv_item(const CJob& jb, LAS float* scr, int item, int lane) { f32x4 v[8]; conv_load(jb, item, lane, v); conv_finish(jb, scr, item, lane, v); }
__device__ __forceinline__ void conv_job(const CJob& jb, LAS float* scr, int gw, int ngw, int lane, int& base) {
    const int nit = (jb.K / 64) * (jb.N / 32);
    int first = gw - base; if (first < 0) first += ngw;
    for (int it = first; it < nit; it += ngw) conv_item(jb, scr, it, lane);
    base = (base + nit) % ngw;
}
__device__ __forceinline__ CJob static_job(KP P, int j) {
    CJob jb; jb.pad = 0; jb.gain = nullptr; jb.mode = 0; jb.fp8 = 0; jb.wscale = 1.f; jb.ldw = 0; jb.col0 = 0;
    if (j >= 30 + 128) { const int l = j - (30 + 128);
        jb.W = P->in[3] + (size_t)l * DM * NIN; jb.gain = P->in[2] + l * DM; jb.dst = (bf16*)(P->ws + WS_WIN + (size_t)l * NIN * DM * 2 + (size_t)NIN_A * DM * 2); jb.K = DM; jb.N = NIN_B; jb.mode = 3; jb.fp8 = 1; jb.wscale = WIN_SCALE; jb.ldw = NIN; jb.col0 = C_LG; return jb; }
    if (j < 24) { const int l = j / 6, k = j % 6;
        if (k == 0) { jb.W = P->in[3] + (size_t)l * DM * NIN; jb.gain = P->in[2] + l * DM; jb.dst = (bf16*)(P->ws + WS_WIN + (size_t)l * NIN * DM * (INPROJ_FP8 ? 1 : 2)); jb.K = DM; jb.N = INPROJ_GATES_FP8 ? NIN_A : NIN; jb.ldw = NIN; jb.mode = 3; jb.fp8 = (INPROJ_FP8 || ((INPROJ_FP8_MASK >> l) & 1)) ? 1 : 0; jb.wscale = jb.fp8 ? WIN_SCALE : 1.f; }
        else if (k == 1) { jb.W = P->in[15] + (size_t)l * DM * DM; jb.dst = (bf16*)(P->ws + WS_WPA) + (size_t)l * DM * DM; jb.K = DM; jb.N = DM; jb.fp8 = (MERGE_FP8_MASK >> l) & 1; jb.wscale = jb.fp8 ? WIN_SCALE : 1.f; }
        else if (k == 2) { jb.W = P->in[16] + (size_t)l * DM * DM; jb.dst = (bf16*)(P->ws + WS_WPB) + (size_t)l * DM * DM; jb.K = DM; jb.N = DM; jb.fp8 = (MERGE_FP8_MASK >> l) & 1; jb.wscale = jb.fp8 ? WIN_SCALE : 1.f; }
        else if (k == 3) { jb.W = P->in[17] + (size_t)l * DM * DM; jb.dst = (bf16*)(P->ws + WS_WOUT) + (size_t)l * DM * DM; jb.K = DM; jb.N = DM; jb.fp8 = (OUT_FP8_MASK >> l) & 1; jb.wscale = jb.fp8 ? WIN_SCALE : 1.f; }
        else if (k == 4) { jb.W = P->in[28] + (size_t)l * DM * DM; jb.gain = P->in[27] + l * DM; jb.dst = (bf16*)(P->ws + WS_WPG) + (size_t)l * DM * DM; jb.K = DM; jb.N = DM; jb.fp8 = (PLE_FP8_MASK >> l) & 1; jb.wscale = jb.fp8 ? WIN_SCALE : 1.f; }
        else { jb.W = P->in[29] + (size_t)l * PLE * DM; jb.dst = (bf16*)(P->ws + WS_WPP) + (size_t)l * DM * PLE; jb.K = PLE; jb.N = DM; }
    } else if (j >= 30) { const int idx = j - 30, l = idx >> 5, mat = (idx >> 4) & 1, n = idx & 15;
        jb.W = P->in[mat ? 12 : 10] + (size_t)(l * 16 + n) * 64 * 64; jb.dst = (bf16*)(P->ws + WS_LRUW) + (size_t)((l * 2 + mat) * 16 + n) * 64 * 64; jb.K = 64; jb.N = 64;
    } else { const int j2 = (j - 24) / 3, k = (j - 24) % 3;
        const bool f8 = (DENSE_FP8_MASK >> j2) & 1;
        if (k < 2) { jb.W = P->in[19 + k] + (size_t)j2 * DM * DFF; jb.gain = P->in[18] + (2 * j2) * DM; jb.dst = (bf16*)(P->ws + WS_W13D) + (size_t)j2 * 2 * DFF * DM; jb.K = DM; jb.N = DFF; jb.mode = 4 + k; jb.fp8 = f8; jb.wscale = f8 ? W13_SCALE : 1.f; }
        else { jb.W = P->in[21] + (size_t)j2 * DFF * DM; jb.dst = (bf16*)(P->ws + WS_W2D) + (size_t)j2 * DM * DFF; jb.K = DFF; jb.N = DM; jb.fp8 = f8; jb.wscale = f8 ? W2_SCALE : 1.f; }
    }
    if (jb.ldw == 0) jb.ldw = jb.N;
    return jb;
}
__device__ __forceinline__ CJob moe_job(KP P, int j2, int j) {
    CJob jb; jb.pad = 0; jb.gain = nullptr; jb.mode = 0; jb.fp8 = MOE_FP8 ? 1 : 0; jb.wscale = 1.f; jb.col0 = 0; const int e = j / 3, k = j % 3;
    if (k < 2) { jb.W = P->in[24 + k] + ((size_t)j2 * NEXP + e) * DM * DFF; jb.gain = P->in[18] + (2 * j2 + 1) * DM; jb.dst = (bf16*)(P->ws + WS_W13E + (size_t)e * 2 * DFF * DM * (MOE_FP8 ? 1 : 2)); jb.K = DM; jb.N = DFF; jb.mode = 4 + k; jb.wscale = MOE_FP8 ? W13_SCALE : 1.f; }
    else { jb.W = P->in[26] + ((size_t)j2 * NEXP + e) * DFF * DM; jb.dst = (bf16*)(P->ws + WS_W2E + (size_t)e * DM * DFF * (MOE_FP8 ? 1 : 2)); jb.K = DFF; jb.N = DM; jb.wscale = MOE_FP8 ? W2_SCALE : 1.f; }
    jb.ldw = jb.N;
    return jb;
}
__device__ __forceinline__ void conv_static_all(KP P, const LAS int* pref, int njobs, LAS float* scr, int gw, int ngw, int lane) {
#define PREF_U(j_) __builtin_amdgcn_readfirstlane(pref[j_])
    const int NT = PREF_U(njobs); int fl = gw; if (fl >= NT) return;
    int job = 0; while (fl >= PREF_U(job + 1)) ++job;
    CJob jb = static_job(P, job); f32x4 v[8]; conv_load(jb, fl - PREF_U(job), lane, v);
    for (;;) { const int nx = fl + ngw; const bool has = nx < NT; CJob jn = jb; int jobn = job; f32x4 w[8];
        if (has) { while (nx >= PREF_U(jobn + 1)) ++jobn; jn = static_job(P, jobn); conv_load(jn, nx - PREF_U(jobn), lane, w); }
        conv_finish(jb, scr, fl - PREF_U(job), lane, v);
        if (!has) break;
        jb = jn; job = jobn; fl = nx;
#pragma unroll
        for (int i = 0; i < 8; ++i) v[i] = w[i]; }
#undef PREF_U
}
__device__ __forceinline__ void conv_moe_layer(KP P, int j2, LAS float* scr, int gw, int ngw, int lane) {
    constexpr int IT = (DM / 64) * (DFF / 32), NT = 24 * IT;
    int fl = gw; if (fl >= NT) return;
    CJob jb = moe_job(P, j2, fl / IT); f32x4 v[8]; conv_load(jb, fl % IT, lane, v);
    for (;;) { const int nx = fl + ngw; const bool has = nx < NT; CJob jn = jb; f32x4 w[8];
        if (has) { jn = moe_job(P, j2, nx / IT); conv_load(jn, nx % IT, lane, w); }
        conv_finish(jb, scr, fl % IT, lane, v);
        if (!has) break;
        jb = jn; fl = nx;
#pragma unroll
        for (int i = 0; i < 8; ++i) v[i] = w[i]; }
}
template <bool COMBINE> __device__ __forceinline__ void rowstats_row(const float* xrow, bf16* hbrow, float* ssq, const bf16* o1, const bf16* o2, int lane, unsigned char* h8row = nullptr) {
    float s[4];
#pragma unroll
    for (int j = 0; j < 4; ++j) { f32x4 v;
        if (COMBINE) v = unpack_lo(*((const u32x2*)hbrow + lane + 64 * j)) + unpack_lo(*((const u32x2*)o1 + lane + 64 * j)) + unpack_lo(*((const u32x2*)o2 + lane + 64 * j));
        else v = *((const f32x4*)xrow + lane + 64 * j);
        s[j] = (v.x * v.x + v.y * v.y) + (v.z * v.z + v.w * v.w);
        u32x2 o; o.x = cvt_pk_bf16(v.x, v.y); o.y = cvt_pk_bf16(v.z, v.w); *((u32x2*)hbrow + lane + 64 * j) = o;
        if (h8row) *((unsigned*)h8row + lane + 64 * j) = pk4_fp8(v.x, v.y, v.z, v.w); }
#pragma unroll
    for (int j = 0; j < 4; ++j) s[j] = wave_sum(s[j]);
    const float v = lane == 0 ? s[0] : lane == 1 ? s[1] : lane == 2 ? s[2] : lane == 3 ? s[3] : 0.f;
    if (lane < 16) ssq[lane] = v;
}

__device__ __forceinline__ void rowstats_x2(const float* xA, bf16* hA, float* ssqA, const float* xB, bf16* hB, float* ssqB, int lane) {
    f32x4 va[4], vb[4];
#pragma unroll
    for (int j = 0; j < 4; ++j) { va[j] = __builtin_nontemporal_load((const f32x4*)xA + lane + 64 * j); vb[j] = __builtin_nontemporal_load((const f32x4*)xB + lane + 64 * j); }
    float sa[4], sb[4];
#pragma unroll
    for (int j = 0; j < 4; ++j) { const f32x4 v = va[j], w = vb[j]; sa[j] = (v.x * v.x + v.y * v.y) + (v.z * v.z + v.w * v.w); sb[j] = (w.x * w.x + w.y * w.y) + (w.z * w.z + w.w * w.w);
        u32x2 o; o.x = cvt_pk_bf16(v.x, v.y); o.y = cvt_pk_bf16(v.z, v.w); *((u32x2*)hA + lane + 64 * j) = o; o.x = cvt_pk_bf16(w.x, w.y); o.y = cvt_pk_bf16(w.z, w.w); *((u32x2*)hB + lane + 64 * j) = o; }
#pragma unroll
    for (int j = 0; j < 4; ++j) { sa[j] = wave_sum(sa[j]); sb[j] = wave_sum(sb[j]); }
    const float ua = lane == 0 ? sa[0] : lane == 1 ? sa[1] : lane == 2 ? sa[2] : lane == 3 ? sa[3] : 0.f, ub = lane == 0 ? sb[0] : lane == 1 ? sb[1] : lane == 2 ? sb[2] : lane == 3 ? sb[3] : 0.f;
    if (lane < 16) { ssqA[lane] = ua; ssqB[lane] = ub; }
}
__device__ __forceinline__ void combine_rows2(bf16* hA, float* ssqA, const bf16* a1, const bf16* a2, bf16* hB, float* ssqB, const bf16* b1, const bf16* b2, int lane, unsigned char* h8A = nullptr, unsigned char* h8B = nullptr) {
    u32x2 ra[3][4], rb[3][4];
#pragma unroll
    for (int j = 0; j < 4; ++j) { ra[0][j] = *((const u32x2*)hA + lane + 64 * j); ra[1][j] = *((const u32x2*)a1 + lane + 64 * j); ra[2][j] = *((const u32x2*)a2 + lane + 64 * j);
                                  rb[0][j] = *((const u32x2*)hB + lane + 64 * j); rb[1][j] = *((const u32x2*)b1 + lane + 64 * j); rb[2][j] = *((const u32x2*)b2 + lane + 64 * j); }
    float sa[4], sb[4];
#pragma unroll
    for (int j = 0; j < 4; ++j) { const f32x4 v = unpack_lo(ra[0][j]) + unpack_lo(ra[1][j]) + unpack_lo(ra[2][j]), w = unpack_lo(rb[0][j]) + unpack_lo(rb[1][j]) + unpack_lo(rb[2][j]);
        sa[j] = (v.x * v.x + v.y * v.y) + (v.z * v.z + v.w * v.w); sb[j] = (w.x * w.x + w.y * w.y) + (w.z * w.z + w.w * w.w);
        u32x2 o; o.x = cvt_pk_bf16(v.x, v.y); o.y = cvt_pk_bf16(v.z, v.w); *((u32x2*)hA + lane + 64 * j) = o; o.x = cvt_pk_bf16(w.x, w.y); o.y = cvt_pk_bf16(w.z, w.w); *((u32x2*)hB + lane + 64 * j) = o;
        if (h8A) { *((unsigned*)h8A + lane + 64 * j) = pk4_fp8(v.x, v.y, v.z, v.w); *((unsigned*)h8B + lane + 64 * j) = pk4_fp8(w.x, w.y, w.z, w.w); } }
#pragma unroll
    for (int j = 0; j < 4; ++j) { sa[j] = wave_sum(sa[j]); sb[j] = wave_sum(sb[j]); }
    const float va = lane == 0 ? sa[0] : lane == 1 ? sa[1] : lane == 2 ? sa[2] : lane == 3 ? sa[3] : 0.f, vb = lane == 0 ? sb[0] : lane == 1 ? sb[1] : lane == 2 ? sb[2] : lane == 3 ? sb[3] : 0.f;
    if (lane < 16) { ssqA[lane] = va; ssqB[lane] = vb; }
}

__device__ __forceinline__ void cvt_p_bf16(const f32x4* src, u32x2* dst, int i0, int stride) {
    constexpr int N4 = M * PLE / 4; int i = i0;
    for (; i + 3 * stride < N4; i += 4 * stride) { f32x4 v[4];
#pragma unroll
        for (int k = 0; k < 4; ++k) v[k] = __builtin_nontemporal_load(src + i + k * stride);
#pragma unroll
        for (int k = 0; k < 4; ++k) { u32x2 o; o.x = cvt_pk_bf16(v[k].x, v[k].y); o.y = cvt_pk_bf16(v[k].z, v[k].w); dst[i + k * stride] = o; } }
    for (; i < N4; i += stride) { const f32x4 v = __builtin_nontemporal_load(src + i); u32x2 o; o.x = cvt_pk_bf16(v.x, v.y); o.y = cvt_pk_bf16(v.z, v.w); dst[i] = o; }
}

__device__ __forceinline__ int t5_bucket(int d) {
    if (d < 16) return d;
    return 16 + (d >= 19) + (d >= 21) + (d >= 24) + (d >= 27) + (d >= 31) + (d >= 35) + (d >= 40) + (d >= 46) + (d >= 52) + (d >= 59) + (d >= 67) + (d >= 77) + (d >= 87) + (d >= 99) + (d >= 113);
}
namespace attn {
typedef float f32x16 __attribute__((ext_vector_type(16)));
typedef short s16x4 __attribute__((ext_vector_type(4)));
constexpr int KIMG = 0, VIMG = 32768, RBT = 65536, LSCR = RBT + 3072, OST = RBT + 4096, LDS_BYTES = OST + 8 * 4096;
__device__ __forceinline__ int crow(int r, int hi) { return (r & 3) + 8 * (r >> 2) + 4 * hi; }
__device__ __forceinline__ s16x4 vtr(const LAS unsigned char* p) { return __builtin_bit_cast(s16x4, __builtin_amdgcn_ds_read_tr16_b64_v4i16((LAS s16x4*)p)); }
__device__ __forceinline__ void attn_phase(LAS unsigned char* lds, const bf16* U, bf16* YA, const float* sinks, const float* rel_bias, int G, int c, int wbase, int y8) {
    const int tid = opaque_tid(wbase), lane = tid & 63, wid = __builtin_amdgcn_readfirstlane(tid >> 6), r32 = lane & 31, hi = lane >> 5;
    const int g = wid >> 1, qh = wid & 1; G = opaque_s(G); c = opaque_s(c);
    LAS float* rbt = (LAS float*)(lds + RBT); LAS float* lscr = (LAS float*)(lds + LSCR) + wid * 32; LAS bf16* stg = (LAS bf16*)(lds + OST + wid * 4096);
    int kvh_tab = -1;
    for (int L = c; L < BATCH * 32 * 4; L += G) {
        const int kvh = L & 3, n = (L >> 2) & 31, b = L >> 7;
        const int tok0 = b * SEQ + (n - 1) * 128;
        if (kvh != kvh_tab) { kvh_tab = kvh;
            for (int e = tid; e < 4 * 192; e += 512) { const int gg = e / 192, jj = e % 192, dist = 159 - jj;
                rbt[e] = (dist >= 0 && dist < 128) ? rel_bias[t5_bucket(dist) * 16 + kvh * 4 + gg] * LOG2E : -1.0e30f; } }
#pragma unroll
        for (int kg = 0; kg < 4; ++kg) { const int key = 64 * kg + lane; int t = tok0 + key; if (t < b * SEQ) t = b * SEQ;
            __builtin_amdgcn_global_load_lds((const unsigned*)(U + (size_t)t * NIN + C_K + kvh * 64 + 8 * wid), (LAS unsigned*)(lds + KIMG + wid * 4096 + kg * 1024), 16, 0, 0); }
#pragma unroll
        for (int j = 0; j < 4; ++j) { const int kg16 = 4 * (wid & 3) + j, key = 16 * kg16 + (lane >> 2); int t = tok0 + key; if (t < b * SEQ) t = b * SEQ;
            __builtin_amdgcn_global_load_lds((const unsigned*)(U + (size_t)t * NIN + C_V + kvh * 64 + 32 * (wid >> 2) + 8 * (lane & 3)), (LAS unsigned*)(lds + VIMG + (wid >> 2) * 16384 + kg16 * 1024), 16, 0, 0); }
        const size_t mq0 = (size_t)b * SEQ + n * 128 + 64 * qh;
        bf16x8 qf[2][4];
#pragma unroll
        for (int qt = 0; qt < 2; ++qt)
#pragma unroll
            for (int d0 = 0; d0 < 4; ++d0) qf[qt][d0] = *(const bf16x8*)(U + (mq0 + 32 * qt + r32) * NIN + (kvh * 4 + g) * 64 + 16 * d0 + 8 * hi);
        asm volatile("s_waitcnt vmcnt(0)" ::: "memory"); __syncthreads();
        const float sink2 = sinks[kvh * 4 + g] * LOG2E; const LAS float* bt = rbt + g * 192 + 31 - r32 + 4 * hi;
#pragma unroll
        for (int qt = 0; qt < 2; ++qt) {
            const int iq0 = 64 * qh + 32 * qt, kt0 = iq0 >> 5; const size_t mq = mq0 + 32 * qt;
            f32x16 p[5];
#pragma unroll
            for (int jt = 0; jt < 5; ++jt) { f32x16 a = {};
#pragma unroll
                for (int d0 = 0; d0 < 4; ++d0) { const bf16x8 kf = *(const LAS bf16x8*)(lds + KIMG + (2 * d0 + hi) * 4096 + (32 * (kt0 + jt) + r32) * 16); a = __builtin_amdgcn_mfma_f32_32x32x16_bf16(kf, qf[qt][d0], a, 0, 0, 0); }
                p[jt] = a; }
            float mx = sink2;
#pragma unroll
            for (int jt = 0; jt < 5; ++jt)
#pragma unroll
                for (int r = 0; r < 16; ++r) { float s = p[jt][r] + bt[32 * jt + (r & 3) + 8 * (r >> 2)];
                    if (n == 0) { if (32 * (kt0 + jt) + crow(r, hi) < 128) s = -1.0e30f; }
                    p[jt][r] = s; mx = fmaxf(mx, s); }
            mx = max_x32(mx);
            float l = 0.f;
#pragma unroll
            for (int jt = 0; jt < 5; ++jt)
#pragma unroll
                for (int r = 0; r < 16; ++r) { const float e = __builtin_amdgcn_exp2f(p[jt][r] - mx); p[jt][r] = e; l += e; }
            l = sum_x32(l); l += __builtin_amdgcn_exp2f(sink2 - mx);
            f32x16 o[2]; o[0] = (f32x16){}; o[1] = (f32x16){};
            const LAS unsigned char* vb = lds + VIMG + ((lane >> 4) & 1) * 32 + (lane & 3) * 8 + (4 * hi + ((lane & 15) >> 2)) * 64;
#pragma unroll
            for (int jt = 0; jt < 5; ++jt)
#pragma unroll
                for (int s = 0; s < 2; ++s) { u32x4 w; w.x = cvt_pk_bf16(p[jt][8 * s], p[jt][8 * s + 1]); w.y = cvt_pk_bf16(p[jt][8 * s + 2], p[jt][8 * s + 3]); w.z = cvt_pk_bf16(p[jt][8 * s + 4], p[jt][8 * s + 5]); w.w = cvt_pk_bf16(p[jt][8 * s + 6], p[jt][8 * s + 7]);
                    const bf16x8 pa = __builtin_bit_cast(bf16x8, w);
#pragma unroll
                    for (int d0 = 0; d0 < 2; ++d0) { const LAS unsigned char* vp = vb + d0 * 16384 + (32 * (kt0 + jt) + 16 * s) * 64; const s16x4 lo = vtr(vp), hv = vtr(vp + 8 * 64);
                        const bf16x8 vf = (bf16x8){lo[0], lo[1], lo[2], lo[3], hv[0], hv[1], hv[2], hv[3]};
                        o[d0] = __builtin_amdgcn_mfma_f32_32x32x16_bf16(pa, vf, o[d0], 0, 0, 0); } }
            if (hi == 0) lscr[r32] = l;
            asm volatile("s_waitcnt lgkmcnt(0)" ::: "memory");
#pragma unroll
            for (int r = 0; r < 16; r += 2) { const int qi = crow(r, hi); const float rl0 = __builtin_amdgcn_rcpf(lscr[qi]), rl1 = __builtin_amdgcn_rcpf(lscr[qi + 1]);
                const unsigned w0 = cvt_pk_bf16(o[0][r] * rl0, o[0][r + 1] * rl1), w1 = cvt_pk_bf16(o[1][r] * rl0, o[1][r + 1] * rl1);
                stg[qi * 64 + r32] = (bf16)(w0 & 0xffffu); stg[(qi + 1) * 64 + r32] = (bf16)(w0 >> 16); stg[qi * 64 + 32 + r32] = (bf16)(w1 & 0xffffu); stg[(qi + 1) * 64 + 32 + r32] = (bf16)(w1 >> 16); }
            asm volatile("s_waitcnt lgkmcnt(0)" ::: "memory");
#pragma unroll
            for (int i = 0; i < 4; ++i) { const int row = 8 * i + (lane >> 3), chn = lane & 7;
                const u32x4 sv = *(const LAS u32x4*)(stg + row * 64 + 8 * chn);
                if (y8) { f32x4 a0, a1; pg8::unpack8(sv, a0, a1); a0 = a0 * Y8_SCALE; a1 = a1 * Y8_SCALE; u32x2 w8; w8.x = pk4_fp8(a0[0], a0[1], a0[2], a0[3]); w8.y = pk4_fp8(a1[0], a1[1], a1[2], a1[3]);
                    *(u32x2*)((unsigned char*)YA + (mq + row) * DM + (kvh * 4 + g) * 64 + 8 * chn) = w8; }
                else *(u32x4*)(YA + (mq + row) * DM + (kvh * 4 + g) * 64 + 8 * chn) = sv; }
            asm volatile("s_waitcnt lgkmcnt(0)" ::: "memory");
        }
        __syncthreads();
    }
}
}

namespace lru {
typedef float f32x16 __attribute__((ext_vector_type(16)));
constexpr int TC = 128, NCK = SEQ / TC, NUNIT = BATCH * 16 * NCK, CW_BYTES = 5 * 64 * 4, ST_BYTES = 2 * 32 * 128, WAVE_LDS = ST_BYTES + CW_BYTES + 256, WL_OFF = 8 * WAVE_LDS, WL_ROW = 144;
__device__ __forceinline__ int crow(int r, int hi) { return (r & 3) + 8 * (r >> 2) + 4 * hi; }
__device__ __forceinline__ void lru_scan(LAS unsigned char* lds, const bf16* U, bf16* HR, bf16* PQ, float* AGG, const bf16* Wt, const float* conv_w, const float* conv_b,
                                         const float* b_rg, const float* b_ig, const float* lam, int G, int c, int wbase) {
    const int tid = opaque_tid(wbase), lane = tid & 63, wid = __builtin_amdgcn_readfirstlane(tid >> 6), r32 = lane & 31, hi = lane >> 5; G = opaque_s(G); c = opaque_s(c);
    LAS unsigned char* wl = lds + wid * WAVE_LDS; LAS bf16* stH = (LAS bf16*)wl; LAS bf16* stP = (LAS bf16*)(wl + 32 * 128);
    LAS float* cw = (LAS float*)(wl + ST_BYTES);
    int nb_l = -1;
    for (int un = c * 8 + wid; un < NUNIT; un += G * 8) {
        const int ck = un & (NCK - 1), nb = (un >> 5) & 15, b = un >> 9, ch0 = nb * 64;
        if (nb != nb_l) {
            __syncthreads();
#pragma unroll
            for (int j = 0; j < 2; ++j) { const int p = tid + 512 * j, row = p >> 3, seg = p & 7;
                *(LAS u32x4*)(lds + WL_OFF + row * WL_ROW + seg * 16) = *(const u32x4*)(Wt + (size_t)(row >> 6) * 16 * 64 * 64 + (size_t)(nb * 64 + (row & 63)) * 64 + seg * 8); }
            __syncthreads(); nb_l = nb; }
#pragma unroll
        for (int j = 0; j < 4; ++j) cw[j * 64 + lane] = conv_w[j * DM + ch0 + lane];
        cw[4 * 64 + lane] = conv_b[ch0 + lane];
        float brg[2], big[2], sp8[2], carry[2], prodA[2];
#pragma unroll
        for (int ct = 0; ct < 2; ++ct) { const int ch = ch0 + 32 * ct + r32; brg[ct] = b_rg[ch] * -LOG2E; big[ct] = b_ig[ch] * -LOG2E; { const float x = fast_exp(-lam[ch]); sp8[ct] = (-8.f * LOG2E) * (x < 0.25f ? x * (1.f - x * (0.5f - x * ((1.f / 3.f) - x * (0.25f - x * (0.2f - x * (1.f / 6.f)))))) : (__builtin_amdgcn_logf(1.f + x) * 0.6931471805599453f)); } carry[ct] = 0.f; prodA[ct] = 1.f; }
        asm volatile("s_waitcnt lgkmcnt(0)" ::: "memory");
        u32x4 raw[4][4];
#define LRU_LOAD_RAW(st_) do { const int t_ = ck * TC + (st_) * 32 + r32; const size_t m_ = (size_t)b * SEQ + t_; _Pragma("unroll") for (int ks = 0; ks < 4; ++ks) _Pragma("unroll") for (int j = 0; j < 4; ++j) { \
            const int back_ = 3 - j; const size_t mm_ = (t_ >= back_) ? m_ - back_ : m_; raw[ks][j] = *(const u32x4*)(U + mm_ * NIN + C_LX + ch0 + 16 * ks + 8 * hi); } } while (0)
        LRU_LOAD_RAW(0);
        for (int st = 0; st < 4; ++st) {
            const int t0 = ck * TC + st * 32, t = t0 + r32;
            bf16x8 af[4];
#pragma unroll
            for (int ks = 0; ks < 4; ++ks) { const int cl = 16 * ks + 8 * hi; f32x4 x0 = *(const LAS f32x4*)(cw + 256 + cl), x1 = *(const LAS f32x4*)(cw + 256 + cl + 4);
#pragma unroll
                for (int j = 0; j < 4; ++j) { const int back = 3 - j; const bool ok = t >= back;
                    f32x4 v0, v1; pg8::unpack8(raw[ks][j], v0, v1);
                    const f32x4 w0 = *(const LAS f32x4*)(cw + j * 64 + cl), w1 = *(const LAS f32x4*)(cw + j * 64 + cl + 4);
                    if (ok) { x0 = x0 + w0 * v0; x1 = x1 + w1 * v1; } }
                af[ks] = __builtin_bit_cast(bf16x8, pg8::pack8(x0, x1)); }
            if (st < 3) LRU_LOAD_RAW(st + 1);
#pragma unroll
            for (int ct = 0; ct < 2; ++ct) {
                f32x16 R = {}, I = {}, X = {};
                int zoff; asm volatile("v_mov_b32 %0, 0" : "=v"(zoff)); const LAS unsigned char* Wp = lds + WL_OFF + zoff;
                bf16x8 wr[4], wi[4];
#pragma unroll
                for (int ks = 0; ks < 4; ++ks) { const int o = (32 * ct + r32) * WL_ROW + (16 * ks + 8 * hi) * 2; wr[ks] = *(const LAS bf16x8*)(Wp + o); wi[ks] = *(const LAS bf16x8*)(Wp + 64 * WL_ROW + o); }
#pragma unroll
                for (int ks = 0; ks < 4; ++ks) { bf16x8 idf;
#pragma unroll
                    for (int j = 0; j < 8; ++j) idf[j] = (16 * ks + 8 * hi + j == 32 * ct + r32) ? (short)0x3F80 : (short)0;
                    R = __builtin_amdgcn_mfma_f32_32x32x16_bf16(af[ks], wr[ks], R, 0, 0, 0); I = __builtin_amdgcn_mfma_f32_32x32x16_bf16(af[ks], wi[ks], I, 0, 0, 0);
                    X = __builtin_amdgcn_mfma_f32_32x32x16_bf16(af[ks], idf, X, 0, 0, 0); }
                float P[16], H[16];
#pragma unroll
                for (int r = 0; r < 16; ++r) { const float er = __builtin_amdgcn_exp2f(R[r] * -LOG2E + brg[ct]), ei = __builtin_amdgcn_exp2f(I[r] * -LOG2E + big[ct]);
                    const float e1 = 1.f + er, e2 = 1.f + ei, qq = __builtin_amdgcn_rcpf(e1 * e2), rr = qq * e2, ii = qq * e1;
                    const float a = __builtin_amdgcn_exp2f(rr * sp8[ct]);
                    P[r] = a; H[r] = __builtin_amdgcn_sqrtf(fmaxf(1.f - a * a, 0.f)) * (ii * X[r]); }
                float Ag[4], Hg[4], Ao[4], Ho[4];
#pragma unroll
                for (int g4 = 0; g4 < 4; ++g4) {
#pragma unroll
                    for (int j = 1; j < 4; ++j) { H[4 * g4 + j] = P[4 * g4 + j] * H[4 * g4 + j - 1] + H[4 * g4 + j]; P[4 * g4 + j] = P[4 * g4 + j] * P[4 * g4 + j - 1]; }
                    Ag[g4] = P[4 * g4 + 3]; Hg[g4] = H[4 * g4 + 3]; Ao[g4] = get_x32(Ag[g4], hi); Ho[g4] = get_x32(Hg[g4], hi); }
                float C = carry[ct], PC = prodA[ct], Cm[4], Pm[4];
#pragma unroll
                for (int g4 = 0; g4 < 4; ++g4) { const float A0 = hi ? Ao[g4] : Ag[g4], H0 = hi ? Ho[g4] : Hg[g4], A1 = hi ? Ag[g4] : Ao[g4], H1 = hi ? Hg[g4] : Ho[g4];
                    const float C1 = A0 * C + H0, P1 = PC * A0; Cm[g4] = hi ? C1 : C; Pm[g4] = hi ? P1 : PC; C = A1 * C1 + H1; PC = P1 * A1; }
                carry[ct] = C; prodA[ct] = PC;
#pragma unroll
                for (int r = 0; r < 16; r += 2) { const int o = crow(r, hi) * 64 + 32 * ct + r32;
                    const unsigned wh = cvt_pk_bf16(H[r] + P[r] * Cm[r >> 2], H[r + 1] + P[r + 1] * Cm[r >> 2]), wp = cvt_pk_bf16(P[r] * Pm[r >> 2], P[r + 1] * Pm[r >> 2]);
                    stH[o] = (bf16)(wh & 0xffffu); stH[o + 64] = (bf16)(wh >> 16); stP[o] = (bf16)(wp & 0xffffu); stP[o + 64] = (bf16)(wp >> 16); }
            }
            asm volatile("s_waitcnt lgkmcnt(0)" ::: "memory");
#pragma unroll
            for (int i = 0; i < 4; ++i) { const int row = (lane >> 3) + 8 * i, chn = lane & 7; const size_t go = ((size_t)b * SEQ + t0 + row) * DM + ch0 + 8 * chn;
                *(u32x4*)(HR + go) = *(const LAS u32x4*)(stH + row * 64 + 8 * chn); *(u32x4*)(PQ + go) = *(const LAS u32x4*)(stP + row * 64 + 8 * chn); }
            asm volatile("s_waitcnt lgkmcnt(0)" ::: "memory");
        }
        if (hi == 0) {
#pragma unroll
            for (int ct = 0; ct < 2; ++ct) *(f32x2*)(AGG + ((size_t)(b * NCK + ck) * DM + ch0 + 32 * ct + r32) * 2) = (f32x2){prodA[ct], carry[ct]};
        }
    }
}
#undef LRU_LOAD_RAW
template <bool F8> __device__ __forceinline__ void lru_apply(const bf16* U, const bf16* HR, const bf16* PQ, const float* AGG, bf16* YB, int G, int c, int wbase) {
    const int tid = opaque_tid(wbase); G = opaque_s(G); c = opaque_s(c); const int ch = 8 * (tid & 127), tq = tid >> 7;
    for (int cu = c; cu < BATCH * NCK; cu += G) { const int b = cu / NCK, ck = cu % NCK;
        f32x4 c0 = {}, c1 = {};
        int j = 0;
        for (; j + 8 <= ck; j += 8) { f32x4 p[8][4];
#pragma unroll
            for (int k = 0; k < 8; ++k) { const f32x4* ap = (const f32x4*)(AGG + ((size_t)(b * NCK + j + k) * DM + ch) * 2); p[k][0] = ap[0]; p[k][1] = ap[1]; p[k][2] = ap[2]; p[k][3] = ap[3]; }
#pragma unroll
            for (int k = 0; k < 8; ++k) { c0 = (f32x4){p[k][0].x * c0.x + p[k][0].y, p[k][0].z * c0.y + p[k][0].w, p[k][1].x * c0.z + p[k][1].y, p[k][1].z * c0.w + p[k][1].w};
                                          c1 = (f32x4){p[k][2].x * c1.x + p[k][2].y, p[k][2].z * c1.y + p[k][2].w, p[k][3].x * c1.z + p[k][3].y, p[k][3].z * c1.w + p[k][3].w}; } }
        for (; j < ck; ++j) { const f32x4* ap = (const f32x4*)(AGG + ((size_t)(b * NCK + j) * DM + ch) * 2); const f32x4 p0 = ap[0], p1 = ap[1], p2 = ap[2], p3 = ap[3];
            c0 = (f32x4){p0.x * c0.x + p0.y, p0.z * c0.y + p0.w, p1.x * c0.z + p1.y, p1.z * c0.w + p1.w}; c1 = (f32x4){p2.x * c1.x + p2.y, p2.z * c1.y + p2.w, p3.x * c1.z + p3.y, p3.z * c1.w + p3.w}; }
        for (int i = 0; i < 32; i += 4) { u32x4 hv[4], qv[4], gv[4];
#pragma unroll
            for (int k = 0; k < 4; ++k) { const size_t m = (size_t)b * SEQ + ck * TC + tq + 4 * (i + k); hv[k] = *(const u32x4*)(HR + m * DM + ch); qv[k] = *(const u32x4*)(PQ + m * DM + ch); gv[k] = *(const u32x4*)(U + m * NIN + C_LG + ch); }
#pragma unroll
            for (int k = 0; k < 4; ++k) { const size_t m = (size_t)b * SEQ + ck * TC + tq + 4 * (i + k); f32x4 h0, h1, q0, q1, g0, g1; pg8::unpack8(hv[k], h0, h1); pg8::unpack8(qv[k], q0, q1); pg8::unpack8(gv[k], g0, g1);
                if (F8) { const f32x4 y0 = (h0 + q0 * c0) * g0 * Y8_SCALE, y1 = (h1 + q1 * c1) * g1 * Y8_SCALE; u32x2 w8; w8.x = pk4_fp8(y0[0], y0[1], y0[2], y0[3]); w8.y = pk4_fp8(y1[0], y1[1], y1[2], y1[3]);
                    *(u32x2*)((unsigned char*)YB + m * DM + ch) = w8; }
                else *(u32x4*)(YB + m * DM + ch) = pg8::pack8((h0 + q0 * c0) * g0, (h1 + q1 * c1) * g1); } }
    }
}
}

namespace moe {
constexpr int NCHUNK = M / 128;
__device__ __forceinline__ void route_a(LAS unsigned char* lds, const bf16* h, const float* ssq, const float* gain, const float* rw, const float* rb, int* sel, float* selw, int* CNT, int G, int c, int wbase) {
    const int tid = opaque_tid(wbase), lane = tid & 63, wid = __builtin_amdgcn_readfirstlane(tid >> 6); LAS int* lc = (LAS int*)lds; G = opaque_s(G); c = opaque_s(c);
    f32x4 wg[4][4][2];
#pragma unroll
    for (int j = 0; j < 4; ++j) { const f32x4 gk = *(const f32x4*)(gain + 4 * lane + 256 * j);
#pragma unroll
        for (int q = 0; q < 4; ++q) { const float* wp = rw + (size_t)(4 * lane + 256 * j + q) * 8; wg[j][q][0] = *(const f32x4*)wp * gk[q]; wg[j][q][1] = *(const f32x4*)(wp + 4) * gk[q]; } }
    float rbv[8];
#pragma unroll
    for (int e = 0; e < 8; ++e) rbv[e] = rb[e];
    for (int chunk = c; chunk < NCHUNK; chunk += G) {
        if (tid < 8) lc[tid] = 0;
        __syncthreads();
        for (int i0 = 0; i0 < 16; i0 += 2) {
            u32x2 hx[2][4]; f32x4 sq[2];
#pragma unroll
            for (int u = 0; u < 2; ++u) { const int m = chunk * 128 + wid * 16 + i0 + u; const u32x2* hp = (const u32x2*)(h + (size_t)m * DM) + lane;
#pragma unroll
                for (int j = 0; j < 4; ++j) hx[u][j] = hp[64 * j];
                sq[u] = *(const f32x4*)(ssq + 16 * (size_t)m + 4 * (lane & 3)); }
#pragma unroll
            for (int u = 0; u < 2; ++u) { const int m = chunk * 128 + wid * 16 + i0 + u; f32x4 a0 = {}, a1 = {};
#pragma unroll
                for (int j = 0; j < 4; ++j) { const f32x4 x = unpack_lo(hx[u][j]);
#pragma unroll
                    for (int q = 0; q < 4; ++q) { a0 = a0 + wg[j][q][0] * x[q]; a1 = a1 + wg[j][q][1] * x[q]; } }
                float s = (sq[u].x + sq[u].y) + (sq[u].z + sq[u].w); s += swz_f<1>(s); s += swz_f<2>(s);
                const float rs = __builtin_amdgcn_rsqf(s * (1.f / 1024.f) + EPS); float acc[8] = {a0.x, a0.y, a0.z, a0.w, a1.x, a1.y, a1.z, a1.w};
#pragma unroll
                for (int e = 0; e < 8; ++e) acc[e] = wave_sum(acc[e]) * rs + rbv[e];
                int i1 = 0; float v1 = acc[0];
#pragma unroll
                for (int e = 1; e < 8; ++e) if (acc[e] > v1) { v1 = acc[e]; i1 = e; }
                int i2 = -1; float v2 = -3.0e38f;
#pragma unroll
                for (int e = 0; e < 8; ++e) if (e != i1 && acc[e] > v2) { v2 = acc[e]; i2 = e; }
                const float ex = fast_exp(v2 - v1), w1 = 1.f / (1.f + ex), w2 = ex / (1.f + ex);
                if (lane == 0) { sel[2 * m] = i1; sel[2 * m + 1] = i2; selw[2 * m] = w1; selw[2 * m + 1] = w2; atomicAdd((int*)(lc + i1), 1); atomicAdd((int*)(lc + i2), 1); }
            }
        }
        __syncthreads();
        if (tid < 8) CNT[chunk * 8 + tid] = lc[tid];
        __syncthreads();
    }
}
__device__ __forceinline__ void route_b(LAS unsigned char* lds, const int* sel, const float* selw, const float* ssq, const int* CNT, const bf16* hb, int* tok, float* srs, float* sgw, int* tslot, int* meta, bf16* XG, int G, int c, int wbase) {
    const int tid = opaque_tid(wbase), lane = tid & 63, wid = __builtin_amdgcn_readfirstlane(tid >> 6); G = opaque_s(G); c = opaque_s(c);
    LAS int* tot = (LAS int*)lds; LAS int* pre = tot + 8; LAS int* start = tot + 16; LAS int* pos = tot + 32; LAS float* rsl = (LAS float*)(tot + 32 + 256);
    for (int chunk = c; chunk < NCHUNK; chunk += G) {
        { int t = 0, p = 0;
#pragma unroll
          for (int j = 0; j < NCHUNK / 64; ++j) { const int ch = lane + 64 * j; const int v = CNT[ch * 8 + wid]; t += v; p += (ch < chunk) ? v : 0; }
          t += swz_i<1>(t); t += swz_i<2>(t); t += swz_i<4>(t); t += swz_i<8>(t); t += swz_i<16>(t); t = sum_x32i(t);
          p += swz_i<1>(p); p += swz_i<2>(p); p += swz_i<4>(p); p += swz_i<8>(p); p += swz_i<16>(p); p = sum_x32i(p);
          if (lane == 0) { tot[wid] = t; pre[wid] = p; } }
        __syncthreads();
        if (tid == 0) { int s = 0; for (int e = 0; e < 8; ++e) { start[e] = s; s += ((tot[e] + 255) >> 8) << 8; } start[8] = s; }
        __syncthreads();
        if (chunk == 0 && tid < 9) meta[tid] = start[tid] >> 8;
        if (wid == 0) {
            int run[8];
#pragma unroll
            for (int e = 0; e < 8; ++e) run[e] = start[e] + pre[e];
#pragma unroll
            for (int hf = 0; hf < 2; ++hf)
#pragma unroll
                for (int k = 0; k < 2; ++k) { const int m = chunk * 128 + hf * 64 + lane; const int e = sel[2 * m + k]; int p = 0;
#pragma unroll
                    for (int ee = 0; ee < 8; ++ee) { const unsigned long long mask = __ballot(e == ee); if (e == ee) p = run[ee] + __popcll(mask & ((1ull << lane) - 1ull)); run[ee] += __popcll(mask); }
                    const float rsm = rstd_of(ssq, m); tok[p] = m; srs[p] = rsm; sgw[p] = selw[2 * m + k]; tslot[2 * m + k] = p; pos[(hf * 2 + k) * 64 + lane] = p; rsl[(hf * 2 + k) * 64 + lane] = rsm; }
        }
        __syncthreads();
        for (int q0 = wid * 32; q0 < wid * 32 + 32; q0 += 4) {
            u32x4 r0[4], r1[4]; int pp[4]; float rr[4];
#pragma unroll
            for (int u = 0; u < 4; ++u) { const int q = q0 + u, m = chunk * 128 + (q >> 7) * 64 + (q & 63); pp[u] = pos[q]; rr[u] = rsl[q];
                if (MOE_FP8) { const u32x4* src = (const u32x4*)(hb + (size_t)m * DM) + 2 * lane; r0[u] = src[0]; r1[u] = src[1]; }
                else { const u32x4* src = (const u32x4*)(hb + (size_t)m * DM); r0[u] = src[lane]; r1[u] = src[lane + 64]; } }
#pragma unroll
            for (int u = 0; u < 4; ++u) {
                if (MOE_FP8) { const float rs = rr[u]; f32x4 a0, a1, b0, b1; pg8::unpack8(r0[u], a0, a1); pg8::unpack8(r1[u], b0, b1);
                    u32x4 o; o.x = pk4_fp8(a0.x * rs, a0.y * rs, a0.z * rs, a0.w * rs); o.y = pk4_fp8(a1.x * rs, a1.y * rs, a1.z * rs, a1.w * rs); o.z = pk4_fp8(b0.x * rs, b0.y * rs, b0.z * rs, b0.w * rs); o.w = pk4_fp8(b1.x * rs, b1.y * rs, b1.z * rs, b1.w * rs);
                    *((u32x4*)((unsigned char*)XG + (size_t)pp[u] * DM) + lane) = o; }
                else { u32x4* dst = (u32x4*)(XG + (size_t)pp[u] * DM); dst[lane] = r0[u]; dst[lane + 64] = r1[u]; } } }
        if (chunk == 0) {
            for (int e = 0; e < 8; ++e) { const int s0 = start[e] + tot[e], s1 = start[e + 1];
                for (int s = s0 + tid; s < s1; s += 512) { tok[s] = 0; srs[s] = 0.f; sgw[s] = 0.f; }
                unsigned z0; asm volatile("v_mov_b32 %0, 0" : "=v"(z0)); const u32x4 zz = (u32x4){z0, z0, z0, z0};
                for (int s = s0 + wid; s < s1; s += 8) { if (MOE_FP8) *((u32x4*)((unsigned char*)XG + (size_t)s * DM) + lane) = zz;
                    else { u32x4* dst = (u32x4*)(XG + (size_t)s * DM); dst[lane] = zz; dst[lane + 64] = zz; } } }
        }
        __syncthreads();
    }
}
}

#define XB_TMO      128
#define XB_XCNT(j)  (256  + 64 * (j))
#define XB_XSUB(j)  (1280 + 64 * (j))
#define XB_XGEN(j)  (2304 + 64 * (j))
#define XB_TOP      3328
#define XB_TOPGEN   3392
#define XCD_BAR_WORDS 3456
#define XB_SPIN_CAP (1u << 18)
__device__ __forceinline__ unsigned xb_ld(unsigned* p)              { return __hip_atomic_load(p, __ATOMIC_RELAXED, __HIP_MEMORY_SCOPE_AGENT); }
__device__ __forceinline__ unsigned xb_add(unsigned* p, unsigned v) { return __hip_atomic_fetch_add(p, v, __ATOMIC_RELAXED, __HIP_MEMORY_SCOPE_AGENT); }
__device__ __forceinline__ unsigned xb_xcc_id() { return (unsigned)__builtin_amdgcn_s_getreg((3 << 11) | 20) & 0xFu; }
#define XB_SPIN(cond, bar) do { unsigned _sp = 0; while (cond) { __builtin_amdgcn_s_sleep(1); \
    if ((++_sp & 255u) == 0u) { if (xb_ld(&(bar)[XB_TMO])) break; if (_sp > XB_SPIN_CAP) { atomicAdd(&(bar)[XB_TMO], 1u); break; } } } } while (0)
struct XcdBarrier { unsigned* bar; unsigned x; volatile LAS unsigned* st; };
__device__ __forceinline__ XcdBarrier xcd_barrier_post(unsigned* bar, volatile LAS unsigned* st) {
    XcdBarrier b; b.bar = bar; b.x = xb_xcc_id(); b.st = st;
    if (threadIdx.x == 0) (void)xb_add(&bar[XB_XCNT(b.x)], 1u);
    return b;
}
__device__ __forceinline__ void xcd_barrier_complete(unsigned* bar, unsigned x, unsigned& nloc, unsigned& nx) {
    const unsigned G = gridDim.x * gridDim.y * gridDim.z;
    unsigned sum, cnt, mine, sp = 0u;
    for (;;) {
        sum = 0u; cnt = 0u; mine = 0u;
#pragma unroll
        for (unsigned j = 0; j < 16; ++j) { const unsigned c = xb_ld(&bar[XB_XCNT(j)]); sum += c; cnt += (c > 0u) ? 1u : 0u; mine = (j == x) ? c : mine; }
        if (sum == G) break;
        __builtin_amdgcn_s_sleep(1);
        if ((++sp & 255u) == 0u) { if (xb_ld(&bar[XB_TMO])) break; if (sp > XB_SPIN_CAP) { atomicAdd(&bar[XB_TMO], 1u); break; } }
    }
    nloc = mine > 0u ? mine : 1u; nx = cnt > 0u ? cnt : 1u;
}
__device__ __forceinline__ void xcd_barrier(const XcdBarrier& b, bool leader) {
    asm volatile("s_waitcnt vmcnt(0)" ::: "memory");
    __syncthreads();
    if (leader) {
        unsigned zo_; asm volatile("v_mov_b32 %0, 0" : "=v"(zo_)); unsigned* bar = b.bar + zo_;
        __builtin_amdgcn_s_waitcnt(0);
        unsigned nloc = b.st[0], nx = b.st[1];
        if (nloc == 0u) { xcd_barrier_complete(bar, b.x, nloc, nx); b.st[0] = nloc; b.st[1] = nx; }
        const unsigned old = xb_add(&bar[XB_XSUB(b.x)], 1u);
        const unsigned gen = old / nloc;
        if (old + 1u == (gen + 1u) * nloc) {
            __builtin_amdgcn_fence(__ATOMIC_RELEASE, "agent");
            asm volatile("s_waitcnt vmcnt(0)" ::: "memory");
            const unsigned og = xb_add(&bar[XB_TOP], 1u);
            const unsigned tg = og / nx;
            if (og + 1u == (tg + 1u) * nx) xb_add(&bar[XB_TOPGEN], 1u);
            else XB_SPIN(xb_ld(&bar[XB_TOPGEN]) == tg, bar);
            __builtin_amdgcn_fence(__ATOMIC_ACQUIRE, "agent");
            xb_add(&bar[XB_XGEN(b.x)], 1u);
            asm volatile("s_waitcnt vmcnt(0)" ::: "memory");
        } else {
            XB_SPIN(xb_ld(&bar[XB_XGEN(b.x)]) == gen, bar);
            __builtin_amdgcn_fence(__ATOMIC_ACQUIRE, "agent");
            asm volatile("s_waitcnt vmcnt(0)" ::: "memory");
        }
    }
    __syncthreads();
}

constexpr int MEGA_LDS = 147456, LDSCTL_OFF = 131072;
constexpr int CW_BAR = 4096;
constexpr size_t CTL_ZERO_BYTES = 65536;

__device__ __forceinline__ KP kargs() { KP pp = (KP)__builtin_amdgcn_kernarg_segment_ptr(); asm volatile("" : "+s"(pp)); return pp; }
#define KIN(i) (kargs()->in[i])
#define KWS (kargs()->ws)
#define KOUT (kargs()->out)
#ifndef DUP_ID
#define DUP_ID 0
#define DUP_N 1
#endif
#define REP(id) for (int rep_ = 0; rep_ < ((DUP_ID == (id)) ? DUP_N : 1); ++rep_)
__global__ void __launch_bounds__(512, 2) mega(Ptrs Pdummy) {
    extern __shared__ __attribute__((aligned(16))) unsigned char lds_raw[];
    LAS unsigned char* lds = (LAS unsigned char*)lds_raw;
    const int G = (int)gridDim.x, c = (int)blockIdx.x, wbase = __builtin_amdgcn_readfirstlane((int)threadIdx.x) & ~63;
    { volatile LAS unsigned* MISC0 = (volatile LAS unsigned*)(lds + LDSCTL_OFF); if (threadIdx.x < 64) MISC0[threadIdx.x] = 0u; }
    __syncthreads();
    (void)xcd_barrier_post((unsigned*)(KWS + WS_CTL) + CW_BAR, (volatile LAS unsigned*)(lds + LDSCTL_OFF) + 8);
#define GRID_BAR() do { XcdBarrier b_; b_.bar = (unsigned*)(KWS + WS_CTL) + CW_BAR; b_.x = xb_xcc_id(); b_.st = (volatile LAS unsigned*)(lds + LDSCTL_OFF) + 8; xcd_barrier(b_, opaque_tid(wbase) == 0); } while (0)
#define HBUF(k) ((bf16*)(ws + ((k) ? WS_HB2 : WS_HB)))
#define SBUF(k) ((float*)(ws + WS_SSQ) + ((k) ? (size_t)16 * M : (size_t)0))
#define WAVE_IDS() const int tid = opaque_tid(wbase), lane = tid & 63, wid = __builtin_amdgcn_readfirstlane(tid >> 6), gw = c * 8 + wid, ngw = G * 8; (void)tid; (void)lane; (void)gw; (void)ngw

    REP(1) { WAVE_IDS(); const KP P = kargs(); unsigned char* ws = P->ws; LAS float* scr = (LAS float*)(lds + wid * 16384);
      { constexpr int NJ = 30 + 128 + (INPROJ_GATES_FP8 ? DEPTH : 0); LAS int* pref = (LAS int*)(lds + 9216);
        if (tid < NJ) { const CJob jb = static_job(P, tid); pref[512 + tid] = (jb.K / 64) * (jb.N / 32); }
        __syncthreads();
        if (tid == 0) { int s = 0; for (int j = 0; j < NJ; ++j) { pref[j] = s; s += pref[512 + j]; } pref[NJ] = s; }
        __syncthreads();
        conv_static_all(P, pref, NJ, scr, gw, ngw, lane); }
      if ((INPROJ_FP8 || INPROJ_GATES_FP8)) { for (int m = gw; m < M; m += ngw) rowstats_row<false>(P->in[0] + (size_t)m * DM, HBUF(0) + (size_t)m * DM, SBUF(0) + 16 * (size_t)m, nullptr, nullptr, lane, ws + WS_HB8 + (size_t)m * DM); }
      else for (int m = gw; m < M; m += 2 * ngw) { const int m2 = m + ngw;
          if (m2 >= M) { rowstats_row<false>(P->in[0] + (size_t)m * DM, HBUF(0) + (size_t)m * DM, SBUF(0) + 16 * (size_t)m, nullptr, nullptr, lane); break; }
          rowstats_x2(P->in[0] + (size_t)m * DM, HBUF(0) + (size_t)m * DM, SBUF(0) + 16 * (size_t)m, P->in[0] + (size_t)m2 * DM, HBUF(0) + (size_t)m2 * DM, SBUF(0) + 16 * (size_t)m2, lane); }
      bf16* PB = (bf16*)(ws + WS_PB);
      cvt_p_bf16((const f32x4*)P->in[1], (u32x2*)PB, c * 512 + tid, G * 512); }
    GRID_BAR();

    if (DUP_ID == 20) for (int rep_ = 0; rep_ < DUP_N; ++rep_) GRID_BAR();
    int hc = 0, sc = 0;
    for (int l = 0; l < DEPTH; ++l) {
        if ((INPROJ_FP8_MASK >> opaque_s(l)) & 1) {
          REP(2) { unsigned char* ws = KWS; pg8::Gemm g{(const bf16*)(ws + WS_HB8), (const bf16*)(ws + WS_WIN + (size_t)l * NIN * DM * 2), DM / 2, 0}; pg8::StaticOrder S; S.init(M, NIN, opaque_s(G), opaque_s(c));
            pg8::EpiInproj<false> E{(bf16*)(ws + WS_R + R_U), SBUF(sc), KIN(4) + l * 64, KIN(5) + l * 64, 0, 1.f / WIN_SCALE}; pg8::gemm_phase<pg8::EpiInproj<false>, pg8::StaticOrder, true, true, true>(lds, g, S, E, wbase); }
        } else
        REP(2) { unsigned char* ws = KWS; pg8::Gemm g{HBUF(hc), (const bf16*)(ws + WS_WIN + (size_t)l * NIN * DM * 2), DM, 0}; pg8::StaticOrder S; S.init(M, INPROJ_GATES_FP8 ? NIN_A : NIN, opaque_s(G), opaque_s(c));
          pg8::EpiInproj<false> E{(bf16*)(ws + WS_R + R_U), SBUF(sc), KIN(4) + l * 64, KIN(5) + l * 64, 0, 1.f}; pg8::gemm_phase<pg8::EpiInproj<false>, pg8::StaticOrder, true, true>(lds, g, S, E, wbase); }
        if (INPROJ_GATES_FP8) REP(2) { unsigned char* ws = KWS; pg8::Gemm g{(const bf16*)(ws + WS_HB8), (const bf16*)(ws + WS_WIN + (size_t)l * NIN * DM * 2 + (size_t)NIN_A * DM * 2), DM / 2, 0}; pg8::StaticOrder S; S.init(M, NIN_B, opaque_s(G), opaque_s(c));
          pg8::EpiInproj<true> E{(bf16*)(ws + WS_R + R_U), SBUF(sc), nullptr, nullptr, NIN_A / 256, 1.f / WIN_SCALE}; pg8::gemm_phase<pg8::EpiInproj<true>, pg8::StaticOrder, true, true, true>(lds, g, S, E, wbase); }
        REP(3) { unsigned char* ws = KWS; pg8::Gemm g{(const bf16*)(ws + WS_PB), (const bf16*)(ws + WS_WPP) + (size_t)l * DM * PLE, PLE, 0}; pg8::StaticOrder S; S.init(M, DM, opaque_s(G), opaque_s(c));
          pg8::EpiStore16 E{(bf16*)(ws + WS_PP), DM, 1.f}; pg8::gemm_phase<pg8::EpiStore16, pg8::StaticOrder, true, true>(lds, g, S, E, wbase); }
        GRID_BAR();
        const bool cf_ = (l & 1) && ((opaque_s(c) >> 3) & 1);
        if (cf_) { __syncthreads(); WAVE_IDS(); const KP P = kargs(); LAS float* scr = (LAS float*)(lds + wid * 16384); conv_moe_layer(P, l >> 1, scr, gw, ngw, lane); __syncthreads(); }
        REP(4) { unsigned char* ws = KWS; attn::attn_phase(lds, (const bf16*)(ws + WS_R + R_U), (bf16*)(ws + WS_R + R_YA), KIN(6) + l * 16, KIN(7), G, c, wbase, (MERGE_FP8_MASK >> opaque_s(l)) & 1); }
        REP(5) { unsigned char* ws = KWS; const bf16* Wt = (const bf16*)(ws + WS_LRUW) + (size_t)l * 2 * 16 * 64 * 64; __syncthreads();
          lru::lru_scan(lds, (const bf16*)(ws + WS_R + R_U), (bf16*)(ws + WS_R + R_HR), (bf16*)(ws + WS_R + R_PQ), (float*)(ws + WS_AGG), Wt, KIN(8) + l * 4 * DM, KIN(9) + l * DM, KIN(11) + l * DM, KIN(13) + l * DM, KIN(14) + l * DM, G, c, wbase); }
        if (l + 1 < DEPTH) REP(6) { unsigned char* ws = KWS; const f32x4* src = (const f32x4*)(KIN(1) + (size_t)(l + 1) * M * PLE); bf16* PB = (bf16*)(ws + WS_PB);
            cvt_p_bf16(src, (u32x2*)PB, opaque_s(c) * 512 + opaque_tid(wbase), G * 512); }
        if ((l & 1) && !cf_) REP(7) { __syncthreads(); WAVE_IDS(); const KP P = kargs(); LAS float* scr = (LAS float*)(lds + wid * 16384);
            conv_moe_layer(P, l >> 1, scr, gw, ngw, lane); }
        GRID_BAR();
        if ((MERGE_FP8_MASK >> opaque_s(l)) & 1) { unsigned char* ws = KWS; lru::lru_apply<true>((const bf16*)(ws + WS_R + R_U), (const bf16*)(ws + WS_R + R_HR), (const bf16*)(ws + WS_R + R_PQ), (const float*)(ws + WS_AGG), (bf16*)(ws + WS_R + R_YB), G, c, wbase); }
        else REP(8) { unsigned char* ws = KWS; lru::lru_apply<false>((const bf16*)(ws + WS_R + R_U), (const bf16*)(ws + WS_R + R_HR), (const bf16*)(ws + WS_R + R_PQ), (const float*)(ws + WS_AGG), (bf16*)(ws + WS_R + R_YB), G, c, wbase); }
        GRID_BAR();
        {
        if ((MERGE_FP8_MASK >> opaque_s(l)) & 1) {
          REP(9) { unsigned char* ws = KWS; pg8::Gemm g{(const bf16*)(ws + WS_R + R_YA), (const bf16*)(ws + WS_WPA) + (size_t)l * DM * DM, DM / 2, 0};
            pg8::MergeOrder S; S.A1 = (const bf16*)(ws + WS_R + R_YB); S.Bt1 = (const bf16*)(ws + WS_WPB) + (size_t)l * DM * DM; S.so.init(M, DM, opaque_s(G), opaque_s(c));
            pg8::EpiMerge<true> E{(bf16*)(ws + WS_R + R_MB), (const bf16*)(ws + WS_R + R_U), MB8_SCALE / (WIN_SCALE * Y8_SCALE), 0}; pg8::gemm_phase<pg8::EpiMerge<true>, pg8::MergeOrder, true, true, true>(lds, g, S, E, wbase); }
        } else if ((OUT_FP8_MASK & ~MERGE_FP8_MASK) != 0 && ((OUT_FP8_MASK >> opaque_s(l)) & 1)) { unsigned char* ws = KWS; pg8::Gemm g{(const bf16*)(ws + WS_R + R_YA), (const bf16*)(ws + WS_WPA) + (size_t)l * DM * DM, DM, 0};
          pg8::MergeOrder S; S.A1 = (const bf16*)(ws + WS_R + R_YB); S.Bt1 = (const bf16*)(ws + WS_WPB) + (size_t)l * DM * DM; S.so.init(M, DM, opaque_s(G), opaque_s(c));
          pg8::EpiMerge<true> E{(bf16*)(ws + WS_R + R_MB), (const bf16*)(ws + WS_R + R_U), MB8_SCALE, 0}; pg8::gemm_phase<pg8::EpiMerge<true>, pg8::MergeOrder, true, true>(lds, g, S, E, wbase); }
        else
        REP(9) { unsigned char* ws = KWS; pg8::Gemm g{(const bf16*)(ws + WS_R + R_YA), (const bf16*)(ws + WS_WPA) + (size_t)l * DM * DM, DM, 0};
          pg8::MergeOrder S; S.A1 = (const bf16*)(ws + WS_R + R_YB); S.Bt1 = (const bf16*)(ws + WS_WPB) + (size_t)l * DM * DM; S.so.init(M, DM, opaque_s(G), opaque_s(c));
          pg8::EpiMerge<false> E{(bf16*)(ws + WS_R + R_MB), (const bf16*)(ws + WS_R + R_U), 1.f, 0}; pg8::gemm_phase<pg8::EpiMerge<false>, pg8::MergeOrder, true, true>(lds, g, S, E, wbase); }
        GRID_BAR();
        if ((OUT_FP8_MASK >> opaque_s(l)) & 1) { unsigned char* ws = KWS; pg8::Gemm g{(const bf16*)(ws + WS_R + R_MB), (const bf16*)(ws + WS_WOUT) + (size_t)l * DM * DM, DM / 2, 0}; pg8::StaticOrder S; S.init(M, DM, opaque_s(G), opaque_s(c));
          pg8::EpiResid<0, 2> E{HBUF(hc), HBUF(hc), nullptr, SBUF(sc ^ 1), nullptr, nullptr, (l & 1) ? nullptr : ws + WS_HB8, 1.f / (WIN_SCALE * MB8_SCALE), 0}; pg8::gemm_phase<pg8::EpiResid<0, 2>, pg8::StaticOrder, true, true, true>(lds, g, S, E, wbase); }
        else
        for (int rep_ = 0; rep_ < ((DUP_ID == 10 && l == 0) ? DUP_N : 1); ++rep_) { unsigned char* ws = KWS; pg8::Gemm g{(const bf16*)(ws + WS_R + R_MB), (const bf16*)(ws + WS_WOUT) + (size_t)l * DM * DM, DM, 0}; pg8::StaticOrder S; S.init(M, DM, opaque_s(G), opaque_s(c));
          pg8::EpiResid<0> E{HBUF(hc), HBUF(hc), nullptr, SBUF(sc ^ 1), nullptr, nullptr, (!(l & 1) && ((DENSE_FP8_MASK >> (l >> 1)) & 1)) ? ws + WS_HB8 : nullptr, 1.f, 0}; pg8::gemm_phase<pg8::EpiResid<0>, pg8::StaticOrder, true, true>(lds, g, S, E, wbase); }
        }
        sc ^= 1;
        GRID_BAR();
        if (!(l & 1)) {
            if ((DENSE_FP8_MASK >> (l >> 1)) & 1) {
                REP(11) { unsigned char* ws = KWS; pg8::Gemm g{(const bf16*)(ws + WS_HB8), (const bf16*)(ws + WS_W13D) + (size_t)(l >> 1) * 2 * DFF * DM, DM / 2, 0}; pg8::StaticOrder S; S.init(M, 2 * DFF, opaque_s(G), opaque_s(c));
                  pg8::EpiSwiglu<false> E{(bf16*)(ws + WS_R + R_G), SBUF(sc), nullptr, nullptr, 1, 1.f / W13_SCALE}; pg8::gemm_phase<pg8::EpiSwiglu<false>, pg8::StaticOrder, true, true, true>(lds, g, S, E, wbase); }
                GRID_BAR();
                { unsigned char* ws = KWS; pg8::Gemm g{(const bf16*)(ws + WS_R + R_G), (const bf16*)(ws + WS_W2D) + (size_t)(l >> 1) * DM * DFF, DFF / 2, 0}; pg8::StaticOrder S; S.init(M, DM, opaque_s(G), opaque_s(c));
                  pg8::EpiResid<0> E{HBUF(hc), HBUF(hc), nullptr, SBUF(sc ^ 1), nullptr, nullptr, nullptr, 1.f / (W2_SCALE * G8_SCALE), 0}; pg8::gemm_phase<pg8::EpiResid<0>, pg8::StaticOrder, true, true, true>(lds, g, S, E, wbase); sc ^= 1; }
                GRID_BAR();
            } else {
                REP(11) { unsigned char* ws = KWS; pg8::Gemm g{HBUF(hc), (const bf16*)(ws + WS_W13D) + (size_t)(l >> 1) * 2 * DFF * DM, DM, 0}; pg8::StaticOrder S; S.init(M, 2 * DFF, opaque_s(G), opaque_s(c));
                  pg8::EpiSwiglu<false> E{(bf16*)(ws + WS_R + R_G), SBUF(sc), nullptr, nullptr, 0, 1.f}; pg8::gemm_phase<pg8::EpiSwiglu<false>, pg8::StaticOrder, true, true>(lds, g, S, E, wbase); }
                GRID_BAR();
                { unsigned char* ws = KWS; pg8::Gemm g{(const bf16*)(ws + WS_R + R_G), (const bf16*)(ws + WS_W2D) + (size_t)(l >> 1) * DM * DFF, DFF, 0}; pg8::StaticOrder S; S.init(M, DM, opaque_s(G), opaque_s(c));
                  pg8::EpiResid<0> E{HBUF(hc), HBUF(hc), nullptr, SBUF(sc ^ 1), nullptr, nullptr, nullptr, 1.f, 0}; pg8::gemm_phase<pg8::EpiResid<0>, pg8::StaticOrder, true, true>(lds, g, S, E, wbase); sc ^= 1; }
                GRID_BAR();
            }
        } else {
            REP(12) { unsigned char* ws = KWS; moe::route_a(lds, HBUF(hc), SBUF(sc), KIN(18) + l * DM, KIN(22) + (size_t)(l >> 1) * DM * NEXP, KIN(23) + (l >> 1) * NEXP, (int*)(ws + WS_SEL), (float*)(ws + WS_SEL + 256 * 1024), (int*)(ws + WS_SLOT + 964 * 1024), G, c, wbase); }
            GRID_BAR();
            REP(13) { unsigned char* ws = KWS; moe::route_b(lds, (const int*)(ws + WS_SEL), (const float*)(ws + WS_SEL + 256 * 1024), SBUF(sc), (const int*)(ws + WS_SLOT + 964 * 1024), HBUF(hc), (int*)(ws + WS_SLOT), (float*)(ws + WS_SLOT + 320 * 1024),
                                             (float*)(ws + WS_SLOT + 640 * 1024), (int*)(ws + WS_SEL + 512 * 1024), (int*)(ws + WS_SLOT + 960 * 1024), (bf16*)(ws + WS_R + R_XG), G, c, wbase); }
            GRID_BAR();
            REP(14) { unsigned char* ws = KWS; pg8::Gemm g{(const bf16*)(ws + WS_R + R_XG8), (const bf16*)(ws + WS_W13E), MOE_FP8 ? DM / 2 : DM, 0}; pg8::MoeOrder S; S.meta = (const int*)(ws + WS_SLOT + 960 * 1024); S.wstride = (size_t)2 * DFF * DM / (MOE_FP8 ? 2 : 1); S.N = 2 * DFF; S.pad0 = 0; S.setup(opaque_s(G), opaque_s(c));
              pg8::EpiSwiglu<true> E{(bf16*)(ws + WS_R + R_GM), nullptr, (const float*)(ws + WS_SLOT + 320 * 1024), (const float*)(ws + WS_SLOT + 640 * 1024), 0, 1.f}; pg8::gemm_phase<pg8::EpiSwiglu<true>, pg8::MoeOrder, true, true, MOE_FP8>(lds, g, S, E, wbase); }
            GRID_BAR();
            REP(15) { unsigned char* ws = KWS; pg8::Gemm g{(const bf16*)(ws + WS_R + R_GM), (const bf16*)(ws + WS_W2E), MOE_FP8 ? DFF / 2 : DFF, 0}; pg8::MoeOrder S; S.meta = (const int*)(ws + WS_SLOT + 960 * 1024); S.wstride = (size_t)DM * DFF / (MOE_FP8 ? 2 : 1); S.N = DM; S.pad0 = 0; S.setup(opaque_s(G), opaque_s(c));
              pg8::EpiStore16 E{(bf16*)(ws + WS_R + R_XG), DM, MOE_FP8 ? 1.f / (W2_SCALE * G8_SCALE) : 1.f}; pg8::gemm_phase<pg8::EpiStore16, pg8::MoeOrder, true, true, MOE_FP8>(lds, g, S, E, wbase); }
            GRID_BAR();
            { WAVE_IDS(); unsigned char* ws = KWS; const int* TSLOT = (const int*)(ws + WS_SEL + 512 * 1024); const bf16* XG = (const bf16*)(ws + WS_R + R_XG);
              for (int m = gw; m < M; m += 2 * ngw) { const int m2 = m + ngw;
                  if (m2 >= M) { rowstats_row<true>(nullptr, HBUF(hc) + (size_t)m * DM, SBUF(sc ^ 1) + 16 * (size_t)m, XG + (size_t)TSLOT[2 * m] * DM, XG + (size_t)TSLOT[2 * m + 1] * DM, lane); break; }
                  const int s1 = TSLOT[2 * m], s2 = TSLOT[2 * m + 1], s3 = TSLOT[2 * m2], s4 = TSLOT[2 * m2 + 1];
                  const bool p8 = (PLE_FP8_MASK >> l) & 1;
                  combine_rows2(HBUF(hc) + (size_t)m * DM, SBUF(sc ^ 1) + 16 * (size_t)m, XG + (size_t)s1 * DM, XG + (size_t)s2 * DM,
                                HBUF(hc) + (size_t)m2 * DM, SBUF(sc ^ 1) + 16 * (size_t)m2, XG + (size_t)s3 * DM, XG + (size_t)s4 * DM, lane,
                                p8 ? ws + WS_HB8 + (size_t)m * DM : nullptr, p8 ? ws + WS_HB8 + (size_t)m2 * DM : nullptr); } }
            sc ^= 1;
            GRID_BAR();
        }
        if ((PLE_FP8_MASK >> l) & 1) {
          unsigned char* ws = KWS; pg8::Gemm g{(const bf16*)(ws + WS_HB8), (const bf16*)(ws + WS_WPG) + (size_t)l * DM * DM, DM / 2, 0}; pg8::StaticOrder S; S.init(M, DM, opaque_s(G), opaque_s(c));
          pg8::EpiResid<1> E{HBUF(hc), HBUF(hc ^ 1), l + 1 < DEPTH ? nullptr : KOUT, SBUF(sc ^ 1), (const bf16*)(ws + WS_PP), SBUF(sc), nullptr, 1.f / WIN_SCALE, 0}; pg8::gemm_phase<pg8::EpiResid<1>, pg8::StaticOrder, true, true, true>(lds, g, S, E, wbase); sc ^= 1; hc ^= 1; }
        else
        { unsigned char* ws = KWS; pg8::Gemm g{HBUF(hc), (const bf16*)(ws + WS_WPG) + (size_t)l * DM * DM, DM, 0}; pg8::StaticOrder S; S.init(M, DM, opaque_s(G), opaque_s(c));
          pg8::EpiResid<1> E{HBUF(hc), HBUF(hc ^ 1), l + 1 < DEPTH ? nullptr : KOUT, SBUF(sc ^ 1), (const bf16*)(ws + WS_PP), SBUF(sc), ((INPROJ_FP8 || INPROJ_GATES_FP8 || ((INPROJ_FP8_MASK >> (l + 1)) & 1)) && l + 1 < DEPTH) ? ws + WS_HB8 : nullptr, 1.f, 0}; pg8::gemm_phase<pg8::EpiResid<1>, pg8::StaticOrder, true, true>(lds, g, S, E, wbase); sc ^= 1; hc ^= 1; }
        if (l + 1 < DEPTH) GRID_BAR();
    }
    { WAVE_IDS(); if (xb_ld((unsigned*)(KWS + WS_CTL) + CW_BAR + XB_TMO) != 0u) { const float q = __builtin_nanf(""); float* out = KOUT;
        for (int m = gw; m < M; m += ngw) { f32x4* o = (f32x4*)(out + (size_t)m * DM) + lane;
#pragma unroll
            for (int j = 0; j < 4; ++j) o[64 * j] = (f32x4){q, q, q, q}; } } }
#undef GRID_BAR
}

extern "C" void kernel_launch(void* const* d_in, const int* in_sizes, int n_in, void* d_out, int out_size, void* d_ws, size_t ws_size, hipStream_t stream) {
    static int ok = 0, grid = 256;
    if (ok == 0) {
        if (n_in != 30 || in_sizes[0] != M * DM || out_size != M * DM || ws_size < WS_END) { fprintf(stderr, "kernel_launch: unexpected shapes (n_in %d, ws %zu < %zu)\n", n_in, ws_size, (size_t)WS_END); ok = -1; return; }
        if (hipFuncSetAttribute((const void*)mega, hipFuncAttributeMaxDynamicSharedMemorySize, MEGA_LDS) != hipSuccess) { fprintf(stderr, "kernel_launch: hipFuncSetAttribute failed\n"); ok = -1; return; }
        int dev = 0, cus = 0;
        if (hipGetDevice(&dev) == hipSuccess && hipDeviceGetAttribute(&cus, hipDeviceAttributeMultiprocessorCount, dev) == hipSuccess && cus > 0 && cus < 256) grid = cus;
        (void)hipGetLastError();
        ok = 1;
    }
    if (ok < 0) return;
    Ptrs P; memset(&P, 0, sizeof(P)); for (int i = 0; i < 30; ++i) P.in[i] = (const float*)d_in[i]; P.out = (float*)d_out; P.ws = (unsigned char*)d_ws;
    (void)hipMemsetAsync((unsigned char*)d_ws + WS_CTL, 0, CTL_ZERO_BYTES, stream);
    hipLaunchKernelGGL(mega, dim3(grid), dim3(512), MEGA_LDS, stream, P);
}
```

```cpp
#include <hip/hip_runtime.h>
#include <cstdio>
#include <cstdint>
#include <cstring>

#define LAS __attribute__((address_space(3)))
#define GAS __attribute__((address_space(1)))
typedef unsigned short bf16;
typedef short bf16x8 __attribute__((ext_vector_type(8)));
typedef float f32x4 __attribute__((ext_vector_type(4)));
typedef float f32x2 __attribute__((ext_vector_type(2)));
typedef unsigned u32x4 __attribute__((ext_vector_type(4)));
typedef unsigned u32x2 __attribute__((ext_vector_type(2)));

constexpr int BATCH = 8, SEQ = 4096, DM = 1024, DEPTH = 4, M = BATCH * SEQ;
constexpr int NIN = 5632, C_Q = 0, C_K = 1024, C_V = 1280, C_LX = 1536, C_LG = 2560, C_GA = 3584, C_GB = 4608;
constexpr int DFF = 3584, NEXP = 8, PLE = 256;
constexpr int NSLOT = 67584;
constexpr bool INPROJ_GATES_FP8 = false;
constexpr int NIN_A = C_LG, NIN_B = NIN - C_LG;
constexpr int INPROJ_FP8_MASK = 14;
constexpr int OUT_FP8_MASK = 14, MERGE_FP8_MASK = 14;
constexpr float Y8_SCALE = 8.f, MB8_SCALE = 16.f;
constexpr int PLE_FP8_MASK = 8;
constexpr bool INPROJ_FP8 = false;
constexpr float WIN_SCALE = 64.f;
constexpr int DENSE_FP8_MASK = 2;
constexpr bool MOE_FP8 = true;
static_assert(MOE_FP8 || !(INPROJ_FP8 || INPROJ_GATES_FP8), "WS_HB8 lives in the free half of the fp8 expert-weight region");
constexpr float W13_SCALE = 64.f, W2_SCALE = 128.f, G8_SCALE = 8.f;
constexpr float EPS = 1e-6f, LOG2E = 1.4426950408889634f, QSCALE = 0.125f * LOG2E;

constexpr size_t MiB = 1u << 20;
constexpr size_t WS_CTL = 0;
constexpr size_t WS_WIN = 1 * MiB;
constexpr size_t WS_WPA = 45 * MiB, WS_WPB = 53 * MiB, WS_WOUT = 61 * MiB, WS_WPG = 69 * MiB;
constexpr size_t WS_WPP = 77 * MiB;
constexpr size_t WS_W13D = 79 * MiB;
constexpr size_t WS_W2D = 107 * MiB;
constexpr size_t WS_LRUW = 121 * MiB;
constexpr size_t WS_W13E = 122 * MiB;
constexpr size_t WS_HB8 = 178 * MiB;
constexpr size_t WS_W2E = 234 * MiB;
constexpr size_t WS_PB = 290 * MiB;
constexpr size_t WS_HB = 306 * MiB;
constexpr size_t WS_SSQ = 370 * MiB;
constexpr size_t WS_SEL = 374 * MiB;
constexpr size_t WS_SLOT = 375 * MiB;
constexpr size_t WS_PP = 376 * MiB;
constexpr size_t WS_HB2 = 440 * MiB;
constexpr size_t WS_R = 504 * MiB;
constexpr size_t R_U = 0, R_YA = 352 * MiB, R_YB = 416 * MiB, R_MB = 480 * MiB, R_NA = 544 * MiB, R_NU = 576 * MiB;
constexpr size_t R_HR = R_MB, R_PQ = R_NA;
constexpr size_t WS_AGG = WS_SEL;
constexpr size_t R_G = 0;
constexpr size_t R_XG = 0, R_XG8 = 0, R_GM = 132 * MiB;
constexpr size_t WS_END = WS_R + 608 * MiB;

__host__ __device__ __forceinline__ float bf2f(bf16 x) { return __builtin_bit_cast(float, (unsigned)x << 16); }
__host__ __device__ __forceinline__ bf16 f2bf(float f) { unsigned u = __builtin_bit_cast(unsigned, f); return (bf16)((u + 0x7fffu + ((u >> 16) & 1u)) >> 16); }
__device__ __forceinline__ unsigned pk2(float lo, float hi) { return (unsigned)f2bf(lo) | ((unsigned)f2bf(hi) << 16); }
__device__ __forceinline__ float fast_exp(float x) { return __builtin_amdgcn_exp2f(x * LOG2E); }
__device__ __forceinline__ float sigmoidf_(float x) { return 1.f / (1.f + fast_exp(-x)); }
__device__ __forceinline__ float gelu_tanh(float x) { const float z = 0.7978845608028654f * (x + 0.044715f * x * x * x); return x / (1.f + fast_exp(-2.f * z)); }
__device__ __forceinline__ int lane_id() { unsigned ones = ~0u; asm volatile("" : "+s"(ones)); return (int)__builtin_amdgcn_mbcnt_hi(ones, __builtin_amdgcn_mbcnt_lo(ones, 0u)); }
__device__ __forceinline__ int opaque_tid(int wbase) { int t = wbase + lane_id(); asm volatile("" : "+v"(t)); return t; }
__device__ __forceinline__ int opaque_s(int x) { asm volatile("" : "+s"(x)); return x; }
__device__ __forceinline__ float opaque_f(float x) { asm volatile("" : "+v"(x)); return x; }
__device__ __forceinline__ unsigned opaque_u(unsigned x) { asm volatile("" : "+v"(x)); return x; }
template <int MASK> __device__ __forceinline__ float swz_f(float v) { return __builtin_bit_cast(float, __builtin_amdgcn_ds_swizzle(__builtin_bit_cast(int, v), (MASK << 10) | 0x1f)); }
template <int MASK> __device__ __forceinline__ int swz_i(int v) { return __builtin_amdgcn_ds_swizzle(v, (MASK << 10) | 0x1f); }
__device__ __forceinline__ float sum_x32(float v) { const unsigned u = __builtin_bit_cast(unsigned, v); auto rr = __builtin_amdgcn_permlane32_swap(u, u, false, false); return __builtin_bit_cast(float, (unsigned)rr[0]) + __builtin_bit_cast(float, (unsigned)rr[1]); }
__device__ __forceinline__ float max_x32(float v) { const unsigned u = __builtin_bit_cast(unsigned, v); auto rr = __builtin_amdgcn_permlane32_swap(u, u, false, false); return fmaxf(__builtin_bit_cast(float, (unsigned)rr[0]), __builtin_bit_cast(float, (unsigned)rr[1])); }
__device__ __forceinline__ int sum_x32i(int v) { auto rr = __builtin_amdgcn_permlane32_swap((unsigned)v, (unsigned)v, false, false); return (int)rr[0] + (int)rr[1]; }
__device__ __forceinline__ float get_x32(float v, int hi) { const unsigned u = __builtin_bit_cast(unsigned, v); auto rr = __builtin_amdgcn_permlane32_swap(u, u, false, false); return __builtin_bit_cast(float, hi ? (unsigned)rr[0] : (unsigned)rr[1]); }
__device__ __forceinline__ float wave_sum(float v) {
    v += swz_f<1>(v); v += swz_f<2>(v); v += swz_f<4>(v); v += swz_f<8>(v); v += swz_f<16>(v);
    return sum_x32(v);
}
__device__ __forceinline__ float rstd_of(const float* ssq, int m) {
    const f32x4* p = (const f32x4*)(ssq + 16 * (size_t)m); const f32x4 a = p[0], b = p[1], c = p[2], d = p[3];
    const float s = (((a.x + a.y) + (a.z + a.w)) + ((b.x + b.y) + (b.z + b.w))) + (((c.x + c.y) + (c.z + c.w)) + ((d.x + d.y) + (d.z + d.w)));
    return __builtin_amdgcn_rsqf(s * (1.f / 1024.f) + EPS);
}
__device__ __forceinline__ unsigned cvt_pk_bf16(float lo, float hi) { unsigned r; asm volatile("v_cvt_pk_bf16_f32 %0, %1, %2" : "=v"(r) : "v"(lo), "v"(hi)); return r; }
__device__ __forceinline__ unsigned pk4_fp8(float a, float b, float c, float d) {
    a = __builtin_amdgcn_fmed3f(a, -448.f, 448.f); b = __builtin_amdgcn_fmed3f(b, -448.f, 448.f); c = __builtin_amdgcn_fmed3f(c, -448.f, 448.f); d = __builtin_amdgcn_fmed3f(d, -448.f, 448.f);
    int w = __builtin_bit_cast(int, a); w = __builtin_amdgcn_cvt_pk_fp8_f32(a, b, w, false);
    w = __builtin_amdgcn_cvt_pk_fp8_f32(c, d, w, true); return (unsigned)w; }
__device__ __forceinline__ float fast_sigmoid(float x) { return __builtin_amdgcn_rcpf(1.f + __builtin_amdgcn_exp2f(-LOG2E * x)); }
__device__ __forceinline__ float fast_gelu_tanh(float x) { const float z = (2.f * 0.7978845608028654f * LOG2E) * (x + 0.044715f * x * x * x); return x * __builtin_amdgcn_rcpf(1.f + __builtin_amdgcn_exp2f(-z)); }
__device__ __forceinline__ f32x4 unpack_lo(u32x2 w) { return (f32x4){__builtin_bit_cast(float, w.x << 16), __builtin_bit_cast(float, w.x & 0xffff0000u), __builtin_bit_cast(float, w.y << 16), __builtin_bit_cast(float, w.y & 0xffff0000u)}; }

namespace pg8 {
typedef unsigned short bf16_t;
constexpr int BM = 256, BK = 64, HALF = 128, HTB = HALF * BK * 2, STAGE_BYTES = 8 * HTB, NXCD = 8, WGM = 8;
__host__ __device__ __forceinline__ int lds_byte(int r, int c) { const int st = (r >> 4) * 2 + (c >> 5), rr = r & 15, cc = c & 31, ob = rr * 64 + cc * 2; return st * 1024 + (ob ^ (((ob >> 9) & 1) << 5)); }
__host__ __device__ __forceinline__ void stage_rc(int b, int& R, int& C) { const int st = b / 1024, sb = b % 1024, swz = sb ^ (((sb >> 9) & 1) << 5); R = (st >> 1) * 16 + swz / 64; C = (st & 1) * 32 + (swz % 64) / 2; }
__host__ __device__ __forceinline__ int perm32(int rho) { const int n = rho >> 4, i = rho & 15; return 8 * (i >> 2) + 4 * n + (i & 3); }

struct Unit { int pm, pn, part; };
struct Gemm { const bf16_t* A; const bf16_t* Bt; int K; int pad; };

struct StaticOrder {
    int nM, nN, nwg, G, c, pad;
    __host__ __device__ void init(int M_, int N_, int G_, int c_) { nM = M_ / BM; nN = N_ / BM; nwg = nM * nN; G = G_; c = c_; pad = 0; }
    __device__ __forceinline__ void setup(int G_, int c_) { G = G_; c = c_; }
    __host__ __device__ bool next(int i, Unit& u) const {
        const int L = i * G + c; if (L >= nwg) return false;
        int wgid = L; { const int q = nwg / NXCD, r = nwg % NXCD, xcd = wgid % NXCD, off = wgid / NXCD; wgid = (xcd < r ? xcd * (q + 1) : r * (q + 1) + (xcd - r) * q) + off; }
        const int nig = WGM * nN, gid = wgid / nig, fm = gid * WGM, gsz = (nM - fm) < WGM ? (nM - fm) : WGM;
        u.pm = fm + ((wgid % nig) % gsz); u.pn = (wgid % nig) / gsz; u.part = 0; return true;
    }
    static constexpr bool TWO = false;
    __device__ __forceinline__ unsigned a_off(const Unit& u, const Gemm& g) const { return (unsigned)u.pm * (unsigned)(BM * 2) * (unsigned)g.K; }
    __device__ __forceinline__ unsigned b_off(const Unit& u, const Gemm& g) const { return (unsigned)u.pn * (unsigned)(BM * 2) * (unsigned)g.K; }
    __device__ __forceinline__ void a_ready(const Unit&) const {}
    __device__ __forceinline__ void done(const Unit&) const {}
};
struct MoeOrder {
    const int* meta; size_t wstride; int N, pad0;
    StaticOrder so; int ts[10];
    __device__ __forceinline__ void setup(int G_, int c_) {
#pragma unroll
        for (int e = 0; e < 9; ++e) ts[e] = __builtin_amdgcn_readfirstlane(__hip_atomic_load(meta + e, __ATOMIC_RELAXED, __HIP_MEMORY_SCOPE_AGENT));
        so.init(ts[8] * BM, N, G_, c_);
    }
    __device__ __forceinline__ bool next(int i, Unit& u) const { return so.next(i, u); }
    static constexpr bool TWO = false;
    __device__ __forceinline__ unsigned a_off(const Unit& u, const Gemm& g) const { return (unsigned)u.pm * (unsigned)(BM * 2) * (unsigned)g.K; }
    __device__ __forceinline__ unsigned b_off(const Unit& u, const Gemm& g) const {
        int e = 0;
#pragma unroll
        for (int j = 1; j < 8; ++j) e += (u.pm >= ts[j]) ? 1 : 0;
        return (unsigned)e * (unsigned)(wstride * 2) + (unsigned)u.pn * (unsigned)(BM * 2) * (unsigned)g.K;
    }
    __device__ __forceinline__ void a_ready(const Unit&) const {}
    __device__ __forceinline__ void done(const Unit&) const {}
};

#define EPI_ROWS(ai, m) (u.pm * BM + (ai) * HALF + wr * 64 + (m) * 16 + fr)
__device__ __forceinline__ float rstd_q(const float* ssq, int row, int fq) {
    const f32x4 p = *(const f32x4*)(ssq + 16 * (size_t)row + 4 * fq); float s = (p.x + p.y) + (p.z + p.w); s += swz_f<16>(s); s = sum_x32(s);
    return __builtin_amdgcn_rsqf(s * (1.f / 1024.f) + EPS);
}
__device__ __forceinline__ u32x4 pack8(const f32x4 a, const f32x4 b) { u32x4 w; w.x = cvt_pk_bf16(a[0], a[1]); w.y = cvt_pk_bf16(a[2], a[3]); w.z = cvt_pk_bf16(b[0], b[1]); w.w = cvt_pk_bf16(b[2], b[3]); return w; }
__device__ __forceinline__ void unpack8(const u32x4 w, f32x4& a, f32x4& b) {
    a = (f32x4){__builtin_bit_cast(float, w.x << 16), __builtin_bit_cast(float, w.x & 0xffff0000u), __builtin_bit_cast(float, w.y << 16), __builtin_bit_cast(float, w.y & 0xffff0000u)};
    b = (f32x4){__builtin_bit_cast(float, w.z << 16), __builtin_bit_cast(float, w.z & 0xffff0000u), __builtin_bit_cast(float, w.w << 16), __builtin_bit_cast(float, w.w & 0xffff0000u)}; }
template <bool GATES> struct EpiInproj {
    static constexpr bool PERM = true, AFTER_DRAIN = false, HAS_PRE = false;
    bf16* U; const float* ssq; const float* qg; const float* kg; int pn_off; float ascale;
    __device__ __forceinline__ bool reset(const Unit&) const { return true; }
    __device__ __forceinline__ void operator()(const f32x4 (&acc)[2][2][4][2], const Unit& u, int wr, int wc, int fr, int fq) const {
        const int pn = u.pn + pn_off, type = GATES ? (pn < 14 ? 3 : 4) : (pn < 4 ? 0 : pn == 4 ? 1 : pn < 10 ? 2 : pn < 14 ? 3 : 4);
        const float* gp = (type == 0 ? qg : kg) + 8 * fq; const float gsc = type == 0 ? QSCALE : 1.f;
        float rs8[2][4];
#pragma unroll
        for (int ai = 0; ai < 2; ++ai)
#pragma unroll
            for (int m = 0; m < 4; ++m) rs8[ai][m] = rstd_q(ssq, EPI_ROWS(ai, m), fq) * ascale;
#pragma unroll
        for (int ai = 0; ai < 2; ++ai)
#pragma unroll
            for (int m = 0; m < 4; ++m) { const int row = EPI_ROWS(ai, m); const float rs = rs8[ai][m]; f32x4 v[2][2];
#pragma unroll
                for (int bj = 0; bj < 2; ++bj)
#pragma unroll
                    for (int n = 0; n < 2; ++n) v[bj][n] = acc[ai][bj][m][n] * rs;
                if (!GATES && type <= 1) { float ss = 0.f;
#pragma unroll
                    for (int bj = 0; bj < 2; ++bj)
#pragma unroll
                        for (int n = 0; n < 2; ++n) ss += (v[bj][n][0] * v[bj][n][0] + v[bj][n][1] * v[bj][n][1]) + (v[bj][n][2] * v[bj][n][2] + v[bj][n][3] * v[bj][n][3]);
                    ss += swz_f<16>(ss); ss = sum_x32(ss);
                    const float r = __builtin_amdgcn_rsqf(ss * (1.f / 64.f) + EPS) * gsc;
#pragma unroll
                    for (int bj = 0; bj < 2; ++bj)
#pragma unroll
                        for (int n = 0; n < 2; ++n) v[bj][n] = v[bj][n] * r * *(const f32x4*)(gp + 32 * bj + 4 * n);
                } else if (type == 3) {
#pragma unroll
                    for (int bj = 0; bj < 2; ++bj)
#pragma unroll
                        for (int n = 0; n < 2; ++n)
#pragma unroll
                            for (int e = 0; e < 4; ++e) v[bj][n][e] = fast_gelu_tanh(v[bj][n][e]);
                } else if (type == 4) {
#pragma unroll
                    for (int bj = 0; bj < 2; ++bj)
#pragma unroll
                        for (int n = 0; n < 2; ++n)
#pragma unroll
                            for (int e = 0; e < 4; ++e) v[bj][n][e] = fmaxf(fast_sigmoid(v[bj][n][e]), 5.9604645e-8f);
                }
                bf16* rowp = U + (size_t)row * NIN + pn * BM + 64 * wc + 8 * fq;
#pragma unroll
                for (int bj = 0; bj < 2; ++bj) *(u32x4*)(rowp + 32 * bj) = pack8(v[bj][0], v[bj][1]);
            }
    }
};
struct EpiStore16 {
    static constexpr bool PERM = true, AFTER_DRAIN = false, HAS_PRE = false;
    bf16* O; int ld; float scale;
    __device__ __forceinline__ bool reset(const Unit&) const { return true; }
    __device__ __forceinline__ void operator()(const f32x4 (&acc)[2][2][4][2], const Unit& u, int wr, int wc, int fr, int fq) const {
#pragma unroll
        for (int ai = 0; ai < 2; ++ai)
#pragma unroll
            for (int m = 0; m < 4; ++m) { bf16* rowp = O + (size_t)EPI_ROWS(ai, m) * ld + u.pn * BM + wc * 32 + 8 * fq;
#pragma unroll
                for (int bj = 0; bj < 2; ++bj) *(u32x4*)(rowp + bj * HALF) = pack8(acc[ai][bj][m][0] * scale, acc[ai][bj][m][1] * scale); }
    }
};
template <bool F8> struct EpiMerge {
    static constexpr bool PERM = true, AFTER_DRAIN = false, HAS_PRE = false;
    bf16* MB; const bf16* U; float oscale; int pad_;
    __device__ __forceinline__ bool reset(const Unit& u) const { return u.part != 0; }
    __device__ __forceinline__ void operator()(f32x4 (&acc)[2][2][4][2], const Unit& u, int wr, int wc, int fr, int fq) const {
#pragma unroll
        for (int ai = 0; ai < 2; ++ai)
#pragma unroll
        for (int mb = 0; mb < 4; mb += 2) {
            u32x4 gbv[4][2], gav[4][2];
#pragma unroll
            for (int m = mb; m < mb + 2; ++m) { const int row = EPI_ROWS(ai, m);
#pragma unroll
                for (int bj = 0; bj < 2; ++bj) { const int col = u.pn * BM + bj * HALF + wc * 32 + 8 * fq; gbv[m][bj] = *(const u32x4*)(U + (size_t)row * NIN + C_GB + col);
                    if (u.part == 0) gav[m][bj] = *(const u32x4*)(U + (size_t)row * NIN + C_GA + col); } }
#pragma unroll
            for (int m = mb; m < mb + 2; ++m) { const int row = EPI_ROWS(ai, m);
#pragma unroll
                for (int bj = 0; bj < 2; ++bj) { const int col = u.pn * BM + bj * HALF + wc * 32 + 8 * fq;
                    f32x4 b0, b1; unpack8(gbv[m][bj], b0, b1);
                    if (u.part == 0) { f32x4 a0, a1; unpack8(gav[m][bj], a0, a1);
#pragma unroll
                        for (int e = 0; e < 4; ++e) { acc[ai][bj][m][0][e] *= a0[e] * __builtin_amdgcn_rcpf(b0[e]); acc[ai][bj][m][1][e] *= a1[e] * __builtin_amdgcn_rcpf(b1[e]); }
                    } else if (!F8) *(u32x4*)(MB + (size_t)row * DM + col) = pack8(acc[ai][bj][m][0] * b0, acc[ai][bj][m][1] * b1);
                    else { const f32x4 o0 = acc[ai][bj][m][0] * b0 * oscale, o1 = acc[ai][bj][m][1] * b1 * oscale;
                        { u32x2 w8; w8.x = pk4_fp8(o0[0], o0[1], o0[2], o0[3]); w8.y = pk4_fp8(o1[0], o1[1], o1[2], o1[3]); *(u32x2*)((unsigned char*)MB + (size_t)row * DM + col) = w8; }
                    }
                } }
        }
    }
};
template <int MODE, int MBAT_ = (MODE == 1 ? 2 : 4)> struct EpiResid {
    static constexpr bool PERM = true, AFTER_DRAIN = false, HAS_PRE = false;
    const bf16* hin; bf16* hout; float* outf; float* ssq_out; const bf16* PP; const float* ssq_in; unsigned char* h8; float ascale; int pad_;
    __device__ __forceinline__ bool reset(const Unit&) const { return true; }
    __device__ __forceinline__ void operator()(const f32x4 (&acc)[2][2][4][2], const Unit& u, int wr, int wc, int fr, int fq) const {
        constexpr int MBAT = MBAT_;
#pragma unroll
        for (int ai = 0; ai < 2; ++ai)
#pragma unroll
        for (int mb = 0; mb < 4; mb += MBAT) {
            u32x4 hv[4][2], pv[4][2]; float rs4[4];
#pragma unroll
            for (int m = mb; m < mb + MBAT; ++m) { const int row = EPI_ROWS(ai, m); rs4[m] = 0.f; if (MODE == 1) rs4[m] = rstd_q(ssq_in, row, fq) * ascale;
#pragma unroll
                for (int bj = 0; bj < 2; ++bj) { const size_t off = (size_t)row * DM + u.pn * BM + bj * HALF + wc * 32 + 8 * fq; hv[m][bj] = *(const u32x4*)(hin + off); if (MODE == 1) pv[m][bj] = *(const u32x4*)(PP + off); } }
#pragma unroll
            for (int m = mb; m < mb + MBAT; ++m) { const int row = EPI_ROWS(ai, m); const float rs = rs4[m]; float ss = 0.f;
#pragma unroll
                for (int bj = 0; bj < 2; ++bj) { const size_t off = (size_t)row * DM + u.pn * BM + bj * HALF + wc * 32 + 8 * fq;
                    f32x4 v0, v1; unpack8(hv[m][bj], v0, v1); const f32x4 a0 = acc[ai][bj][m][0], a1 = acc[ai][bj][m][1];
                    if (MODE == 0) { v0 = v0 + a0 * ascale; v1 = v1 + a1 * ascale; }
                    else { f32x4 p0, p1; unpack8(pv[m][bj], p0, p1);
#pragma unroll
                        for (int e = 0; e < 4; ++e) { v0[e] += fast_sigmoid(a0[e] * rs) * p0[e]; v1[e] += fast_sigmoid(a1[e] * rs) * p1[e]; } }
                    if (outf) { *(f32x4*)(outf + off) = v0; *(f32x4*)(outf + off + 4) = v1; }
                    else *(u32x4*)(hout + off) = pack8(v0, v1);
                    if (h8) { u32x2 w8; w8.x = pk4_fp8(v0[0], v0[1], v0[2], v0[3]); w8.y = pk4_fp8(v1[0], v1[1], v1[2], v1[3]); *(u32x2*)(h8 + off) = w8; }
                    ss += ((v0[0] * v0[0] + v0[1] * v0[1]) + (v0[2] * v0[2] + v0[3] * v0[3])) + ((v1[0] * v1[0] + v1[1] * v1[1]) + (v1[2] * v1[2] + v1[3] * v1[3])); }
                ss += swz_f<16>(ss); ss = sum_x32(ss);
                if (fq == 0) ssq_out[(size_t)row * 16 + u.pn * 4 + wc] = ss; }
        }
    }
};
template <bool MOE> struct EpiSwiglu {
    static constexpr bool PERM = true, AFTER_DRAIN = false, HAS_PRE = MOE && MOE_FP8;
    __device__ __forceinline__ void pre_load(float (&pre)[8], const Unit& u, int wr) const { const int fr = lane_id() & 15;
#pragma unroll
        for (int ai = 0; ai < 2; ++ai)
#pragma unroll
            for (int m = 0; m < 4; ++m) { const unsigned o4 = (unsigned)EPI_ROWS(ai, m) * 4u; asm volatile("global_load_dword %0, %1, %2" : "=v"(pre[ai * 4 + m]) : "v"(o4), "s"(sgw) : "memory"); } }
    bf16* G; const float* ssq; const float* srs; const float* sgw; int f8; float ascale;
    __device__ __forceinline__ bool reset(const Unit&) const { return true; }
    __device__ __forceinline__ void operator()(const f32x4 (&acc)[2][2][4][2], const Unit& u, int wr, int wc, int fr, int fq, const float* pre = nullptr) const {
        float rs8[2][4], gw8[2][4];
#pragma unroll
        for (int ai = 0; ai < 2; ++ai)
#pragma unroll
            for (int m = 0; m < 4; ++m) { const int row = EPI_ROWS(ai, m); float rs, gw = 1.f;
                if (MOE) { rs = (MOE_FP8 ? opaque_f(1.f / W13_SCALE) : srs[row]); gw = (HAS_PRE ? pre[ai * 4 + m] : sgw[row]) * (MOE_FP8 ? G8_SCALE : 1.f); } else { rs = rstd_q(ssq, row, fq) * ascale; if (f8) gw = G8_SCALE; }
                rs8[ai][m] = rs; gw8[ai][m] = gw; }
#pragma unroll
        for (int ai = 0; ai < 2; ++ai)
#pragma unroll
            for (int m = 0; m < 4; ++m) { const int row = EPI_ROWS(ai, m); const float rs = rs8[ai][m], gw = gw8[ai][m];
                const float rs2 = rs * gw; f32x4 o[2];
#pragma unroll
                for (int bj = 0; bj < 2; ++bj)
#pragma unroll
                    for (int e = 0; e < 4; ++e) { const float a = acc[ai][bj][m][0][e] * rs, b = acc[ai][bj][m][1][e] * rs2; o[bj][e] = a * fast_sigmoid(a) * b; }
                if ((MOE && MOE_FP8) || (!MOE && f8)) { u32x2 w; w.x = pk4_fp8(o[0][0], o[0][1], o[0][2], o[0][3]); w.y = pk4_fp8(o[1][0], o[1][1], o[1][2], o[1][3]);
                    *(u32x2*)((unsigned char*)G + (size_t)row * DFF + u.pn * HALF + wc * 32 + 8 * fq) = w; }
                else *(u32x4*)(G + (size_t)row * DFF + u.pn * HALF + wc * 32 + 8 * fq) = pack8(o[0], o[1]); }
    }
};
struct MergeOrder {
    const bf16_t* A1; const bf16_t* Bt1; StaticOrder so;
    __device__ __forceinline__ void setup(int G_, int c_) { so.setup(G_, c_); }
    __device__ __forceinline__ bool next(int i, Unit& u) const { const bool ok = so.next(i >> 1, u); u.part = i & 1; return ok; }
    static constexpr bool TWO = true;
    __device__ __forceinline__ unsigned a_off(const Unit& u, const Gemm& g) const { return (unsigned)u.pm * (unsigned)(BM * 2) * (unsigned)g.K; }
    __device__ __forceinline__ unsigned b_off(const Unit& u, const Gemm& g) const { return (unsigned)u.pn * (unsigned)(BM * 2) * (unsigned)g.K; }
    __device__ __forceinline__ void a_ready(const Unit&) const {}
    __device__ __forceinline__ void done(const Unit&) const {}
};

typedef int v8i_t __attribute__((ext_vector_type(8)));
__device__ __forceinline__ v8i_t cat8(const bf16x8 a, const bf16x8 b) { const u32x4 x = __builtin_bit_cast(u32x4, a), y = __builtin_bit_cast(u32x4, b); return (v8i_t){(int)x.x, (int)x.y, (int)x.z, (int)x.w, (int)y.x, (int)y.y, (int)y.z, (int)y.w}; }
template <class Epi, class Sched, bool ALIGN_EPI = false, bool SP2 = false, bool FP8 = false>
__device__ __forceinline__ void gemm_phase(LAS unsigned char* lds, const Gemm g, const Sched& S, const Epi& E, int wbase) {
    const int tid = opaque_tid(wbase), wid = __builtin_amdgcn_readfirstlane(tid >> 6), lane = tid & 63, wr = wid >> 2, wc = wid & 3, fr = lane & 15, fq = lane >> 4;
    const int K = opaque_s(g.K), nt = K / BK;
    unsigned voffA[2], voffB[2];
#pragma unroll
    for (int i = 0; i < 2; ++i) { int R, C; stage_rc(tid * 16 + i * 8192, R, C); const int Rb = Epi::PERM ? ((R & ~31) + perm32(R & 31)) : R;
        voffA[i] = (unsigned)(R * K + C) * 2u; voffB[i] = (unsigned)(Rb * K + C) * 2u; }
    const unsigned kstep = (unsigned)(BK * 2);
    const unsigned hstep = (unsigned)HALF * (unsigned)K * 2u;
    typedef __amdgpu_buffer_rsrc_t rsrc_t;
    const rsrc_t rA0 = __builtin_amdgcn_make_buffer_rsrc((void*)g.A, 0, 0xffffffff, 0x00020000), rB0 = __builtin_amdgcn_make_buffer_rsrc((void*)g.Bt, 0, 0xffffffff, 0x00020000);
    rsrc_t rA1 = rA0, rB1 = rB0;
    if constexpr (Sched::TWO) { rA1 = __builtin_amdgcn_make_buffer_rsrc((void*)S.A1, 0, 0xffffffff, 0x00020000); rB1 = __builtin_amdgcn_make_buffer_rsrc((void*)S.Bt1, 0, 0xffffffff, 0x00020000); }
    const unsigned ldsw = (unsigned)wid * 1024u;
    const int aoff = lds_byte(wr * 64 + fr, fq * 8), boff = lds_byte(wc * 32 + fr, fq * 8);
#define PG8_SA(b, h) (((b) * 2 + (h)) * HTB)
#define PG8_SB(b, h) ((4 + (b) * 2 + (h)) * HTB)
#define PG8_STAGE(bufoff, rs_, soff_, voff) do { _Pragma("unroll") for (int _i = 0; _i < 2; ++_i) \
        __builtin_amdgcn_raw_ptr_buffer_load_lds(rs_, (LAS void*)(lds + (bufoff) + ldsw + _i * 8192), 16, (int)(voff)[_i], (int)(soff_), 0, 0); } while (0)
#define PG8_LD2(p_) cat8(*(const LAS bf16x8*)(p_), *(const LAS bf16x8*)((p_) + 1024))
#define PG8_LDA(dst, b, h) do { _Pragma("unroll") for (int m = 0; m < 4; ++m) dst[m] = PG8_LD2(lds + PG8_SA(b, h) + aoff + m * 2048); } while (0)
#define PG8_LDB(dst, b, h) do { _Pragma("unroll") for (int n = 0; n < 2; ++n) dst[n] = PG8_LD2(lds + PG8_SB(b, h) + boff + n * 2048); } while (0)
#define PG8_LO(v_) __builtin_bit_cast(bf16x8, __builtin_shufflevector(v_, v_, 0, 1, 2, 3))
#define PG8_HI(v_) __builtin_bit_cast(bf16x8, __builtin_shufflevector(v_, v_, 4, 5, 6, 7))
#define PG8_MMA(ai, bj, At, Bt) do { __builtin_amdgcn_s_setprio(1); \
        if constexpr (FP8) { _Pragma("unroll") for (int m = 0; m < 4; ++m) _Pragma("unroll") for (int n = 0; n < 2; ++n) \
            acc[ai][bj][m][n] = __builtin_amdgcn_mfma_scale_f32_16x16x128_f8f6f4(Bt[n], At[m], acc[ai][bj][m][n], 0, 0, 0, 0x7f7f7f7f, 0, 0x7f7f7f7f); } \
        else { _Pragma("unroll") for (int m = 0; m < 4; ++m) _Pragma("unroll") for (int n = 0; n < 2; ++n) { \
            acc[ai][bj][m][n] = __builtin_amdgcn_mfma_f32_16x16x32_bf16(PG8_LO(Bt[n]), PG8_LO(At[m]), acc[ai][bj][m][n], 0, 0, 0); \
            acc[ai][bj][m][n] = __builtin_amdgcn_mfma_f32_16x16x32_bf16(PG8_HI(Bt[n]), PG8_HI(At[m]), acc[ai][bj][m][n], 0, 0, 0); } } \
        __builtin_amdgcn_s_setprio(0); } while (0)
#define PG8_WAIT_V(n) asm volatile("s_waitcnt vmcnt(" #n ")" ::: "memory")
#define PG8_WAIT_L(n) asm volatile("s_waitcnt lgkmcnt(" #n ")" ::: "memory")
#define PG8_BAR __builtin_amdgcn_s_barrier()
#define PG8_SCHED __builtin_amdgcn_sched_barrier(0)
    Unit cur, nxt; int ui = 0;
    if (!S.next(0, cur)) return;
    f32x4 acc[2][2][4][2];
#define PG8_ZERO_ACC() do { float z_; asm volatile("v_mov_b32 %0, 0" : "=v"(z_)); _Pragma("unroll") for (int a = 0; a < 2; ++a) _Pragma("unroll") for (int b = 0; b < 2; ++b) _Pragma("unroll") for (int m = 0; m < 4; ++m) \
        _Pragma("unroll") for (int n = 0; n < 2; ++n) acc[a][b][m][n] = (f32x4){z_, z_, z_, z_}; } while (0)
    PG8_ZERO_ACC();
    v8i_t At[4], B0[2], B1[2];
    unsigned cA = S.a_off(cur, g), cB = S.b_off(cur, g); rsrc_t rAc = (Sched::TWO && cur.part) ? rA1 : rA0, rBc = (Sched::TWO && cur.part) ? rB1 : rB0;
    S.a_ready(cur);
    if constexpr (SP2) {
        PG8_STAGE(PG8_SB(0, 0), rBc, cB, voffB); PG8_STAGE(PG8_SB(0, 1), rBc, cB + hstep, voffB); PG8_STAGE(PG8_SA(0, 0), rAc, cA, voffA); PG8_STAGE(PG8_SA(0, 1), rAc, cA + hstep, voffA);
        if (wr == 1) PG8_BAR;
        PG8_WAIT_V(2); PG8_BAR;
        PG8_STAGE(PG8_SB(1, 0), rBc, cB + kstep, voffB); PG8_STAGE(PG8_SA(1, 0), rAc, cA + kstep, voffA); PG8_STAGE(PG8_SB(1, 1), rBc, cB + hstep + kstep, voffB);
        PG8_WAIT_V(6); PG8_BAR;
    } else {
        PG8_STAGE(PG8_SB(0, 0), rBc, cB, voffB); PG8_STAGE(PG8_SA(0, 0), rAc, cA, voffA); PG8_STAGE(PG8_SB(0, 1), rBc, cB + hstep, voffB); PG8_STAGE(PG8_SA(0, 1), rAc, cA + hstep, voffA);
        if (wr == 1) PG8_BAR;
        PG8_WAIT_V(4); PG8_BAR;
        PG8_STAGE(PG8_SB(1, 0), rBc, cB + kstep, voffB); PG8_STAGE(PG8_SA(1, 0), rAc, cA + kstep, voffA); PG8_STAGE(PG8_SB(1, 1), rBc, cB + hstep + kstep, voffB);
        PG8_WAIT_V(6); PG8_BAR;
    }
    for (;;) {
        const bool has_next = S.next(ui + 1, nxt);
        const unsigned nA = has_next ? S.a_off(nxt, g) : cA, nB = has_next ? S.b_off(nxt, g) : cB;
        const rsrc_t rAn = (Sched::TWO && has_next) ? (nxt.part ? rA1 : rA0) : rAc, rBn = (Sched::TWO && has_next) ? (nxt.part ? rB1 : rB0) : rBc;
        float pre_[8] = {0.f, 0.f, 0.f, 0.f, 0.f, 0.f, 0.f, 0.f};
        if constexpr (Epi::HAS_PRE) E.pre_load(pre_, cur, wr);
        for (int t = 0; t < nt; t += 2) {
            const bool last = (t == nt - 2);
            const unsigned a1 = cA + (unsigned)(t + 1) * kstep;
            const unsigned a2 = last ? nA : cA + (unsigned)(t + 2) * kstep, b2 = last ? nB : cB + (unsigned)(t + 2) * kstep; const rsrc_t rA2 = (Sched::TWO && last) ? rAn : rAc, rB2 = (Sched::TWO && last) ? rBn : rBc;
            const unsigned a3 = a2 + kstep, b3 = b2 + kstep;
            if (last && has_next) S.a_ready(nxt);
            if constexpr (SP2) {
            PG8_LDB(B0, 0, 0); PG8_LDB(B1, 0, 1); PG8_SCHED; PG8_LDA(At, 0, 0); PG8_STAGE(PG8_SA(1, 1), rAc, a1 + hstep, voffA);
            PG8_WAIT_V(8); PG8_WAIT_L(0); PG8_BAR; PG8_MMA(0, 0, At, B0); PG8_MMA(0, 1, At, B1); PG8_BAR; PG8_SCHED;
            PG8_LDA(At, 0, 1); PG8_STAGE(PG8_SB(0, 0), rB2, b2, voffB); PG8_STAGE(PG8_SB(0, 1), rB2, b2 + hstep, voffB); PG8_STAGE(PG8_SA(0, 0), rA2, a2, voffA);
            PG8_WAIT_V(8); PG8_WAIT_L(0); PG8_BAR; PG8_MMA(1, 0, At, B0); PG8_MMA(1, 1, At, B1); PG8_BAR; PG8_SCHED;
            PG8_LDB(B0, 1, 0); PG8_LDB(B1, 1, 1); PG8_SCHED; PG8_LDA(At, 1, 0); PG8_STAGE(PG8_SA(0, 1), rA2, a2 + hstep, voffA);
            PG8_WAIT_V(8); PG8_WAIT_L(0); PG8_BAR; PG8_MMA(0, 0, At, B0); PG8_MMA(0, 1, At, B1); PG8_BAR; PG8_SCHED;
            PG8_LDA(At, 1, 1); PG8_STAGE(PG8_SB(1, 0), rB2, b3, voffB); PG8_STAGE(PG8_SB(1, 1), rB2, b3 + hstep, voffB); PG8_STAGE(PG8_SA(1, 0), rA2, a3, voffA);
            PG8_WAIT_V(8); PG8_WAIT_L(0); PG8_BAR; PG8_MMA(1, 0, At, B0); PG8_MMA(1, 1, At, B1); PG8_BAR; PG8_SCHED;
            } else {
            PG8_LDB(B0, 0, 0); PG8_SCHED; PG8_LDA(At, 0, 0); PG8_STAGE(PG8_SA(1, 1), rAc, a1 + hstep, voffA);
            PG8_WAIT_L(8); PG8_BAR; PG8_WAIT_L(0); PG8_MMA(0, 0, At, B0); PG8_BAR; PG8_SCHED;
            PG8_LDB(B1, 0, 1); PG8_STAGE(PG8_SB(0, 0), rB2, b2, voffB);
            PG8_BAR; PG8_WAIT_L(0); PG8_MMA(0, 1, At, B1); PG8_BAR;
            PG8_LDA(At, 0, 1); PG8_STAGE(PG8_SA(0, 0), rA2, a2, voffA);
            PG8_BAR; PG8_WAIT_L(0); PG8_MMA(1, 0, At, B0); PG8_BAR; PG8_SCHED;
            PG8_STAGE(PG8_SB(0, 1), rB2, b2 + hstep, voffB);
            PG8_WAIT_V(6); PG8_BAR; PG8_MMA(1, 1, At, B1); PG8_BAR;
            PG8_LDB(B0, 1, 0); PG8_SCHED; PG8_LDA(At, 1, 0); PG8_STAGE(PG8_SA(0, 1), rA2, a2 + hstep, voffA);
            PG8_WAIT_L(8); PG8_BAR; PG8_WAIT_L(0); PG8_MMA(0, 0, At, B0); PG8_BAR; PG8_SCHED;
            PG8_LDB(B1, 1, 1); PG8_STAGE(PG8_SB(1, 0), rB2, b3, voffB);
            PG8_BAR; PG8_WAIT_L(0); PG8_MMA(0, 1, At, B1); PG8_BAR;
            PG8_LDA(At, 1, 1); PG8_STAGE(PG8_SA(1, 0), rA2, a3, voffA);
            PG8_BAR; PG8_WAIT_L(0); PG8_MMA(1, 0, At, B0); PG8_BAR; PG8_SCHED;
            PG8_STAGE(PG8_SB(1, 1), rB2, b3 + hstep, voffB);
            PG8_WAIT_V(6); PG8_BAR; PG8_MMA(1, 1, At, B1); PG8_BAR;
            }
        }
        if constexpr (ALIGN_EPI) { if (wr == 0) PG8_BAR; }
        { int fr_ = fr, fq_ = fq; asm volatile("" : "+v"(fr_), "+v"(fq_));
          if constexpr (Epi::HAS_PRE) E(acc, cur, wr, wc, fr_, fq_, pre_); else E(acc, cur, wr, wc, fr_, fq_); } S.done(cur);
        if (!has_next) break;
        if (E.reset(cur)) PG8_ZERO_ACC();
        cur = nxt; cA = nA; cB = nB; rAc = rAn; rBc = rBn; ++ui;
        if constexpr (ALIGN_EPI) { if (wr == 1) PG8_BAR; }
    }
    PG8_WAIT_V(0);
    if constexpr (!ALIGN_EPI) { if (wr == 0) PG8_BAR; }
    PG8_BAR;
#undef PG8_SA
#undef PG8_SB
#undef PG8_STAGE
#undef PG8_LDA
#undef PG8_ZERO_ACC
#undef PG8_LD2
#undef PG8_LO
#undef PG8_HI
#undef PG8_LDB
#undef PG8_MMA
#undef PG8_WAIT_V
#undef PG8_WAIT_L
#undef PG8_BAR
#undef PG8_SCHED
}
}

struct CJob { const float* W; const float* gain; bf16* dst; int K, N, mode, fp8; float wscale; int ldw, col0, pad; };
struct Ptrs { const float* in[30]; float* out; unsigned char* ws; };
typedef const __attribute__((address_space(4))) Ptrs* KP;

__device__ __forceinline__ void conv_load(const CJob& jb, int item, int lane, f32x4 (&v)[8]) {
    const int nblk = jb.N / 32, kb = item / nblk, nb = item % nblk, k0 = 64 * kb, n0 = 32 * nb;
    const float* src = jb.W + (size_t)(k0 + (lane >> 3)) * jb.ldw + jb.col0 + n0 + 4 * (lane & 7);
#pragma unroll
    for (int i = 0; i < 8; ++i) v[i] = __builtin_nontemporal_load((const f32x4*)(src + (size_t)(8 * i) * jb.ldw));
}
__device__ __forceinline__ void conv_finish(const CJob& jb, LAS float* scr, int item, int lane, const f32x4 (&v)[8]) {
    const int nblk = jb.N / 32, kb = item / nblk, nb = item % nblk, k0 = 64 * kb, n0 = 32 * nb;
    const int c = lane & 7;
    f32x4 g0 = (f32x4){1.f, 1.f, 1.f, 1.f}, g1 = g0;
    if (jb.gain) { g0 = *(const f32x4*)(jb.gain + k0 + 8 * c); g1 = *(const f32x4*)(jb.gain + k0 + 8 * c + 4); }
#pragma unroll
    for (int i = 0; i < 8; ++i) { LAS float* d = scr + ((lane >> 3) + 8 * i) * 33 + 4 * (lane & 7); d[0] = v[i].x; d[1] = v[i].y; d[2] = v[i].z; d[3] = v[i].w; }
    asm volatile("s_waitcnt lgkmcnt(0)" ::: "memory");
#pragma unroll
    for (int j = 0; j < 4; ++j) { const int n = (lane >> 3) + 8 * j; const LAS float* s = scr + (8 * c) * 33 + n;
        u32x4 o; o.x = cvt_pk_bf16(s[0 * 33] * g0.x, s[1 * 33] * g0.y); o.y = cvt_pk_bf16(s[2 * 33] * g0.z, s[3 * 33] * g0.w); o.z = cvt_pk_bf16(s[4 * 33] * g1.x, s[5 * 33] * g1.y); o.w = cvt_pk_bf16(s[6 * 33] * g1.z, s[7 * 33] * g1.w);
        const int nn = n0 + n; int row = nn;
        if (jb.mode == 3) { const int w = nn & 255; row = (nn & ~255) + ((w >> 5) & 1) * 128 + (w >> 6) * 32 + (w & 31); }
        else if (jb.mode >= 4) { const int r = nn & 127; row = (nn >> 7) * 256 + ((r >> 2) & 1) * 128 + (r >> 5) * 32 + ((r >> 3) & 3) * 8 + (jb.mode == 5 ? 4 : 0) + (r & 3); }
        if (jb.fp8) { const float ws_ = jb.wscale; u32x2 o8; o8.x = pk4_fp8(s[0 * 33] * g0.x * ws_, s[1 * 33] * g0.y * ws_, s[2 * 33] * g0.z * ws_, s[3 * 33] * g0.w * ws_);
            o8.y = pk4_fp8(s[4 * 33] * g1.x * ws_, s[5 * 33] * g1.y * ws_, s[6 * 33] * g1.z * ws_, s[7 * 33] * g1.w * ws_); *(u32x2*)((unsigned char*)jb.dst + (size_t)row * jb.K + k0 + 8 * c) = o8; }
        else *(u32x4*)(jb.dst + (size_t)row * jb.K + k0 + 8 * c) = o; }
    asm volatile("s_waitcnt lgkmcnt(0)" ::: "memory");
}
__device__ __forceinline__ void conv_item(const CJob& jb, LAS float* scr, int item, int lane) { f32x4 v[8]; conv_load(jb, item, lane, v); conv_finish(jb, scr, item, lane, v); }
__device__ __forceinline__ void conv_job(const CJob& jb, LAS float* scr, int gw, int ngw, int lane, int& base) {
    const int nit = (jb.K / 64) * (jb.N / 32);
    int first = gw - base; if (first < 0) first += ngw;
    for (int it = first; it < nit; it += ngw) conv_item(jb, scr, it, lane);
    base = (base + nit) % ngw;
}
__device__ __forceinline__ CJob static_job(KP P, int j) {
    CJob jb; jb.pad = 0; jb.gain = nullptr; jb.mode = 0; jb.fp8 = 0; jb.wscale = 1.f; jb.ldw = 0; jb.col0 = 0;
    if (j >= 30 + 128) { const int l = j - (30 + 128);
        jb.W = P->in[3] + (size_t)l * DM * NIN; jb.gain = P->in[2] + l * DM; jb.dst = (bf16*)(P->ws + WS_WIN + (size_t)l * NIN * DM * 2 + (size_t)NIN_A * DM * 2); jb.K = DM; jb.N = NIN_B; jb.mode = 3; jb.fp8 = 1; jb.wscale = WIN_SCALE; jb.ldw = NIN; jb.col0 = C_LG; return jb; }
    if (j < 24) { const int l = j / 6, k = j % 6;
        if (k == 0) { jb.W = P->in[3] + (size_t)l * DM * NIN; jb.gain = P->in[2] + l * DM; jb.dst = (bf16*)(P->ws + WS_WIN + (size_t)l * NIN * DM * (INPROJ_FP8 ? 1 : 2)); jb.K = DM; jb.N = INPROJ_GATES_FP8 ? NIN_A : NIN; jb.ldw = NIN; jb.mode = 3; jb.fp8 = (INPROJ_FP8 || ((INPROJ_FP8_MASK >> l) & 1)) ? 1 : 0; jb.wscale = jb.fp8 ? WIN_SCALE : 1.f; }
        else if (k == 1) { jb.W = P->in[15] + (size_t)l * DM * DM; jb.dst = (bf16*)(P->ws + WS_WPA) + (size_t)l * DM * DM; jb.K = DM; jb.N = DM; jb.fp8 = (MERGE_FP8_MASK >> l) & 1; jb.wscale = jb.fp8 ? WIN_SCALE : 1.f; }
        else if (k == 2) { jb.W = P->in[16] + (size_t)l * DM * DM; jb.dst = (bf16*)(P->ws + WS_WPB) + (size_t)l * DM * DM; jb.K = DM; jb.N = DM; jb.fp8 = (MERGE_FP8_MASK >> l) & 1; jb.wscale = jb.fp8 ? WIN_SCALE : 1.f; }
        else if (k == 3) { jb.W = P->in[17] + (size_t)l * DM * DM; jb.dst = (bf16*)(P->ws + WS_WOUT) + (size_t)l * DM * DM; jb.K = DM; jb.N = DM; jb.fp8 = (OUT_FP8_MASK >> l) & 1; jb.wscale = jb.fp8 ? WIN_SCALE : 1.f; }
        else if (k == 4) { jb.W = P->in[28] + (size_t)l * DM * DM; jb.gain = P->in[27] + l * DM; jb.dst = (bf16*)(P->ws + WS_WPG) + (size_t)l * DM * DM; jb.K = DM; jb.N = DM; jb.fp8 = (PLE_FP8_MASK >> l) & 1; jb.wscale = jb.fp8 ? WIN_SCALE : 1.f; }
        else { jb.W = P->in[29] + (size_t)l * PLE * DM; jb.dst = (bf16*)(P->ws + WS_WPP) + (size_t)l * DM * PLE; jb.K = PLE; jb.N = DM; }
    } else if (j >= 30) { const int idx = j - 30, l = idx >> 5, mat = (idx >> 4) & 1, n = idx & 15;
        jb.W = P->in[mat ? 12 : 10] + (size_t)(l * 16 + n) * 64 * 64; jb.dst = (bf16*)(P->ws + WS_LRUW) + (size_t)((l * 2 + mat) * 16 + n) * 64 * 64; jb.K = 64; jb.N = 64;
    } else { const int j2 = (j - 24) / 3, k = (j - 24) % 3;
        const bool f8 = (DENSE_FP8_MASK >> j2) & 1;
        if (k < 2) { jb.W = P->in[19 + k] + (size_t)j2 * DM * DFF; jb.gain = P->in[18] + (2 * j2) * DM; jb.dst = (bf16*)(P->ws + WS_W13D) + (size_t)j2 * 2 * DFF * DM; jb.K = DM; jb.N = DFF; jb.mode = 4 + k; jb.fp8 = f8; jb.wscale = f8 ? W13_SCALE : 1.f; }
        else { jb.W = P->in[21] + (size_t)j2 * DFF * DM; jb.dst = (bf16*)(P->ws + WS_W2D) + (size_t)j2 * DM * DFF; jb.K = DFF; jb.N = DM; jb.fp8 = f8; jb.wscale = f8 ? W2_SCALE : 1.f; }
    }
    if (jb.ldw == 0) jb.ldw = jb.N;
    return jb;
}
__device__ __forceinline__ CJob moe_job(KP P, int j2, int j) {
    CJob jb; jb.pad = 0; jb.gain = nullptr; jb.mode = 0; jb.fp8 = MOE_FP8 ? 1 : 0; jb.wscale = 1.f; jb.col0 = 0; const int e = j / 3, k = j % 3;
    if (k < 2) { jb.W = P->in[24 + k] + ((size_t)j2 * NEXP + e) * DM * DFF; jb.gain = P->in[18] + (2 * j2 + 1) * DM; jb.dst = (bf16*)(P->ws + WS_W13E + (size_t)e * 2 * DFF * DM * (MOE_FP8 ? 1 : 2)); jb.K = DM; jb.N = DFF; jb.mode = 4 + k; jb.wscale = MOE_FP8 ? W13_SCALE : 1.f; }
    else { jb.W = P->in[26] + ((size_t)j2 * NEXP + e) * DFF * DM; jb.dst = (bf16*)(P->ws + WS_W2E + (size_t)e * DM * DFF * (MOE_FP8 ? 1 : 2)); jb.K = DFF; jb.N = DM; jb.wscale = MOE_FP8 ? W2_SCALE : 1.f; }
    jb.ldw = jb.N;
    return jb;
}
__device__ __forceinline__ void conv_static_all(KP P, const LAS int* pref, int njobs, LAS float* scr, int gw, int ngw, int lane) {
#define PREF_U(j_) __builtin_amdgcn_readfirstlane(pref[j_])
    const int NT = PREF_U(njobs); int fl = gw; if (fl >= NT) return;
    int job = 0; while (fl >= PREF_U(job + 1)) ++job;
    CJob jb = static_job(P, job); f32x4 v[8]; conv_load(jb, fl - PREF_U(job), lane, v);
    for (;;) { const int nx = fl + ngw; const bool has = nx < NT; CJob jn = jb; int jobn = job; f32x4 w[8];
        if (has) { while (nx >= PREF_U(jobn + 1)) ++jobn; jn = static_job(P, jobn); conv_load(jn, nx - PREF_U(jobn), lane, w); }
        conv_finish(jb, scr, fl - PREF_U(job), lane, v);
        if (!has) break;
        jb = jn; job = jobn; fl = nx;
#pragma unroll
        for (int i = 0; i < 8; ++i) v[i] = w[i]; }
#undef PREF_U
}
__device__ __forceinline__ void conv_moe_layer(KP P, int j2, LAS float* scr, int gw, int ngw, int lane) {
    constexpr int IT = (DM / 64) * (DFF / 32), NT = 24 * IT;
    int fl = gw; if (fl >= NT) return;
    CJob jb = moe_job(P, j2, fl / IT); f32x4 v[8]; conv_load(jb, fl % IT, lane, v);
    for (;;) { const int nx = fl + ngw; const bool has = nx < NT; CJob jn = jb; f32x4 w[8];
        if (has) { jn = moe_job(P, j2, nx / IT); conv_load(jn, nx % IT, lane, w); }
        conv_finish(jb, scr, fl % IT, lane, v);
        if (!has) break;
        jb = jn; fl = nx;
#pragma unroll
        for (int i = 0; i < 8; ++i) v[i] = w[i]; }
}
template <bool COMBINE> __device__ __forceinline__ void rowstats_row(const float* xrow, bf16* hbrow, float* ssq, const bf16* o1, const bf16* o2, int lane, unsigned char* h8row = nullptr) {
    float s[4];
#pragma unroll
    for (int j = 0; j < 4; ++j) { f32x4 v;
        if (COMBINE) v = unpack_lo(*((const u32x2*)hbrow + lane + 64 * j)) + unpack_lo(*((const u32x2*)o1 + lane + 64 * j)) + unpack_lo(*((const u32x2*)o2 + lane + 64 * j));
        else v = *((const f32x4*)xrow + lane + 64 * j);
        s[j] = (v.x * v.x + v.y * v.y) + (v.z * v.z + v.w * v.w);
        u32x2 o; o.x = cvt_pk_bf16(v.x, v.y); o.y = cvt_pk_bf16(v.z, v.w); *((u32x2*)hbrow + lane + 64 * j) = o;
        if (h8row) *((unsigned*)h8row + lane + 64 * j) = pk4_fp8(v.x, v.y, v.z, v.w); }
#pragma unroll
    for (int j = 0; j < 4; ++j) s[j] = wave_sum(s[j]);
    const float v = lane == 0 ? s[0] : lane == 1 ? s[1] : lane == 2 ? s[2] : lane == 3 ? s[3] : 0.f;
    if (lane < 16) ssq[lane] = v;
}

__device__ __forceinline__ void rowstats_x2(const float* xA, bf16* hA, float* ssqA, const float* xB, bf16* hB, float* ssqB, int lane) {
    f32x4 va[4], vb[4];
#pragma unroll
    for (int j = 0; j < 4; ++j) { va[j] = __builtin_nontemporal_load((const f32x4*)xA + lane + 64 * j); vb[j] = __builtin_nontemporal_load((const f32x4*)xB + lane + 64 * j); }
    float sa[4], sb[4];
#pragma unroll
    for (int j = 0; j < 4; ++j) { const f32x4 v = va[j], w = vb[j]; sa[j] = (v.x * v.x + v.y * v.y) + (v.z * v.z + v.w * v.w); sb[j] = (w.x * w.x + w.y * w.y) + (w.z * w.z + w.w * w.w);
        u32x2 o; o.x = cvt_pk_bf16(v.x, v.y); o.y = cvt_pk_bf16(v.z, v.w); *((u32x2*)hA + lane + 64 * j) = o; o.x = cvt_pk_bf16(w.x, w.y); o.y = cvt_pk_bf16(w.z, w.w); *((u32x2*)hB + lane + 64 * j) = o; }
#pragma unroll
    for (int j = 0; j < 4; ++j) { sa[j] = wave_sum(sa[j]); sb[j] = wave_sum(sb[j]); }
    const float ua = lane == 0 ? sa[0] : lane == 1 ? sa[1] : lane == 2 ? sa[2] : lane == 3 ? sa[3] : 0.f, ub = lane == 0 ? sb[0] : lane == 1 ? sb[1] : lane == 2 ? sb[2] : lane == 3 ? sb[3] : 0.f;
    if (lane < 16) { ssqA[lane] = ua; ssqB[lane] = ub; }
}
__device__ __forceinline__ void combine_rows2(bf16* hA, float* ssqA, const bf16* a1, const bf16* a2, bf16* hB, float* ssqB, const bf16* b1, const bf16* b2, int lane, unsigned char* h8A = nullptr, unsigned char* h8B = nullptr) {
    u32x2 ra[3][4], rb[3][4];
#pragma unroll
    for (int j = 0; j < 4; ++j) { ra[0][j] = *((const u32x2*)hA + lane + 64 * j); ra[1][j] = *((const u32x2*)a1 + lane + 64 * j); ra[2][j] = *((const u32x2*)a2 + lane + 64 * j);
                                  rb[0][j] = *((const u32x2*)hB + lane + 64 * j); rb[1][j] = *((const u32x2*)b1 + lane + 64 * j); rb[2][j] = *((const u32x2*)b2 + lane + 64 * j); }
    float sa[4], sb[4];
#pragma unroll
    for (int j = 0; j < 4; ++j) { const f32x4 v = unpack_lo(ra[0][j]) + unpack_lo(ra[1][j]) + unpack_lo(ra[2][j]), w = unpack_lo(rb[0][j]) + unpack_lo(rb[1][j]) + unpack_lo(rb[2][j]);
        sa[j] = (v.x * v.x + v.y * v.y) + (v.z * v.z + v.w * v.w); sb[j] = (w.x * w.x + w.y * w.y) + (w.z * w.z + w.w * w.w);
        u32x2 o; o.x = cvt_pk_bf16(v.x, v.y); o.y = cvt_pk_bf16(v.z, v.w); *((u32x2*)hA + lane + 64 * j) = o; o.x = cvt_pk_bf16(w.x, w.y); o.y = cvt_pk_bf16(w.z, w.w); *((u32x2*)hB + lane + 64 * j) = o;
        if (h8A) { *((unsigned*)h8A + lane + 64 * j) = pk4_fp8(v.x, v.y, v.z, v.w); *((unsigned*)h8B + lane + 64 * j) = pk4_fp8(w.x, w.y, w.z, w.w); } }
#pragma unroll
    for (int j = 0; j < 4; ++j) { sa[j] = wave_sum(sa[j]); sb[j] = wave_sum(sb[j]); }
    const float va = lane == 0 ? sa[0] : lane == 1 ? sa[1] : lane == 2 ? sa[2] : lane == 3 ? sa[3] : 0.f, vb = lane == 0 ? sb[0] : lane == 1 ? sb[1] : lane == 2 ? sb[2] : lane == 3 ? sb[3] : 0.f;
    if (lane < 16) { ssqA[lane] = va; ssqB[lane] = vb; }
}

__device__ __forceinline__ void cvt_p_bf16(const f32x4* src, u32x2* dst, int i0, int stride) {
    constexpr int N4 = M * PLE / 4; int i = i0;
    for (; i + 3 * stride < N4; i += 4 * stride) { f32x4 v[4];
#pragma unroll
        for (int k = 0; k < 4; ++k) v[k] = __builtin_nontemporal_load(src + i + k * stride);
#pragma unroll
        for (int k = 0; k < 4; ++k) { u32x2 o; o.x = cvt_pk_bf16(v[k].x, v[k].y); o.y = cvt_pk_bf16(v[k].z, v[k].w); dst[i + k * stride] = o; } }
    for (; i < N4; i += stride) { const f32x4 v = __builtin_nontemporal_load(src + i); u32x2 o; o.x = cvt_pk_bf16(v.x, v.y); o.y = cvt_pk_bf16(v.z, v.w); dst[i] = o; }
}

__device__ __forceinline__ int t5_bucket(int d) {
    if (d < 16) return d;
    return 16 + (d >= 19) + (d >= 21) + (d >= 24) + (d >= 27) + (d >= 31) + (d >= 35) + (d >= 40) + (d >= 46) + (d >= 52) + (d >= 59) + (d >= 67) + (d >= 77) + (d >= 87) + (d >= 99) + (d >= 113);
}
namespace attn {
typedef float f32x16 __attribute__((ext_vector_type(16)));
typedef short s16x4 __attribute__((ext_vector_type(4)));
constexpr int KIMG = 0, VIMG = 32768, RBT = 65536, LSCR = RBT + 3072, OST = RBT + 4096, LDS_BYTES = OST + 8 * 4096;
__device__ __forceinline__ int crow(int r, int hi) { return (r & 3) + 8 * (r >> 2) + 4 * hi; }
__device__ __forceinline__ s16x4 vtr(const LAS unsigned char* p) { return __builtin_bit_cast(s16x4, __builtin_amdgcn_ds_read_tr16_b64_v4i16((LAS s16x4*)p)); }
__device__ __forceinline__ void attn_phase(LAS unsigned char* lds, const bf16* U, bf16* YA, const float* sinks, const float* rel_bias, int G, int c, int wbase, int y8) {
    const int tid = opaque_tid(wbase), lane = tid & 63, wid = __builtin_amdgcn_readfirstlane(tid >> 6), r32 = lane & 31, hi = lane >> 5;
    const int g = wid >> 1, qh = wid & 1; G = opaque_s(G); c = opaque_s(c);
    LAS float* rbt = (LAS float*)(lds + RBT); LAS float* lscr = (LAS float*)(lds + LSCR) + wid * 32; LAS bf16* stg = (LAS bf16*)(lds + OST + wid * 4096);
    int kvh_tab = -1;
    for (int L = c; L < BATCH * 32 * 4; L += G) {
        const int kvh = L & 3, n = (L >> 2) & 31, b = L >> 7;
        const int tok0 = b * SEQ + (n - 1) * 128;
        if (kvh != kvh_tab) { kvh_tab = kvh;
            for (int e = tid; e < 4 * 192; e += 512) { const int gg = e / 192, jj = e % 192, dist = 159 - jj;
                rbt[e] = (dist >= 0 && dist < 128) ? rel_bias[t5_bucket(dist) * 16 + kvh * 4 + gg] * LOG2E : -1.0e30f; } }
#pragma unroll
        for (int kg = 0; kg < 4; ++kg) { const int key = 64 * kg + lane; int t = tok0 + key; if (t < b * SEQ) t = b * SEQ;
            __builtin_amdgcn_global_load_lds((const unsigned*)(U + (size_t)t * NIN + C_K + kvh * 64 + 8 * wid), (LAS unsigned*)(lds + KIMG + wid * 4096 + kg * 1024), 16, 0, 0); }
#pragma unroll
        for (int j = 0; j < 4; ++j) { const int kg16 = 4 * (wid & 3) + j, key = 16 * kg16 + (lane >> 2); int t = tok0 + key; if (t < b * SEQ) t = b * SEQ;
            __builtin_amdgcn_global_load_lds((const unsigned*)(U + (size_t)t * NIN + C_V + kvh * 64 + 32 * (wid >> 2) + 8 * (lane & 3)), (LAS unsigned*)(lds + VIMG + (wid >> 2) * 16384 + kg16 * 1024), 16, 0, 0); }
        const size_t mq0 = (size_t)b * SEQ + n * 128 + 64 * qh;
        bf16x8 qf[2][4];
#pragma unroll
        for (int qt = 0; qt < 2; ++qt)
#pragma unroll
            for (int d0 = 0; d0 < 4; ++d0) qf[qt][d0] = *(const bf16x8*)(U + (mq0 + 32 * qt + r32) * NIN + (kvh * 4 + g) * 64 + 16 * d0 + 8 * hi);
        asm volatile("s_waitcnt vmcnt(0)" ::: "memory"); __syncthreads();
        const float sink2 = sinks[kvh * 4 + g] * LOG2E; const LAS float* bt = rbt + g * 192 + 31 - r32 + 4 * hi;
#pragma unroll
        for (int qt = 0; qt < 2; ++qt) {
            const int iq0 = 64 * qh + 32 * qt, kt0 = iq0 >> 5; const size_t mq = mq0 + 32 * qt;
            f32x16 p[5];
#pragma unroll
            for (int jt = 0; jt < 5; ++jt) { f32x16 a = {};
#pragma unroll
                for (int d0 = 0; d0 < 4; ++d0) { const bf16x8 kf = *(const LAS bf16x8*)(lds + KIMG + (2 * d0 + hi) * 4096 + (32 * (kt0 + jt) + r32) * 16); a = __builtin_amdgcn_mfma_f32_32x32x16_bf16(kf, qf[qt][d0], a, 0, 0, 0); }
                p[jt] = a; }
            float mx = sink2;
#pragma unroll
            for (int jt = 0; jt < 5; ++jt)
#pragma unroll
                for (int r = 0; r < 16; ++r) { float s = p[jt][r] + bt[32 * jt + (r & 3) + 8 * (r >> 2)];
                    if (n == 0) { if (32 * (kt0 + jt) + crow(r, hi) < 128) s = -1.0e30f; }
                    p[jt][r] = s; mx = fmaxf(mx, s); }
            mx = max_x32(mx);
            float l = 0.f;
#pragma unroll
            for (int jt = 0; jt < 5; ++jt)
#pragma unroll
                for (int r = 0; r < 16; ++r) { const float e = __builtin_amdgcn_exp2f(p[jt][r] - mx); p[jt][r] = e; l += e; }
            l = sum_x32(l); l += __builtin_amdgcn_exp2f(sink2 - mx);
            f32x16 o[2]; o[0] = (f32x16){}; o[1] = (f32x16){};
            const LAS unsigned char* vb = lds + VIMG + ((lane >> 4) & 1) * 32 + (lane & 3) * 8 + (4 * hi + ((lane & 15) >> 2)) * 64;
#pragma unroll
            for (int jt = 0; jt < 5; ++jt)
#pragma unroll
                for (int s = 0; s < 2; ++s) { u32x4 w; w.x = cvt_pk_bf16(p[jt][8 * s], p[jt][8 * s + 1]); w.y = cvt_pk_bf16(p[jt][8 * s + 2], p[jt][8 * s + 3]); w.z = cvt_pk_bf16(p[jt][8 * s + 4], p[jt][8 * s + 5]); w.w = cvt_pk_bf16(p[jt][8 * s + 6], p[jt][8 * s + 7]);
                    const bf16x8 pa = __builtin_bit_cast(bf16x8, w);
#pragma unroll
                    for (int d0 = 0; d0 < 2; ++d0) { const LAS unsigned char* vp = vb + d0 * 16384 + (32 * (kt0 + jt) + 16 * s) * 64; const s16x4 lo = vtr(vp), hv = vtr(vp + 8 * 64);
                        const bf16x8 vf = (bf16x8){lo[0], lo[1], lo[2], lo[3], hv[0], hv[1], hv[2], hv[3]};
                        o[d0] = __builtin_amdgcn_mfma_f32_32x32x16_bf16(pa, vf, o[d0], 0, 0, 0); } }
            if (hi == 0) lscr[r32] = l;
            asm volatile("s_waitcnt lgkmcnt(0)" ::: "memory");
#pragma unroll
            for (int r = 0; r < 16; r += 2) { const int qi = crow(r, hi); const float rl0 = __builtin_amdgcn_rcpf(lscr[qi]), rl1 = __builtin_amdgcn_rcpf(lscr[qi + 1]);
                const unsigned w0 = cvt_pk_bf16(o[0][r] * rl0, o[0][r + 1] * rl1), w1 = cvt_pk_bf16(o[1][r] * rl0, o[1][r + 1] * rl1);
                stg[qi * 64 + r32] = (bf16)(w0 & 0xffffu); stg[(qi + 1) * 64 + r32] = (bf16)(w0 >> 16); stg[qi * 64 + 32 + r32] = (bf16)(w1 & 0xffffu); stg[(qi + 1) * 64 + 32 + r32] = (bf16)(w1 >> 16); }
            asm volatile("s_waitcnt lgkmcnt(0)" ::: "memory");
#pragma unroll
            for (int i = 0; i < 4; ++i) { const int row = 8 * i + (lane >> 3), chn = lane & 7;
                const u32x4 sv = *(const LAS u32x4*)(stg + row * 64 + 8 * chn);
                if (y8) { f32x4 a0, a1; pg8::unpack8(sv, a0, a1); a0 = a0 * Y8_SCALE; a1 = a1 * Y8_SCALE; u32x2 w8; w8.x = pk4_fp8(a0[0], a0[1], a0[2], a0[3]); w8.y = pk4_fp8(a1[0], a1[1], a1[2], a1[3]);
                    *(u32x2*)((unsigned char*)YA + (mq + row) * DM + (kvh * 4 + g) * 64 + 8 * chn) = w8; }
                else *(u32x4*)(YA + (mq + row) * DM + (kvh * 4 + g) * 64 + 8 * chn) = sv; }
            asm volatile("s_waitcnt lgkmcnt(0)" ::: "memory");
        }
        __syncthreads();
    }
}
}

namespace lru {
typedef float f32x16 __attribute__((ext_vector_type(16)));
constexpr int TC = 128, NCK = SEQ / TC, NUNIT = BATCH * 16 * NCK, CW_BYTES = 5 * 64 * 4, ST_BYTES = 2 * 32 * 128, WAVE_LDS = ST_BYTES + CW_BYTES + 256, WL_OFF = 8 * WAVE_LDS, WL_ROW = 144;
__device__ __forceinline__ int crow(int r, int hi) { return (r & 3) + 8 * (r >> 2) + 4 * hi; }
__device__ __forceinline__ void lru_scan(LAS unsigned char* lds, const bf16* U, bf16* HR, bf16* PQ, float* AGG, const bf16* Wt, const float* conv_w, const float* conv_b,
                                         const float* b_rg, const float* b_ig, const float* lam, int G, int c, int wbase) {
    const int tid = opaque_tid(wbase), lane = tid & 63, wid = __builtin_amdgcn_readfirstlane(tid >> 6), r32 = lane & 31, hi = lane >> 5; G = opaque_s(G); c = opaque_s(c);
    LAS unsigned char* wl = lds + wid * WAVE_LDS; LAS bf16* stH = (LAS bf16*)wl; LAS bf16* stP = (LAS bf16*)(wl + 32 * 128);
    LAS float* cw = (LAS float*)(wl + ST_BYTES);
    int nb_l = -1;
    for (int un = c * 8 + wid; un < NUNIT; un += G * 8) {
        const int ck = un & (NCK - 1), nb = (un >> 5) & 15, b = un >> 9, ch0 = nb * 64;
        if (nb != nb_l) {
            __syncthreads();
#pragma unroll
            for (int j = 0; j < 2; ++j) { const int p = tid + 512 * j, row = p >> 3, seg = p & 7;
                *(LAS u32x4*)(lds + WL_OFF + row * WL_ROW + seg * 16) = *(const u32x4*)(Wt + (size_t)(row >> 6) * 16 * 64 * 64 + (size_t)(nb * 64 + (row & 63)) * 64 + seg * 8); }
            __syncthreads(); nb_l = nb; }
#pragma unroll
        for (int j = 0; j < 4; ++j) cw[j * 64 + lane] = conv_w[j * DM + ch0 + lane];
        cw[4 * 64 + lane] = conv_b[ch0 + lane];
        float brg[2], big[2], sp8[2], carry[2], prodA[2];
#pragma unroll
        for (int ct = 0; ct < 2; ++ct) { const int ch = ch0 + 32 * ct + r32; brg[ct] = b_rg[ch] * -LOG2E; big[ct] = b_ig[ch] * -LOG2E; { const float x = fast_exp(-lam[ch]); sp8[ct] = (-8.f * LOG2E) * (x < 0.25f ? x * (1.f - x * (0.5f - x * ((1.f / 3.f) - x * (0.25f - x * (0.2f - x * (1.f / 6.f)))))) : (__builtin_amdgcn_logf(1.f + x) * 0.6931471805599453f)); } carry[ct] = 0.f; prodA[ct] = 1.f; }
        asm volatile("s_waitcnt lgkmcnt(0)" ::: "memory");
        u32x4 raw[4][4];
#define LRU_LOAD_RAW(st_) do { const int t_ = ck * TC + (st_) * 32 + r32; const size_t m_ = (size_t)b * SEQ + t_; _Pragma("unroll") for (int ks = 0; ks < 4; ++ks) _Pragma("unroll") for (int j = 0; j < 4; ++j) { \
            const int back_ = 3 - j; const size_t mm_ = (t_ >= back_) ? m_ - back_ : m_; raw[ks][j] = *(const u32x4*)(U + mm_ * NIN + C_LX + ch0 + 16 * ks + 8 * hi); } } while (0)
        LRU_LOAD_RAW(0);
        for (int st = 0; st < 4; ++st) {
            const int t0 = ck * TC + st * 32, t = t0 + r32;
            bf16x8 af[4];
#pragma unroll
            for (int ks = 0; ks < 4; ++ks) { const int cl = 16 * ks + 8 * hi; f32x4 x0 = *(const LAS f32x4*)(cw + 256 + cl), x1 = *(const LAS f32x4*)(cw + 256 + cl + 4);
#pragma unroll
                for (int j = 0; j < 4; ++j) { const int back = 3 - j; const bool ok = t >= back;
                    f32x4 v0, v1; pg8::unpack8(raw[ks][j], v0, v1);
                    const f32x4 w0 = *(const LAS f32x4*)(cw + j * 64 + cl), w1 = *(const LAS f32x4*)(cw + j * 64 + cl + 4);
                    if (ok) { x0 = x0 + w0 * v0; x1 = x1 + w1 * v1; } }
                af[ks] = __builtin_bit_cast(bf16x8, pg8::pack8(x0, x1)); }
            if (st < 3) LRU_LOAD_RAW(st + 1);
#pragma unroll
            for (int ct = 0; ct < 2; ++ct) {
                f32x16 R = {}, I = {}, X = {};
                int zoff; asm volatile("v_mov_b32 %0, 0" : "=v"(zoff)); const LAS unsigned char* Wp = lds + WL_OFF + zoff;
                bf16x8 wr[4], wi[4];
#pragma unroll
                for (int ks = 0; ks < 4; ++ks) { const int o = (32 * ct + r32) * WL_ROW + (16 * ks + 8 * hi) * 2; wr[ks] = *(const LAS bf16x8*)(Wp + o); wi[ks] = *(const LAS bf16x8*)(Wp + 64 * WL_ROW + o); }
#pragma unroll
                for (int ks = 0; ks < 4; ++ks) { bf16x8 idf;
#pragma unroll
                    for (int j = 0; j < 8; ++j) idf[j] = (16 * ks + 8 * hi + j == 32 * ct + r32) ? (short)0x3F80 : (short)0;
                    R = __builtin_amdgcn_mfma_f32_32x32x16_bf16(af[ks], wr[ks], R, 0, 0, 0); I = __builtin_amdgcn_mfma_f32_32x32x16_bf16(af[ks], wi[ks], I, 0, 0, 0);
                    X = __builtin_amdgcn_mfma_f32_32x32x16_bf16(af[ks], idf, X, 0, 0, 0); }
                float P[16], H[16];
#pragma unroll
                for (int r = 0; r < 16; ++r) { const float er = __builtin_amdgcn_exp2f(R[r] * -LOG2E + brg[ct]), ei = __builtin_amdgcn_exp2f(I[r] * -LOG2E + big[ct]);
                    const float e1 = 1.f + er, e2 = 1.f + ei, qq = __builtin_amdgcn_rcpf(e1 * e2), rr = qq * e2, ii = qq * e1;
                    const float a = __builtin_amdgcn_exp2f(rr * sp8[ct]);
                    P[r] = a; H[r] = __builtin_amdgcn_sqrtf(fmaxf(1.f - a * a, 0.f)) * (ii * X[r]); }
                float Ag[4], Hg[4], Ao[4], Ho[4];
#pragma unroll
                for (int g4 = 0; g4 < 4; ++g4) {
#pragma unroll
                    for (int j = 1; j < 4; ++j) { H[4 * g4 + j] = P[4 * g4 + j] * H[4 * g4 + j - 1] + H[4 * g4 + j]; P[4 * g4 + j] = P[4 * g4 + j] * P[4 * g4 + j - 1]; }
                    Ag[g4] = P[4 * g4 + 3]; Hg[g4] = H[4 * g4 + 3]; Ao[g4] = get_x32(Ag[g4], hi); Ho[g4] = get_x32(Hg[g4], hi); }
                float C = carry[ct], PC = prodA[ct], Cm[4], Pm[4];
#pragma unroll
                for (int g4 = 0; g4 < 4; ++g4) { const float A0 = hi ? Ao[g4] : Ag[g4], H0 = hi ? Ho[g4] : Hg[g4], A1 = hi ? Ag[g4] : Ao[g4], H1 = hi ? Hg[g4] : Ho[g4];
                    const float C1 = A0 * C + H0, P1 = PC * A0; Cm[g4] = hi ? C1 : C; Pm[g4] = hi ? P1 : PC; C = A1 * C1 + H1; PC = P1 * A1; }
                carry[ct] = C; prodA[ct] = PC;
#pragma unroll
                for (int r = 0; r < 16; r += 2) { const int o = crow(r, hi) * 64 + 32 * ct + r32;
                    const unsigned wh = cvt_pk_bf16(H[r] + P[r] * Cm[r >> 2], H[r + 1] + P[r + 1] * Cm[r >> 2]), wp = cvt_pk_bf16(P[r] * Pm[r >> 2], P[r + 1] * Pm[r >> 2]);
                    stH[o] = (bf16)(wh & 0xffffu); stH[o + 64] = (bf16)(wh >> 16); stP[o] = (bf16)(wp & 0xffffu); stP[o + 64] = (bf16)(wp >> 16); }
            }
            asm volatile("s_waitcnt lgkmcnt(0)" ::: "memory");
#pragma unroll
            for (int i = 0; i < 4; ++i) { const int row = (lane >> 3) + 8 * i, chn = lane & 7; const size_t go = ((size_t)b * SEQ + t0 + row) * DM + ch0 + 8 * chn;
                *(u32x4*)(HR + go) = *(const LAS u32x4*)(stH + row * 64 + 8 * chn); *(u32x4*)(PQ + go) = *(const LAS u32x4*)(stP + row * 64 + 8 * chn); }
            asm volatile("s_waitcnt lgkmcnt(0)" ::: "memory");
        }
        if (hi == 0) {
#pragma unroll
            for (int ct = 0; ct < 2; ++ct) *(f32x2*)(AGG + ((size_t)(b * NCK + ck) * DM + ch0 + 32 * ct + r32) * 2) = (f32x2){prodA[ct], carry[ct]};
        }
    }
}
#undef LRU_LOAD_RAW
template <bool F8> __device__ __forceinline__ void lru_apply(const bf16* U, const bf16* HR, const bf16* PQ, const float* AGG, bf16* YB, int G, int c, int wbase) {
    const int tid = opaque_tid(wbase); G = opaque_s(G); c = opaque_s(c); const int ch = 8 * (tid & 127), tq = tid >> 7;
    for (int cu = c; cu < BATCH * NCK; cu += G) { const int b = cu / NCK, ck = cu % NCK;
        f32x4 c0 = {}, c1 = {};
        int j = 0;
        for (; j + 8 <= ck; j += 8) { f32x4 p[8][4];
#pragma unroll
            for (int k = 0; k < 8; ++k) { const f32x4* ap = (const f32x4*)(AGG + ((size_t)(b * NCK + j + k) * DM + ch) * 2); p[k][0] = ap[0]; p[k][1] = ap[1]; p[k][2] = ap[2]; p[k][3] = ap[3]; }
#pragma unroll
            for (int k = 0; k < 8; ++k) { c0 = (f32x4){p[k][0].x * c0.x + p[k][0].y, p[k][0].z * c0.y + p[k][0].w, p[k][1].x * c0.z + p[k][1].y, p[k][1].z * c0.w + p[k][1].w};
                                          c1 = (f32x4){p[k][2].x * c1.x + p[k][2].y, p[k][2].z * c1.y + p[k][2].w, p[k][3].x * c1.z + p[k][3].y, p[k][3].z * c1.w + p[k][3].w}; } }
        for (; j < ck; ++j) { const f32x4* ap = (const f32x4*)(AGG + ((size_t)(b * NCK + j) * DM + ch) * 2); const f32x4 p0 = ap[0], p1 = ap[1], p2 = ap[2], p3 = ap[3];
            c0 = (f32x4){p0.x * c0.x + p0.y, p0.z * c0.y + p0.w, p1.x * c0.z + p1.y, p1.z * c0.w + p1.w}; c1 = (f32x4){p2.x * c1.x + p2.y, p2.z * c1.y + p2.w, p3.x * c1.z + p3.y, p3.z * c1.w + p3.w}; }
        for (int i = 0; i < 32; i += 4) { u32x4 hv[4], qv[4], gv[4];
#pragma unroll
            for (int k = 0; k < 4; ++k) { const size_t m = (size_t)b * SEQ + ck * TC + tq + 4 * (i + k); hv[k] = *(const u32x4*)(HR + m * DM + ch); qv[k] = *(const u32x4*)(PQ + m * DM + ch); gv[k] = *(const u32x4*)(U + m * NIN + C_LG + ch); }
#pragma unroll
            for (int k = 0; k < 4; ++k) { const size_t m = (size_t)b * SEQ + ck * TC + tq + 4 * (i + k); f32x4 h0, h1, q0, q1, g0, g1; pg8::unpack8(hv[k], h0, h1); pg8::unpack8(qv[k], q0, q1); pg8::unpack8(gv[k], g0, g1);
                if (F8) { const f32x4 y0 = (h0 + q0 * c0) * g0 * Y8_SCALE, y1 = (h1 + q1 * c1) * g1 * Y8_SCALE; u32x2 w8; w8.x = pk4_fp8(y0[0], y0[1], y0[2], y0[3]); w8.y = pk4_fp8(y1[0], y1[1], y1[2], y1[3]);
                    *(u32x2*)((unsigned char*)YB + m * DM + ch) = w8; }
                else *(u32x4*)(YB + m * DM + ch) = pg8::pack8((h0 + q0 * c0) * g0, (h1 + q1 * c1) * g1); } }
    }
}
}

namespace moe {
constexpr int NCHUNK = M / 128;
__device__ __forceinline__ void route_a(LAS unsigned char* lds, const bf16* h, const float* ssq, const float* gain, const float* rw, const float* rb, int* sel, float* selw, int* CNT, int G, int c, int wbase) {
    const int tid = opaque_tid(wbase), lane = tid & 63, wid = __builtin_amdgcn_readfirstlane(tid >> 6); LAS int* lc = (LAS int*)lds; G = opaque_s(G); c = opaque_s(c);
    f32x4 wg[4][4][2];
#pragma unroll
    for (int j = 0; j < 4; ++j) { const f32x4 gk = *(const f32x4*)(gain + 4 * lane + 256 * j);
#pragma unroll
        for (int q = 0; q < 4; ++q) { const float* wp = rw + (size_t)(4 * lane + 256 * j + q) * 8; wg[j][q][0] = *(const f32x4*)wp * gk[q]; wg[j][q][1] = *(const f32x4*)(wp + 4) * gk[q]; } }
    float rbv[8];
#pragma unroll
    for (int e = 0; e < 8; ++e) rbv[e] = rb[e];
    for (int chunk = c; chunk < NCHUNK; chunk += G) {
        if (tid < 8) lc[tid] = 0;
        __syncthreads();
        for (int i0 = 0; i0 < 16; i0 += 2) {
            u32x2 hx[2][4]; f32x4 sq[2];
#pragma unroll
            for (int u = 0; u < 2; ++u) { const int m = chunk * 128 + wid * 16 + i0 + u; const u32x2* hp = (const u32x2*)(h + (size_t)m * DM) + lane;
#pragma unroll
                for (int j = 0; j < 4; ++j) hx[u][j] = hp[64 * j];
                sq[u] = *(const f32x4*)(ssq + 16 * (size_t)m + 4 * (lane & 3)); }
#pragma unroll
            for (int u = 0; u < 2; ++u) { const int m = chunk * 128 + wid * 16 + i0 + u; f32x4 a0 = {}, a1 = {};
#pragma unroll
                for (int j = 0; j < 4; ++j) { const f32x4 x = unpack_lo(hx[u][j]);
#pragma unroll
                    for (int q = 0; q < 4; ++q) { a0 = a0 + wg[j][q][0] * x[q]; a1 = a1 + wg[j][q][1] * x[q]; } }
                float s = (sq[u].x + sq[u].y) + (sq[u].z + sq[u].w); s += swz_f<1>(s); s += swz_f<2>(s);
                const float rs = __builtin_amdgcn_rsqf(s * (1.f / 1024.f) + EPS); float acc[8] = {a0.x, a0.y, a0.z, a0.w, a1.x, a1.y, a1.z, a1.w};
#pragma unroll
                for (int e = 0; e < 8; ++e) acc[e] = wave_sum(acc[e]) * rs + rbv[e];
                int i1 = 0; float v1 = acc[0];
#pragma unroll
                for (int e = 1; e < 8; ++e) if (acc[e] > v1) { v1 = acc[e]; i1 = e; }
                int i2 = -1; float v2 = -3.0e38f;
#pragma unroll
                for (int e = 0; e < 8; ++e) if (e != i1 && acc[e] > v2) { v2 = acc[e]; i2 = e; }
                const float ex = fast_exp(v2 - v1), w1 = 1.f / (1.f + ex), w2 = ex / (1.f + ex);
                if (lane == 0) { sel[2 * m] = i1; sel[2 * m + 1] = i2; selw[2 * m] = w1; selw[2 * m + 1] = w2; atomicAdd((int*)(lc + i1), 1); atomicAdd((int*)(lc + i2), 1); }
            }
        }
        __syncthreads();
        if (tid < 8) CNT[chunk * 8 + tid] = lc[tid];
        __syncthreads();
    }
}
__device__ __forceinline__ void route_b(LAS unsigned char* lds, const int* sel, const float* selw, const float* ssq, const int* CNT, const bf16* hb, int* tok, float* srs, float* sgw, int* tslot, int* meta, bf16* XG, int G, int c, int wbase) {
    const int tid = opaque_tid(wbase), lane = tid & 63, wid = __builtin_amdgcn_readfirstlane(tid >> 6); G = opaque_s(G); c = opaque_s(c);
    LAS int* tot = (LAS int*)lds; LAS int* pre = tot + 8; LAS int* start = tot + 16; LAS int* pos = tot + 32; LAS float* rsl = (LAS float*)(tot + 32 + 256);
    for (int chunk = c; chunk < NCHUNK; chunk += G) {
        { int t = 0, p = 0;
#pragma unroll
          for (int j = 0; j < NCHUNK / 64; ++j) { const int ch = lane + 64 * j; const int v = CNT[ch * 8 + wid]; t += v; p += (ch < chunk) ? v : 0; }
          t += swz_i<1>(t); t += swz_i<2>(t); t += swz_i<4>(t); t += swz_i<8>(t); t += swz_i<16>(t); t = sum_x32i(t);
          p += swz_i<1>(p); p += swz_i<2>(p); p += swz_i<4>(p); p += swz_i<8>(p); p += swz_i<16>(p); p = sum_x32i(p);
          if (lane == 0) { tot[wid] = t; pre[wid] = p; } }
        __syncthreads();
        if (tid == 0) { int s = 0; for (int e = 0; e < 8; ++e) { start[e] = s; s += ((tot[e] + 255) >> 8) << 8; } start[8] = s; }
        __syncthreads();
        if (chunk == 0 && tid < 9) meta[tid] = start[tid] >> 8;
        if (wid == 0) {
            int run[8];
#pragma unroll
            for (int e = 0; e < 8; ++e) run[e] = start[e] + pre[e];
#pragma unroll
            for (int hf = 0; hf < 2; ++hf)
#pragma unroll
                for (int k = 0; k < 2; ++k) { const int m = chunk * 128 + hf * 64 + lane; const int e = sel[2 * m + k]; int p = 0;
#pragma unroll
                    for (int ee = 0; ee < 8; ++ee) { const unsigned long long mask = __ballot(e == ee); if (e == ee) p = run[ee] + __popcll(mask & ((1ull << lane) - 1ull)); run[ee] += __popcll(mask); }
                    const float rsm = rstd_of(ssq, m); tok[p] = m; srs[p] = rsm; sgw[p] = selw[2 * m + k]; tslot[2 * m + k] = p; pos[(hf * 2 + k) * 64 + lane] = p; rsl[(hf * 2 + k) * 64 + lane] = rsm; }
        }
        __syncthreads();
        for (int q0 = wid * 32; q0 < wid * 32 + 32; q0 += 4) {
            u32x4 r0[4], r1[4]; int pp[4]; float rr[4];
#pragma unroll
            for (int u = 0; u < 4; ++u) { const int q = q0 + u, m = chunk * 128 + (q >> 7) * 64 + (q & 63); pp[u] = pos[q]; rr[u] = rsl[q];
                if (MOE_FP8) { const u32x4* src = (const u32x4*)(hb + (size_t)m * DM) + 2 * lane; r0[u] = src[0]; r1[u] = src[1]; }
                else { const u32x4* src = (const u32x4*)(hb + (size_t)m * DM); r0[u] = src[lane]; r1[u] = src[lane + 64]; } }
#pragma unroll
            for (int u = 0; u < 4; ++u) {
                if (MOE_FP8) { const float rs = rr[u]; f32x4 a0, a1, b0, b1; pg8::unpack8(r0[u], a0, a1); pg8::unpack8(r1[u], b0, b1);
                    u32x4 o; o.x = pk4_fp8(a0.x * rs, a0.y * rs, a0.z * rs, a0.w * rs); o.y = pk4_fp8(a1.x * rs, a1.y * rs, a1.z * rs, a1.w * rs); o.z = pk4_fp8(b0.x * rs, b0.y * rs, b0.z * rs, b0.w * rs); o.w = pk4_fp8(b1.x * rs, b1.y * rs, b1.z * rs, b1.w * rs);
                    *((u32x4*)((unsigned char*)XG + (size_t)pp[u] * DM) + lane) = o; }
                else { u32x4* dst = (u32x4*)(XG + (size_t)pp[u] * DM); dst[lane] = r0[u]; dst[lane + 64] = r1[u]; } } }
        if (chunk == 0) {
            for (int e = 0; e < 8; ++e) { const int s0 = start[e] + tot[e], s1 = start[e + 1];
                for (int s = s0 + tid; s < s1; s += 512) { tok[s] = 0; srs[s] = 0.f; sgw[s] = 0.f; }
                unsigned z0; asm volatile("v_mov_b32 %0, 0" : "=v"(z0)); const u32x4 zz = (u32x4){z0, z0, z0, z0};
                for (int s = s0 + wid; s < s1; s += 8) { if (MOE_FP8) *((u32x4*)((unsigned char*)XG + (size_t)s * DM) + lane) = zz;
                    else { u32x4* dst = (u32x4*)(XG + (size_t)s * DM); dst[lane] = zz; dst[lane + 64] = zz; } } }
        }
        __syncthreads();
    }
}
}

#define XB_TMO      128
#define XB_XCNT(j)  (256  + 64 * (j))
#define XB_XSUB(j)  (1280 + 64 * (j))
#define XB_XGEN(j)  (2304 + 64 * (j))
#define XB_TOP      3328
#define XB_TOPGEN   3392
#define XCD_BAR_WORDS 3456
#define XB_SPIN_CAP (1u << 18)
__device__ __forceinline__ unsigned xb_ld(unsigned* p)              { return __hip_atomic_load(p, __ATOMIC_RELAXED, __HIP_MEMORY_SCOPE_AGENT); }
__device__ __forceinline__ unsigned xb_add(unsigned* p, unsigned v) { return __hip_atomic_fetch_add(p, v, __ATOMIC_RELAXED, __HIP_MEMORY_SCOPE_AGENT); }
__device__ __forceinline__ unsigned xb_xcc_id() { return (unsigned)__builtin_amdgcn_s_getreg((3 << 11) | 20) & 0xFu; }
#define XB_SPIN(cond, bar) do { unsigned _sp = 0; while (cond) { __builtin_amdgcn_s_sleep(1); \
    if ((++_sp & 255u) == 0u) { if (xb_ld(&(bar)[XB_TMO])) break; if (_sp > XB_SPIN_CAP) { atomicAdd(&(bar)[XB_TMO], 1u); break; } } } } while (0)
struct XcdBarrier { unsigned* bar; unsigned x; volatile LAS unsigned* st; };
__device__ __forceinline__ XcdBarrier xcd_barrier_post(unsigned* bar, volatile LAS unsigned* st) {
    XcdBarrier b; b.bar = bar; b.x = xb_xcc_id(); b.st = st;
    if (threadIdx.x == 0) (void)xb_add(&bar[XB_XCNT(b.x)], 1u);
    return b;
}
__device__ __forceinline__ void xcd_barrier_complete(unsigned* bar, unsigned x, unsigned& nloc, unsigned& nx) {
    const unsigned G = gridDim.x * gridDim.y * gridDim.z;
    unsigned sum, cnt, mine, sp = 0u;
    for (;;) {
        sum = 0u; cnt = 0u; mine = 0u;
#pragma unroll
        for (unsigned j = 0; j < 16; ++j) { const unsigned c = xb_ld(&bar[XB_XCNT(j)]); sum += c; cnt += (c > 0u) ? 1u : 0u; mine = (j == x) ? c : mine; }
        if (sum == G) break;
        __builtin_amdgcn_s_sleep(1);
        if ((++sp & 255u) == 0u) { if (xb_ld(&bar[XB_TMO])) break; if (sp > XB_SPIN_CAP) { atomicAdd(&bar[XB_TMO], 1u); break; } }
    }
    nloc = mine > 0u ? mine : 1u; nx = cnt > 0u ? cnt : 1u;
}
__device__ __forceinline__ void xcd_barrier(const XcdBarrier& b, bool leader) {
    asm volatile("s_waitcnt vmcnt(0)" ::: "memory");
    __syncthreads();
    if (leader) {
        unsigned zo_; asm volatile("v_mov_b32 %0, 0" : "=v"(zo_)); unsigned* bar = b.bar + zo_;
        __builtin_amdgcn_s_waitcnt(0);
        unsigned nloc = b.st[0], nx = b.st[1];
        if (nloc == 0u) { xcd_barrier_complete(bar, b.x, nloc, nx); b.st[0] = nloc; b.st[1] = nx; }
        const unsigned old = xb_add(&bar[XB_XSUB(b.x)], 1u);
        const unsigned gen = old / nloc;
        if (old + 1u == (gen + 1u) * nloc) {
            __builtin_amdgcn_fence(__ATOMIC_RELEASE, "agent");
            asm volatile("s_waitcnt vmcnt(0)" ::: "memory");
            const unsigned og = xb_add(&bar[XB_TOP], 1u);
            const unsigned tg = og / nx;
            if (og + 1u == (tg + 1u) * nx) xb_add(&bar[XB_TOPGEN], 1u);
            else XB_SPIN(xb_ld(&bar[XB_TOPGEN]) == tg, bar);
            __builtin_amdgcn_fence(__ATOMIC_ACQUIRE, "agent");
            xb_add(&bar[XB_XGEN(b.x)], 1u);
            asm volatile("s_waitcnt vmcnt(0)" ::: "memory");
        } else {
            XB_SPIN(xb_ld(&bar[XB_XGEN(b.x)]) == gen, bar);
            __builtin_amdgcn_fence(__ATOMIC_ACQUIRE, "agent");
            asm volatile("s_waitcnt vmcnt(0)" ::: "memory");
        }
    }
    __syncthreads();
}

constexpr int MEGA_LDS = 147456, LDSCTL_OFF = 131072;
constexpr int CW_BAR = 4096;
constexpr size_t CTL_ZERO_BYTES = 65536;

__device__ __forceinline__ KP kargs() { KP pp = (KP)__builtin_amdgcn_kernarg_segment_ptr(); asm volatile("" : "+s"(pp)); return pp; }
#define KIN(i) (kargs()->in[i])
#define KWS (kargs()->ws)
#define KOUT (kargs()->out)
#ifndef DUP_ID
#define DUP_ID 0
#define DUP_N 1
#endif
#define REP(id) for (int rep_ = 0; rep_ < ((DUP_ID == (id)) ? DUP_N : 1); ++rep_)
__global__ void __launch_bounds__(512, 2) mega(Ptrs Pdummy) {
    extern __shared__ __attribute__((aligned(16))) unsigned char lds_raw[];
    LAS unsigned char* lds = (LAS unsigned char*)lds_raw;
    const int G = (int)gridDim.x, c = (int)blockIdx.x, wbase = __builtin_amdgcn_readfirstlane((int)threadIdx.x) & ~63;
    { volatile LAS unsigned* MISC0 = (volatile LAS unsigned*)(lds + LDSCTL_OFF); if (threadIdx.x < 64) MISC0[threadIdx.x] = 0u; }
    __syncthreads();
    (void)xcd_barrier_post((unsigned*)(KWS + WS_CTL) + CW_BAR, (volatile LAS unsigned*)(lds + LDSCTL_OFF) + 8);
#define GRID_BAR() do { XcdBarrier b_; b_.bar = (unsigned*)(KWS + WS_CTL) + CW_BAR; b_.x = xb_xcc_id(); b_.st = (volatile LAS unsigned*)(lds + LDSCTL_OFF) + 8; xcd_barrier(b_, opaque_tid(wbase) == 0); } while (0)
#define HBUF(k) ((bf16*)(ws + ((k) ? WS_HB2 : WS_HB)))
#define SBUF(k) ((float*)(ws + WS_SSQ) + ((k) ? (size_t)16 * M : (size_t)0))
#define WAVE_IDS() const int tid = opaque_tid(wbase), lane = tid & 63, wid = __builtin_amdgcn_readfirstlane(tid >> 6), gw = c * 8 + wid, ngw = G * 8; (void)tid; (void)lane; (void)gw; (void)ngw

    REP(1) { WAVE_IDS(); const KP P = kargs(); unsigned char* ws = P->ws; LAS float* scr = (LAS float*)(lds + wid * 16384);
      { constexpr int NJ = 30 + 128 + (INPROJ_GATES_FP8 ? DEPTH : 0); LAS int* pref = (LAS int*)(lds + 9216);
        if (tid < NJ) { const CJob jb = static_job(P, tid); pref[512 + tid] = (jb.K / 64) * (jb.N / 32); }
        __syncthreads();
        if (tid == 0) { int s = 0; for (int j = 0; j < NJ; ++j) { pref[j] = s; s += pref[512 + j]; } pref[NJ] = s; }
        __syncthreads();
        conv_static_all(P, pref, NJ, scr, gw, ngw, lane); }
      if ((INPROJ_FP8 || INPROJ_GATES_FP8)) { for (int m = gw; m < M; m += ngw) rowstats_row<false>(P->in[0] + (size_t)m * DM, HBUF(0) + (size_t)m * DM, SBUF(0) + 16 * (size_t)m, nullptr, nullptr, lane, ws + WS_HB8 + (size_t)m * DM); }
      else for (int m = gw; m < M; m += 2 * ngw) { const int m2 = m + ngw;
          if (m2 >= M) { rowstats_row<false>(P->in[0] + (size_t)m * DM, HBUF(0) + (size_t)m * DM, SBUF(0) + 16 * (size_t)m, nullptr, nullptr, lane); break; }
          rowstats_x2(P->in[0] + (size_t)m * DM, HBUF(0) + (size_t)m * DM, SBUF(0) + 16 * (size_t)m, P->in[0] + (size_t)m2 * DM, HBUF(0) + (size_t)m2 * DM, SBUF(0) + 16 * (size_t)m2, lane); }
      bf16* PB = (bf16*)(ws + WS_PB);
      cvt_p_bf16((const f32x4*)P->in[1], (u32x2*)PB, c * 512 + tid, G * 512); }
    GRID_BAR();

    if (DUP_ID == 20) for (int rep_ = 0; rep_ < DUP_N; ++rep_) GRID_BAR();
    int hc = 0, sc = 0;
    for (int l = 0; l < DEPTH; ++l) {
        if ((INPROJ_FP8_MASK >> opaque_s(l)) & 1) {
          REP(2) { unsigned char* ws = KWS; pg8::Gemm g{(const bf16*)(ws + WS_HB8), (const bf16*)(ws + WS_WIN + (size_t)l * NIN * DM * 2), DM / 2, 0}; pg8::StaticOrder S; S.init(M, NIN, opaque_s(G), opaque_s(c));
            pg8::EpiInproj<false> E{(bf16*)(ws + WS_R + R_U), SBUF(sc), KIN(4) + l * 64, KIN(5) + l * 64, 0, 1.f / WIN_SCALE}; pg8::gemm_phase<pg8::EpiInproj<false>, pg8::StaticOrder, true, true, true>(lds, g, S, E, wbase); }
        } else
        REP(2) { unsigned char* ws = KWS; pg8::Gemm g{HBUF(hc), (const bf16*)(ws + WS_WIN + (size_t)l * NIN * DM * 2), DM, 0}; pg8::StaticOrder S; S.init(M, INPROJ_GATES_FP8 ? NIN_A : NIN, opaque_s(G), opaque_s(c));
          pg8::EpiInproj<false> E{(bf16*)(ws + WS_R + R_U), SBUF(sc), KIN(4) + l * 64, KIN(5) + l * 64, 0, 1.f}; pg8::gemm_phase<pg8::EpiInproj<false>, pg8::StaticOrder, true, true>(lds, g, S, E, wbase); }
        if (INPROJ_GATES_FP8) REP(2) { unsigned char* ws = KWS; pg8::Gemm g{(const bf16*)(ws + WS_HB8), (const bf16*)(ws + WS_WIN + (size_t)l * NIN * DM * 2 + (size_t)NIN_A * DM * 2), DM / 2, 0}; pg8::StaticOrder S; S.init(M, NIN_B, opaque_s(G), opaque_s(c));
          pg8::EpiInproj<true> E{(bf16*)(ws + WS_R + R_U), SBUF(sc), nullptr, nullptr, NIN_A / 256, 1.f / WIN_SCALE}; pg8::gemm_phase<pg8::EpiInproj<true>, pg8::StaticOrder, true, true, true>(lds, g, S, E, wbase); }
        REP(3) { unsigned char* ws = KWS; pg8::Gemm g{(const bf16*)(ws + WS_PB), (const bf16*)(ws + WS_WPP) + (size_t)l * DM * PLE, PLE, 0}; pg8::StaticOrder S; S.init(M, DM, opaque_s(G), opaque_s(c));
          pg8::EpiStore16 E{(bf16*)(ws + WS_PP), DM, 1.f}; pg8::gemm_phase<pg8::EpiStore16, pg8::StaticOrder, true, true>(lds, g, S, E, wbase); }
        GRID_BAR();
        const bool cf_ = (l & 1) && ((opaque_s(c) >> 3) & 1);
        if (cf_) { __syncthreads(); WAVE_IDS(); const KP P = kargs(); LAS float* scr = (LAS float*)(lds + wid * 16384); conv_moe_layer(P, l >> 1, scr, gw, ngw, lane); __syncthreads(); }
        REP(4) { unsigned char* ws = KWS; attn::attn_phase(lds, (const bf16*)(ws + WS_R + R_U), (bf16*)(ws + WS_R + R_YA), KIN(6) + l * 16, KIN(7), G, c, wbase, (MERGE_FP8_MASK >> opaque_s(l)) & 1); }
        REP(5) { unsigned char* ws = KWS; const bf16* Wt = (const bf16*)(ws + WS_LRUW) + (size_t)l * 2 * 16 * 64 * 64; __syncthreads();
          lru::lru_scan(lds, (const bf16*)(ws + WS_R + R_U), (bf16*)(ws + WS_R + R_HR), (bf16*)(ws + WS_R + R_PQ), (float*)(ws + WS_AGG), Wt, KIN(8) + l * 4 * DM, KIN(9) + l * DM, KIN(11) + l * DM, KIN(13) + l * DM, KIN(14) + l * DM, G, c, wbase); }
        if (l + 1 < DEPTH) REP(6) { unsigned char* ws = KWS; const f32x4* src = (const f32x4*)(KIN(1) + (size_t)(l + 1) * M * PLE); bf16* PB = (bf16*)(ws + WS_PB);
            cvt_p_bf16(src, (u32x2*)PB, opaque_s(c) * 512 + opaque_tid(wbase), G * 512); }
        if ((l & 1) && !cf_) REP(7) { __syncthreads(); WAVE_IDS(); const KP P = kargs(); LAS float* scr = (LAS float*)(lds + wid * 16384);
            conv_moe_layer(P, l >> 1, scr, gw, ngw, lane); }
        GRID_BAR();
        if ((MERGE_FP8_MASK >> opaque_s(l)) & 1) { unsigned char* ws = KWS; lru::lru_apply<true>((const bf16*)(ws + WS_R + R_U), (const bf16*)(ws + WS_R + R_HR), (const bf16*)(ws + WS_R + R_PQ), (const float*)(ws + WS_AGG), (bf16*)(ws + WS_R + R_YB), G, c, wbase); }
        else REP(8) { unsigned char* ws = KWS; lru::lru_apply<false>((const bf16*)(ws + WS_R + R_U), (const bf16*)(ws + WS_R + R_HR), (const bf16*)(ws + WS_R + R_PQ), (const float*)(ws + WS_AGG), (bf16*)(ws + WS_R + R_YB), G, c, wbase); }
        GRID_BAR();
        {
        if ((MERGE_FP8_MASK >> opaque_s(l)) & 1) {
          REP(9) { unsigned char* ws = KWS; pg8::Gemm g{(const bf16*)(ws + WS_R + R_YA), (const bf16*)(ws + WS_WPA) + (size_t)l * DM * DM, DM / 2, 0};
            pg8::MergeOrder S; S.A1 = (const bf16*)(ws + WS_R + R_YB); S.Bt1 = (const bf16*)(ws + WS_WPB) + (size_t)l * DM * DM; S.so.init(M, DM, opaque_s(G), opaque_s(c));
            pg8::EpiMerge<true> E{(bf16*)(ws + WS_R + R_MB), (const bf16*)(ws + WS_R + R_U), MB8_SCALE / (WIN_SCALE * Y8_SCALE), 0}; pg8::gemm_phase<pg8::EpiMerge<true>, pg8::MergeOrder, true, true, true>(lds, g, S, E, wbase); }
        } else if ((OUT_FP8_MASK & ~MERGE_FP8_MASK) != 0 && ((OUT_FP8_MASK >> opaque_s(l)) & 1)) { unsigned char* ws = KWS; pg8::Gemm g{(const bf16*)(ws + WS_R + R_YA), (const bf16*)(ws + WS_WPA) + (size_t)l * DM * DM, DM, 0};
          pg8::MergeOrder S; S.A1 = (const bf16*)(ws + WS_R + R_YB); S.Bt1 = (const bf16*)(ws + WS_WPB) + (size_t)l * DM * DM; S.so.init(M, DM, opaque_s(G), opaque_s(c));
          pg8::EpiMerge<true> E{(bf16*)(ws + WS_R + R_MB), (const bf16*)(ws + WS_R + R_U), MB8_SCALE, 0}; pg8::gemm_phase<pg8::EpiMerge<true>, pg8::MergeOrder, true, true>(lds, g, S, E, wbase); }
        else
        REP(9) { unsigned char* ws = KWS; pg8::Gemm g{(const bf16*)(ws + WS_R + R_YA), (const bf16*)(ws + WS_WPA) + (size_t)l * DM * DM, DM, 0};
          pg8::MergeOrder S; S.A1 = (const bf16*)(ws + WS_R + R_YB); S.Bt1 = (const bf16*)(ws + WS_WPB) + (size_t)l * DM * DM; S.so.init(M, DM, opaque_s(G), opaque_s(c));
          pg8::EpiMerge<false> E{(bf16*)(ws + WS_R + R_MB), (const bf16*)(ws + WS_R + R_U), 1.f, 0}; pg8::gemm_phase<pg8::EpiMerge<false>, pg8::MergeOrder, true, true>(lds, g, S, E, wbase); }
        GRID_BAR();
        if ((OUT_FP8_MASK >> opaque_s(l)) & 1) { unsigned char* ws = KWS; pg8::Gemm g{(const bf16*)(ws + WS_R + R_MB), (const bf16*)(ws + WS_WOUT) + (size_t)l * DM * DM, DM / 2, 0}; pg8::StaticOrder S; S.init(M, DM, opaque_s(G), opaque_s(c));
          pg8::EpiResid<0, 2> E{HBUF(hc), HBUF(hc), nullptr, SBUF(sc ^ 1), nullptr, nullptr, (l & 1) ? nullptr : ws + WS_HB8, 1.f / (WIN_SCALE * MB8_SCALE), 0}; pg8::gemm_phase<pg8::EpiResid<0, 2>, pg8::StaticOrder, true, true, true>(lds, g, S, E, wbase); }
        else
        for (int rep_ = 0; rep_ < ((DUP_ID == 10 && l == 0) ? DUP_N : 1); ++rep_) { unsigned char* ws = KWS; pg8::Gemm g{(const bf16*)(ws + WS_R + R_MB), (const bf16*)(ws + WS_WOUT) + (size_t)l * DM * DM, DM, 0}; pg8::StaticOrder S; S.init(M, DM, opaque_s(G), opaque_s(c));
          pg8::EpiResid<0> E{HBUF(hc), HBUF(hc), nullptr, SBUF(sc ^ 1), nullptr, nullptr, (!(l & 1) && ((DENSE_FP8_MASK >> (l >> 1)) & 1)) ? ws + WS_HB8 : nullptr, 1.f, 0}; pg8::gemm_phase<pg8::EpiResid<0>, pg8::StaticOrder, true, true>(lds, g, S, E, wbase); }
        }
        sc ^= 1;
        GRID_BAR();
        if (!(l & 1)) {
            if ((DENSE_FP8_MASK >> (l >> 1)) & 1) {
                REP(11) { unsigned char* ws = KWS; pg8::Gemm g{(const bf16*)(ws + WS_HB8), (const bf16*)(ws + WS_W13D) + (size_t)(l >> 1) * 2 * DFF * DM, DM / 2, 0}; pg8::StaticOrder S; S.init(M, 2 * DFF, opaque_s(G), opaque_s(c));
                  pg8::EpiSwiglu<false> E{(bf16*)(ws + WS_R + R_G), SBUF(sc), nullptr, nullptr, 1, 1.f / W13_SCALE}; pg8::gemm_phase<pg8::EpiSwiglu<false>, pg8::StaticOrder, true, true, true>(lds, g, S, E, wbase); }
                GRID_BAR();
                { unsigned char* ws = KWS; pg8::Gemm g{(const bf16*)(ws + WS_R + R_G), (const bf16*)(ws + WS_W2D) + (size_t)(l >> 1) * DM * DFF, DFF / 2, 0}; pg8::StaticOrder S; S.init(M, DM, opaque_s(G), opaque_s(c));
                  pg8::EpiResid<0> E{HBUF(hc), HBUF(hc), nullptr, SBUF(sc ^ 1), nullptr, nullptr, nullptr, 1.f / (W2_SCALE * G8_SCALE), 0}; pg8::gemm_phase<pg8::EpiResid<0>, pg8::StaticOrder, true, true, true>(lds, g, S, E, wbase); sc ^= 1; }
                GRID_BAR();
            } else {
                REP(11) { unsigned char* ws = KWS; pg8::Gemm g{HBUF(hc), (const bf16*)(ws + WS_W13D) + (size_t)(l >> 1) * 2 * DFF * DM, DM, 0}; pg8::StaticOrder S; S.init(M, 2 * DFF, opaque_s(G), opaque_s(c));
                  pg8::EpiSwiglu<false> E{(bf16*)(ws + WS_R + R_G), SBUF(sc), nullptr, nullptr, 0, 1.f}; pg8::gemm_phase<pg8::EpiSwiglu<false>, pg8::StaticOrder, true, true>(lds, g, S, E, wbase); }
                GRID_BAR();
                { unsigned char* ws = KWS; pg8::Gemm g{(const bf16*)(ws + WS_R + R_G), (const bf16*)(ws + WS_W2D) + (size_t)(l >> 1) * DM * DFF, DFF, 0}; pg8::StaticOrder S; S.init(M, DM, opaque_s(G), opaque_s(c));
                  pg8::EpiResid<0> E{HBUF(hc), HBUF(hc), nullptr, SBUF(sc ^ 1), nullptr, nullptr, nullptr, 1.f, 0}; pg8::gemm_phase<pg8::EpiResid<0>, pg8::StaticOrder, true, true>(lds, g, S, E, wbase); sc ^= 1; }
                GRID_BAR();
            }
        } else {
            REP(12) { unsigned char* ws = KWS; moe::route_a(lds, HBUF(hc), SBUF(sc), KIN(18) + l * DM, KIN(22) + (size_t)(l >> 1) * DM * NEXP, KIN(23) + (l >> 1) * NEXP, (int*)(ws + WS_SEL), (float*)(ws + WS_SEL + 256 * 1024), (int*)(ws + WS_SLOT + 964 * 1024), G, c, wbase); }
            GRID_BAR();
            REP(13) { unsigned char* ws = KWS; moe::route_b(lds, (const int*)(ws + WS_SEL), (const float*)(ws + WS_SEL + 256 * 1024), SBUF(sc), (const int*)(ws + WS_SLOT + 964 * 1024), HBUF(hc), (int*)(ws + WS_SLOT), (float*)(ws + WS_SLOT + 320 * 1024),
                                             (float*)(ws + WS_SLOT + 640 * 1024), (int*)(ws + WS_SEL + 512 * 1024), (int*)(ws + WS_SLOT + 960 * 1024), (bf16*)(ws + WS_R + R_XG), G, c, wbase); }
            GRID_BAR();
            REP(14) { unsigned char* ws = KWS; pg8::Gemm g{(const bf16*)(ws + WS_R + R_XG8), (const bf16*)(ws + WS_W13E), MOE_FP8 ? DM / 2 : DM, 0}; pg8::MoeOrder S; S.meta = (const int*)(ws + WS_SLOT + 960 * 1024); S.wstride = (size_t)2 * DFF * DM / (MOE_FP8 ? 2 : 1); S.N = 2 * DFF; S.pad0 = 0; S.setup(opaque_s(G), opaque_s(c));
              pg8::EpiSwiglu<true> E{(bf16*)(ws + WS_R + R_GM), nullptr, (const float*)(ws + WS_SLOT + 320 * 1024), (const float*)(ws + WS_SLOT + 640 * 1024), 0, 1.f}; pg8::gemm_phase<pg8::EpiSwiglu<true>, pg8::MoeOrder, true, true, MOE_FP8>(lds, g, S, E, wbase); }
            GRID_BAR();
            REP(15) { unsigned char* ws = KWS; pg8::Gemm g{(const bf16*)(ws + WS_R + R_GM), (const bf16*)(ws + WS_W2E), MOE_FP8 ? DFF / 2 : DFF, 0}; pg8::MoeOrder S; S.meta = (const int*)(ws + WS_SLOT + 960 * 1024); S.wstride = (size_t)DM * DFF / (MOE_FP8 ? 2 : 1); S.N = DM; S.pad0 = 0; S.setup(opaque_s(G), opaque_s(c));
              pg8::EpiStore16 E{(bf16*)(ws + WS_R + R_XG), DM, MOE_FP8 ? 1.f / (W2_SCALE * G8_SCALE) : 1.f}; pg8::gemm_phase<pg8::EpiStore16, pg8::MoeOrder, true, true, MOE_FP8>(lds, g, S, E, wbase); }
            GRID_BAR();
            { WAVE_IDS(); unsigned char* ws = KWS; const int* TSLOT = (const int*)(ws + WS_SEL + 512 * 1024); const bf16* XG = (const bf16*)(ws + WS_R + R_XG);
              for (int m = gw; m < M; m += 2 * ngw) { const int m2 = m + ngw;
                  if (m2 >= M) { rowstats_row<true>(nullptr, HBUF(hc) + (size_t)m * DM, SBUF(sc ^ 1) + 16 * (size_t)m, XG + (size_t)TSLOT[2 * m] * DM, XG + (size_t)TSLOT[2 * m + 1] * DM, lane); break; }
                  const int s1 = TSLOT[2 * m], s2 = TSLOT[2 * m + 1], s3 = TSLOT[2 * m2], s4 = TSLOT[2 * m2 + 1];
                  const bool p8 = (PLE_FP8_MASK >> l) & 1;
                  combine_rows2(HBUF(hc) + (size_t)m * DM, SBUF(sc ^ 1) + 16 * (size_t)m, XG + (size_t)s1 * DM, XG + (size_t)s2 * DM,
                                HBUF(hc) + (size_t)m2 * DM, SBUF(sc ^ 1) + 16 * (size_t)m2, XG + (size_t)s3 * DM, XG + (size_t)s4 * DM, lane,
                                p8 ? ws + WS_HB8 + (size_t)m * DM : nullptr, p8 ? ws + WS_HB8 + (size_t)m2 * DM : nullptr); } }
            sc ^= 1;
            GRID_BAR();
        }
        if ((PLE_FP8_MASK >> l) & 1) {
          unsigned char* ws = KWS; pg8::Gemm g{(const bf16*)(ws + WS_HB8), (const bf16*)(ws + WS_WPG) + (size_t)l * DM * DM, DM / 2, 0}; pg8::StaticOrder S; S.init(M, DM, opaque_s(G), opaque_s(c));
          pg8::EpiResid<1> E{HBUF(hc), HBUF(hc ^ 1), l + 1 < DEPTH ? nullptr : KOUT, SBUF(sc ^ 1), (const bf16*)(ws + WS_PP), SBUF(sc), nullptr, 1.f / WIN_SCALE, 0}; pg8::gemm_phase<pg8::EpiResid<1>, pg8::StaticOrder, true, true, true>(lds, g, S, E, wbase); sc ^= 1; hc ^= 1; }
        else
        { unsigned char* ws = KWS; pg8::Gemm g{HBUF(hc), (const bf16*)(ws + WS_WPG) + (size_t)l * DM * DM, DM, 0}; pg8::StaticOrder S; S.init(M, DM, opaque_s(G), opaque_s(c));
          pg8::EpiResid<1> E{HBUF(hc), HBUF(hc ^ 1), l + 1 < DEPTH ? nullptr : KOUT, SBUF(sc ^ 1), (const bf16*)(ws + WS_PP), SBUF(sc), ((INPROJ_FP8 || INPROJ_GATES_FP8 || ((INPROJ_FP8_MASK >> (l + 1)) & 1)) && l + 1 < DEPTH) ? ws + WS_HB8 : nullptr, 1.f, 0}; pg8::gemm_phase<pg8::EpiResid<1>, pg8::StaticOrder, true, true>(lds, g, S, E, wbase); sc ^= 1; hc ^= 1; }
        if (l + 1 < DEPTH) GRID_BAR();
    }
    { WAVE_IDS(); if (xb_ld((unsigned*)(KWS + WS_CTL) + CW_BAR + XB_TMO) != 0u) { const float q = __builtin_nanf(""); float* out = KOUT;
        for (int m = gw; m < M; m += ngw) { f32x4* o = (f32x4*)(out + (size_t)m * DM) + lane;
#pragma unroll
            for (int j = 0; j < 4; ++j) o[64 * j] = (f32x4){q, q, q, q}; } } }
#undef GRID_BAR
}

extern "C" void kernel_launch(void* const* d_in, const int* in_sizes, int n_in, void* d_out, int out_size, void* d_ws, size_t ws_size, hipStream_t stream) {
    static int ok = 0, grid = 256;
    if (ok == 0) {
        if (n_in != 30 || in_sizes[0] != M * DM || out_size != M * DM || ws_size < WS_END) { fprintf(stderr, "kernel_launch: unexpected shapes (n_in %d, ws %zu < %zu)\n", n_in, ws_size, (size_t)WS_END); ok = -1; return; }
        if (hipFuncSetAttribute((const void*)mega, hipFuncAttributeMaxDynamicSharedMemorySize, MEGA_LDS) != hipSuccess) { fprintf(stderr, "kernel_launch: hipFuncSetAttribute failed\n"); ok = -1; return; }
        int dev = 0, cus = 0;
        if (hipGetDevice(&dev) == hipSuccess && hipDeviceGetAttribute(&cus, hipDeviceAttributeMultiprocessorCount, dev) == hipSuccess && cus > 0 && cus < 256) grid = cus;
        (void)hipGetLastError();
        ok = 1;
    }
    if (ok < 0) return;
    Ptrs P; memset(&P, 0, sizeof(P)); for (int i = 0; i < 30; ++i) P.in[i] = (const float*)d_in[i]; P.out = (float*)d_out; P.ws = (unsigned char*)d_ws;
    (void)hipMemsetAsync((unsigned char*)d_ws + WS_CTL, 0, CTL_ZERO_BYTES, stream);
    hipLaunchKernelGGL(mega, dim3(grid), dim3(512), MEGA_LDS, stream, P);
}
```
